# Optimizing an MI355X kernel written in HIP

```python
import math
import jax, jax.numpy as jnp
from jax import lax
import numpy as np

D_MODEL = 1024
BATCH = 8
SEQ = 2048
DEPTH = 2

CTX_LEN = 256
GRID_W = 64
ATT_HEADS = 8
ATT_KV_HEADS = 2
HEAD_DIM = 64
Q_PER_KV = ATT_HEADS // ATT_KV_HEADS
ATT_WIDTH = ATT_HEADS * HEAD_DIM
KV_WIDTH = ATT_KV_HEADS * HEAD_DIM
ROPE_THETA = 10000.0
Q_BLOCK = 128
SSD_HEADS = 8
SSD_HEAD_DIM = 64
SSD_WIDTH = SSD_HEADS * SSD_HEAD_DIM
SSD_GROUPS = 2
SSD_STATE = 128
SSD_CHUNK = 128
D_CONV = 3
CONV_WIDTH = SSD_WIDTH + 2 * SSD_GROUPS * SSD_STATE
MIX_WIDTH = ATT_WIDTH + SSD_WIDTH
IN_SPLITS = (ATT_WIDTH, ATT_WIDTH + KV_WIDTH, ATT_WIDTH + 2 * KV_WIDTH,
             ATT_WIDTH + 2 * KV_WIDTH + SSD_WIDTH, ATT_WIDTH + 2 * KV_WIDTH + SSD_WIDTH + CONV_WIDTH)
IN_WIDTH = IN_SPLITS[-1] + 2 * SSD_HEADS
N_EXPERTS = 64
TOP_K = 8
N_EXPERT_GROUPS = 8
TOPK_GROUPS = 4
EXPERT_DIM = 256
SHARED_DIM = 256
ROUTED_SCALE = 2.5
MOE_BLOCK = 128
EPS = 1e-6

kernel_name = 'hybrid_attn_ssd_moe_ctx_prefix_dit'


def rms_norm(x, g):
    xf = x.astype(jnp.float32)
    y = xf * lax.rsqrt(jnp.mean(xf * xf, axis=-1, keepdims=True) + EPS)
    return (y * g.astype(jnp.float32)).astype(x.dtype)


def modulate(h, shift, scale):
    return h * (1 + scale) + shift


def axial_rope_tables(rows):
    row = jnp.repeat(jnp.arange(rows), GRID_W).astype(jnp.float32)
    col = jnp.tile(jnp.arange(GRID_W), rows).astype(jnp.float32)
    n_freq = HEAD_DIM // 4
    inv_freq = ROPE_THETA ** (-jnp.arange(n_freq, dtype=jnp.float32) / n_freq)
    ang = jnp.concatenate([row[:, None] * inv_freq, col[:, None] * inv_freq], axis=-1)
    return jnp.cos(ang), jnp.sin(ang)


def apply_rope(x, cos, sin):
    x1, x2 = jnp.split(x.astype(jnp.float32), 2, axis=-1)
    cs, sn = cos[None, :, None, :], sin[None, :, None, :]
    return jnp.concatenate([x1 * cs - x2 * sn, x1 * sn + x2 * cs], axis=-1).astype(x.dtype)


def softmax_attend(q, k, v):
    s = jnp.einsum('bqkgd,bskd->bkgqs', q, k).astype(jnp.float32) * (HEAD_DIM ** -0.5)
    p = jax.nn.softmax(s, axis=-1).astype(v.dtype)
    return jnp.einsum('bkgqs,bskd->bqkgd', p, v)


def latent_attention(q, k, v):
    b, s = q.shape[:2]
    nb = s // Q_BLOCK
    qb = q.reshape(b, nb, Q_BLOCK, ATT_KV_HEADS, Q_PER_KV, HEAD_DIM).transpose(1, 0, 2, 3, 4, 5)
    out = lax.map(lambda qi: softmax_attend(qi, k, v), qb)
    return out.transpose(1, 0, 2, 3, 4, 5).reshape(b, s, ATT_WIDTH)


def segsum(a):
    t = a.shape[-1]
    ae = jnp.broadcast_to(a[..., :, None], a.shape + (t,))
    cs = jnp.cumsum(jnp.where(jnp.tril(jnp.ones((t, t), bool), -1), ae, 0.0), axis=-2)
    return jnp.where(jnp.tril(jnp.ones((t, t), bool)), cs, -jnp.inf)


def ssd_scan(xh, dt, a, bg, cg, h0):
    b, l, h, p = xh.shape
    nc = l // SSD_CHUNK
    rep = SSD_HEADS // SSD_GROUPS
    bh = jnp.repeat(bg, rep, axis=2).reshape(b, nc, SSD_CHUNK, h, SSD_STATE)
    ch = jnp.repeat(cg, rep, axis=2).reshape(b, nc, SSD_CHUNK, h, SSD_STATE)
    xd = (xh * dt[..., None].astype(xh.dtype)).reshape(b, nc, SSD_CHUNK, h, p)
    la = (dt * a).astype(jnp.float32).reshape(b, nc, SSD_CHUNK, h).transpose(0, 3, 1, 2)
    la_cs = jnp.cumsum(la, axis=-1)
    y_diag = jnp.einsum('bclhn,bcshn,bhcls,bcshp->bclhp', ch, bh, jnp.exp(segsum(la)), xd)
    decay_to_end = jnp.exp(la_cs[..., -1:] - la_cs)
    states = jnp.einsum('bclhn,bhcl,bclhp->bchpn', bh, decay_to_end, xd)
    states = jnp.concatenate([h0[:, None].astype(states.dtype), states], axis=1)
    chunk_decay = jnp.exp(segsum(jnp.pad(la_cs[..., -1], ((0, 0), (0, 0), (1, 0)))))
    new_states = jnp.einsum('bhzc,bchpn->bzhpn', chunk_decay, states)
    states_in, h_final = new_states[:, :-1], new_states[:, -1]
    y_off = jnp.einsum('bclhn,bchpn,bhcl->bclhp', ch, states_in, jnp.exp(la_cs))
    y = (y_diag + y_off).reshape(b, l, h, p)
    return y.astype(xh.dtype), h_final


def depthwise_conv(u, w, bias):
    out = lax.conv_general_dilated(u, w[:, None, :], window_strides=(1,), padding='SAME',
                                   dimension_numbers=('NWC', 'WIO', 'NWC'), feature_group_count=u.shape[-1])
    return out + bias


def ssd_stream(z, xbc, dt_raw, conv_w, conv_b, dt_bias, a_log, d_skip, g_norm, h0_fwd, h0_bwd):
    b, l, _ = z.shape
    xbc = jax.nn.silu(depthwise_conv(xbc, conv_w, conv_b))
    xs, bg, cg = jnp.split(xbc, [SSD_WIDTH, SSD_WIDTH + SSD_GROUPS * SSD_STATE], axis=-1)
    xh = xs.reshape(b, l, SSD_HEADS, SSD_HEAD_DIM)
    bg = bg.reshape(b, l, SSD_GROUPS, SSD_STATE)
    cg = cg.reshape(b, l, SSD_GROUPS, SSD_STATE)
    dt = jax.nn.softplus(dt_raw.astype(jnp.float32).reshape(b, l, 2, SSD_HEADS) + dt_bias.astype(jnp.float32))
    a = -jnp.exp(a_log.astype(jnp.float32))
    y_f, h_f = ssd_scan(xh, dt[:, :, 0], a[0], bg, cg, h0_fwd)
    y_b, h_b = ssd_scan(xh[:, ::-1], dt[:, ::-1, 1], a[1], bg[:, ::-1], cg[:, ::-1], h0_bwd)
    y = y_f + y_b[:, ::-1] + xh * d_skip[:, None]
    y = y.reshape(b, l, SSD_WIDTH)
    return rms_norm(y * jax.nn.silu(z), g_norm), h_f, h_b


def mixer(hc, hl, cos, sin, w_in, w_out, q_norm, k_norm, conv_w, conv_b, dt_bias, a_log, d_skip, ssd_norm, ctx_out):
    b, lc, _ = hc.shape
    s = hl.shape[1]
    qc, kc, vc, zc, xbcc, dtc = jnp.split(hc @ w_in, IN_SPLITS, axis=-1)
    ql, kl, vl, zl, xbcl, dtl = jnp.split(hl @ w_in, IN_SPLITS, axis=-1)
    kc = rms_norm(kc.reshape(b, lc, ATT_KV_HEADS, HEAD_DIM), k_norm)
    vc = vc.reshape(b, lc, ATT_KV_HEADS, HEAD_DIM)
    kl = apply_rope(rms_norm(kl.reshape(b, s, ATT_KV_HEADS, HEAD_DIM), k_norm), cos, sin)
    vl = vl.reshape(b, s, ATT_KV_HEADS, HEAD_DIM)
    ql = apply_rope(rms_norm(ql.reshape(b, s, ATT_HEADS, HEAD_DIM), q_norm), cos, sin)
    ql = ql.reshape(b, s, ATT_KV_HEADS, Q_PER_KV, HEAD_DIM)
    k_all = jnp.concatenate([kc, kl], axis=1)
    v_all = jnp.concatenate([vc, vl], axis=1)
    att_l = latent_attention(ql, k_all, v_all)
    zero = jnp.zeros((b, SSD_HEADS, SSD_HEAD_DIM, SSD_STATE), jnp.float32)
    ssd_c, h_f, h_b = ssd_stream(zc, xbcc, dtc, conv_w, conv_b, dt_bias, a_log, d_skip, ssd_norm, zero, zero)
    ssd_l, _, _ = ssd_stream(zl, xbcl, dtl, conv_w, conv_b, dt_bias, a_log, d_skip, ssd_norm, h_f, h_b)
    out_l = jnp.concatenate([att_l, ssd_l], axis=-1) @ w_out
    if not ctx_out:
        return None, out_l
    qc = rms_norm(qc.reshape(b, lc, ATT_HEADS, HEAD_DIM), q_norm).reshape(b, lc, ATT_KV_HEADS, Q_PER_KV, HEAD_DIM)
    att_c = softmax_attend(qc, kc, vc).reshape(b, lc, ATT_WIDTH)
    out_c = jnp.concatenate([att_c, ssd_c], axis=-1) @ w_out
    return out_c, out_l


def moe_ffn(h, router_w, router_bias, w_gate, w_up, w_down, ws_gate, ws_up, ws_down):
    b, l, d = h.shape
    scores = jax.nn.sigmoid(jnp.einsum('bld,de->ble', h, router_w).astype(jnp.float32))
    choice = scores + router_bias.astype(jnp.float32)
    grp = choice.reshape(b, l, N_EXPERT_GROUPS, N_EXPERTS // N_EXPERT_GROUPS)
    grp_score = lax.top_k(grp, 2)[0].sum(-1)
    _, grp_idx = lax.top_k(grp_score, TOPK_GROUPS)
    grp_mask = jax.nn.one_hot(grp_idx, N_EXPERT_GROUPS, dtype=jnp.float32).sum(-2)
    expert_ok = jnp.repeat(grp_mask, N_EXPERTS // N_EXPERT_GROUPS, axis=-1) > 0
    _, idx = lax.top_k(jnp.where(expert_ok, choice, -jnp.inf), TOP_K)
    gw = jnp.take_along_axis(scores, idx, axis=-1)
    gw = gw / jnp.sum(gw, axis=-1, keepdims=True) * ROUTED_SCALE
    combine = jnp.sum(jax.nn.one_hot(idx, N_EXPERTS, dtype=jnp.float32) * gw[..., None], axis=-2)
    nb = l // MOE_BLOCK
    hb = h.reshape(b, nb, MOE_BLOCK, d).swapaxes(0, 1)
    cb = combine.astype(h.dtype).reshape(b, nb, MOE_BLOCK, N_EXPERTS).swapaxes(0, 1)

    def block(args):
        hx, cx = args
        g = jnp.einsum('bld,edf->blef', hx, w_gate)
        u = jnp.einsum('bld,edf->blef', hx, w_up)
        return jnp.einsum('blef,efd->bld', jax.nn.silu(g) * u * cx[..., None], w_down)

    routed = lax.map(block, (hb, cb)).swapaxes(0, 1).reshape(b, l, d)
    shared = (jax.nn.silu(h @ ws_gate) * (h @ ws_up)) @ ws_down
    return routed + shared


def setup_inputs(seed: int = 0) -> dict:
    key = jax.random.key(seed)
    ks = jax.random.split(key, 32)
    f32 = jnp.float32
    L, D = DEPTH, D_MODEL

    def nrm(k, shape, scale):
        return jax.random.normal(k, shape, f32) * scale

    dt0 = jnp.exp(jax.random.uniform(ks[13], (L, 2, SSD_HEADS), f32, math.log(1e-3), math.log(1e-1)))
    return {
        'x': nrm(ks[0], (BATCH, SEQ, D), 1.0),
        'c': nrm(ks[1], (BATCH, D), 1.0),
        'ctx': nrm(ks[2], (BATCH, CTX_LEN, D), 1.0),
        'c_ctx': nrm(ks[3], (D,), 1.0),
        'w_mod': nrm(ks[4], (L, D, 6 * D), 0.5 * D ** -0.5),
        'b_mod': nrm(ks[5], (L, 6 * D), 0.01),
        'g_pre_mix': 1.0 + nrm(ks[6], (L, D), 0.05),
        'g_post_mix': 1.0 + nrm(ks[7], (L, D), 0.05),
        'g_pre_ffn': 1.0 + nrm(ks[8], (L, D), 0.05),
        'g_post_ffn': 1.0 + nrm(ks[9], (L, D), 0.05),
        'w_in': nrm(ks[10], (L, D, IN_WIDTH), D ** -0.5),
        'q_norm': 1.0 + nrm(ks[11], (L, HEAD_DIM), 0.05),
        'k_norm': 1.0 + nrm(ks[12], (L, HEAD_DIM), 0.05),
        'conv_w': nrm(ks[14], (L, D_CONV, CONV_WIDTH), D_CONV ** -0.5),
        'conv_b': nrm(ks[15], (L, CONV_WIDTH), 0.01),
        'dt_bias': dt0 + jnp.log(-jnp.expm1(-dt0)),
        'a_log': jnp.log(jax.random.uniform(ks[16], (L, 2, SSD_HEADS), f32, 1.0, 16.0)),
        'd_skip': 1.0 + nrm(ks[17], (L, SSD_HEADS), 0.05),
        'ssd_norm': 1.0 + nrm(ks[18], (L, SSD_WIDTH), 0.05),
        'w_out': nrm(ks[19], (L, MIX_WIDTH, D), MIX_WIDTH ** -0.5),
        'router_w': nrm(ks[20], (L, D, N_EXPERTS), D ** -0.5),
        'router_bias': nrm(ks[21], (L, N_EXPERTS), 0.01),
        'w_gate': nrm(ks[22], (L, N_EXPERTS, D, EXPERT_DIM), D ** -0.5),
        'w_up': nrm(ks[23], (L, N_EXPERTS, D, EXPERT_DIM), D ** -0.5),
        'w_down': nrm(ks[24], (L, N_EXPERTS, EXPERT_DIM, D), EXPERT_DIM ** -0.5),
        'ws_gate': nrm(ks[25], (L, D, SHARED_DIM), D ** -0.5),
        'ws_up': nrm(ks[26], (L, D, SHARED_DIM), D ** -0.5),
        'ws_down': nrm(ks[27], (L, SHARED_DIM, D), SHARED_DIM ** -0.5),
    }


def reference(x, c, ctx, c_ctx, w_mod, b_mod, g_pre_mix, g_post_mix, g_pre_ffn, g_post_ffn, w_in, q_norm, k_norm,
              conv_w, conv_b, dt_bias, a_log, d_skip, ssd_norm, w_out, router_w, router_bias, w_gate, w_up, w_down,
              ws_gate, ws_up, ws_down):
    s = x.shape[1]
    rows = s // GRID_W
    cos, sin = axial_rope_tables(rows)
    xl, xc = x, ctx
    for i in range(DEPTH):
        ctx_out = i < DEPTH - 1
        mod_l = (jax.nn.silu(c) @ w_mod[i] + b_mod[i])[:, None, :]
        mod_c = jax.nn.silu(c_ctx) @ w_mod[i] + b_mod[i]
        sh1_l, sc1_l, g1_l, sh2_l, sc2_l, g2_l = jnp.split(mod_l, 6, axis=-1)
        sh1_c, sc1_c, g1_c, sh2_c, sc2_c, g2_c = jnp.split(mod_c, 6, axis=-1)
        hl = modulate(rms_norm(xl, g_pre_mix[i]), sh1_l, sc1_l)
        hc = modulate(rms_norm(xc, g_pre_mix[i]), sh1_c, sc1_c)
        mc, ml = mixer(hc, hl, cos, sin, w_in[i], w_out[i], q_norm[i], k_norm[i], conv_w[i], conv_b[i],
                       dt_bias[i], a_log[i], d_skip[i], ssd_norm[i], ctx_out)
        xl = xl + g1_l * rms_norm(ml, g_post_mix[i])
        hl = modulate(rms_norm(xl, g_pre_ffn[i]), sh2_l, sc2_l)
        xl = xl + g2_l * rms_norm(moe_ffn(hl, router_w[i], router_bias[i], w_gate[i], w_up[i], w_down[i],
                                          ws_gate[i], ws_up[i], ws_down[i]), g_post_ffn[i])
        if ctx_out:
            xc = xc + g1_c * rms_norm(mc, g_post_mix[i])
            hc = modulate(rms_norm(xc, g_pre_ffn[i]), sh2_c, sc2_c)
            xc = xc + g2_c * rms_norm(moe_ffn(hc, router_w[i], router_bias[i], w_gate[i], w_up[i], w_down[i],
                                              ws_gate[i], ws_up[i], ws_down[i]), g_post_ffn[i])
    return xl
```

```cpp
#include <hip/hip_runtime.h>
#include <stdint.h>
#include <stdio.h>

#define DEV __device__ __forceinline__
typedef unsigned short bf16_t;
typedef short bf16x8 __attribute__((ext_vector_type(8)));
typedef float f32x16 __attribute__((ext_vector_type(16)));
typedef __bf16 bf16x2_t __attribute__((ext_vector_type(2)));
typedef float f32x2_t __attribute__((ext_vector_type(2)));

constexpr int NB = 8, SEQ = 2048, LC = 256, DM = 1024;
constexpr int TL = NB * SEQ, TC = NB * LC, TT = TL + TC;
constexpr int NCH = TT / 128, NCHL = TL / 128;
constexpr int NIN = 2304, NINF = 2320;
constexpr int C_Q = 0, C_K = 512, C_V = 640, C_Z = 768, C_X = 1280;
constexpr int NKEY = LC + SEQ;
constexpr int NEXP = 64, FE = 256, CAP = TT;
constexpr float EPS = 1e-6f;
constexpr float QSCALE = 0.125f * 1.4426950408889634f;
constexpr int GRID = 512, NTHR = 256, NWAVE_TOT = GRID * 4;

constexpr size_t al256(size_t x) { return (x + 255) & ~(size_t)255; }
constexpr size_t WS_CTL = 0, CTL_BYTES = 65536;
constexpr size_t WS_MOD = WS_CTL + CTL_BYTES;
constexpr size_t WS_ROPE = WS_MOD + al256((size_t)2 * 9 * 6144 * 4);
constexpr size_t WS_WIN = WS_ROPE + (size_t)2048 * 32 * 8;
constexpr size_t WS_WOUT = WS_WIN + (size_t)NIN * DM * 2;
constexpr size_t WS_WG = WS_WOUT + (size_t)DM * DM * 2;
constexpr size_t WS_WU = WS_WG + (size_t)65 * FE * DM * 2;
constexpr size_t WS_WD = WS_WU + (size_t)65 * FE * DM * 2;
constexpr size_t WS_XC = WS_WD + (size_t)65 * FE * DM * 2;
constexpr size_t WS_H = WS_XC + (size_t)TC * DM * 4;
constexpr size_t WS_DT = WS_H + (size_t)TT * DM * 2;
constexpr size_t WS_TOPK = WS_DT + (size_t)TT * 16 * 4;
constexpr size_t WS_LIST = WS_TOPK + (size_t)TT * 8 * 4;
constexpr size_t WS_CUM = WS_LIST + (size_t)NEXP * CAP * 8;
constexpr size_t WS_WST = WS_CUM + (size_t)NCH * 16 * 128 * 4;
constexpr size_t WS_DTT = WS_WST + (size_t)NCH * 16 * 128 * 4;
constexpr size_t WS_TOT = WS_DTT + (size_t)NCH * 16 * 128 * 4;
constexpr size_t WS_SSQ = WS_TOT + al256((size_t)NCH * 16 * 4);
constexpr size_t WS_ACT = WS_SSQ + (size_t)TT * 8 * 4;
constexpr size_t WS_R1 = WS_ACT + (size_t)TT * 9 * FE * 2;
constexpr size_t WS_QKVZX = WS_R1;
constexpr size_t WS_ML = WS_R1;
constexpr size_t WS_QP = WS_QKVZX + (size_t)TT * NIN * 2;
constexpr size_t WS_KP = WS_QP + (size_t)TT * 512 * 2;
constexpr size_t WS_VT = WS_KP + (size_t)TT * 128 * 2;
constexpr size_t WS_XT = WS_VT + (size_t)NB * 2 * 64 * NKEY * 2;
constexpr size_t WS_BT = WS_XT + (size_t)NCH * 8 * 64 * 128 * 2;
constexpr size_t WS_BC = WS_BT + (size_t)NCH * 2 * 128 * 128 * 2;
constexpr size_t WS_SST = WS_BC + (size_t)TT * 512 * 2;
constexpr size_t WS_CB = WS_SST + (size_t)NCH * 2 * 8 * 64 * 128 * 2;
constexpr size_t WS_AS = WS_CB + (size_t)NCH * 2 * 128 * 128 * 4;
constexpr size_t WS_R1A_END = WS_AS + (size_t)TT * DM * 2;
constexpr size_t WS_YH = WS_R1;
constexpr size_t WS_MO = WS_YH + (size_t)TT * 9 * 512 * 2;
constexpr size_t WS_R1B_END = WS_MO + (size_t)TT * DM * 4;
constexpr size_t WS_END = WS_R1A_END > WS_R1B_END ? WS_R1A_END : WS_R1B_END;
static_assert(WS_END <= (size_t)536 * 1024 * 1024, "workspace map too large");
constexpr int CW_CNT = 4096;

struct P {
    const float *x, *c, *ctx, *c_ctx, *w_mod, *b_mod, *g_pre_mix, *g_post_mix, *g_pre_ffn, *g_post_ffn, *w_in, *q_norm, *k_norm, *conv_w, *conv_b,
        *dt_bias, *a_log, *d_skip, *ssd_norm, *w_out, *router_w, *router_bias, *w_gate, *w_up, *w_down, *ws_gate, *ws_up, *ws_down;
    float* out;
    unsigned char* ws;
};

DEV unsigned pk2(float lo, float hi) { f32x2_t v = {lo, hi}; bf16x2_t b = __builtin_convertvector(v, bf16x2_t); return __builtin_bit_cast(unsigned, b); }
DEV float bflo(unsigned u) { return __builtin_bit_cast(float, u << 16); }
DEV float bfhi(unsigned u) { return __builtin_bit_cast(float, u & 0xffff0000u); }
DEV void unpack8(uint4 q, float* f) { f[0] = bflo(q.x); f[1] = bfhi(q.x); f[2] = bflo(q.y); f[3] = bfhi(q.y); f[4] = bflo(q.z); f[5] = bfhi(q.z); f[6] = bflo(q.w); f[7] = bfhi(q.w); }
DEV uint4 pack8(const float* f) { uint4 q; q.x = pk2(f[0], f[1]); q.y = pk2(f[2], f[3]); q.z = pk2(f[4], f[5]); q.w = pk2(f[6], f[7]); return q; }
DEV float wave_sum(float v) {
#pragma unroll
    for (int o = 32; o > 0; o >>= 1) v += __shfl_xor(v, o);
    return v;
}
DEV float silu_f(float v) { return v / (1.f + __expf(-v)); }
DEV float sigmoid_f(float v) { return 1.f / (1.f + __expf(-v)); }
DEV float softplus_f(float v) { return v > 20.f ? v : log1pf(__expf(v)); }

template <int BN, class AL, class BL, class EP>
DEV void gemm_tile(unsigned char* lds, int nk, AL& al, BL& bl, EP& ep) {
    constexpr int NT = BN / 64;
    constexpr int NBCH = BN / 32;
    constexpr int A_BYTES = 128 * 128, B_BYTES = BN * 128, STAGE = A_BYTES + B_BYTES;
    const int tid = threadIdx.x, lane = tid & 63, wid = tid >> 6, wr = wid >> 1, wc = wid & 1;
    const int kc = tid & 7, r0 = tid >> 3;
    const int wsw = (kc ^ ((r0 >> 1) & 7)) << 4;
    const int rsw = (lane >> 1) & 7, lr = lane & 31, lh = lane >> 5;
    f32x16 acc[2][NT];
#pragma unroll
    for (int mi = 0; mi < 2; ++mi)
#pragma unroll
        for (int ni = 0; ni < NT; ++ni)
#pragma unroll
            for (int e = 0; e < 16; ++e) acc[mi][ni][e] = 0.f;
    uint4 ra[4], rb[NBCH];
#pragma unroll
    for (int i = 0; i < 4; ++i) ra[i] = al.load(i, r0 + 32 * i, kc);
#pragma unroll
    for (int i = 0; i < NBCH; ++i) rb[i] = bl.load(i, r0 + 32 * i, kc);
    __syncthreads();
#pragma unroll
    for (int i = 0; i < 4; ++i) *(uint4*)(lds + (r0 + 32 * i) * 128 + wsw) = ra[i];
#pragma unroll
    for (int i = 0; i < NBCH; ++i) *(uint4*)(lds + A_BYTES + (r0 + 32 * i) * 128 + wsw) = rb[i];
    __syncthreads();
    for (int ks = 0; ks < nk; ++ks) {
        const int cur = ks & 1;
        if (ks + 1 < nk) {
#pragma unroll
            for (int i = 0; i < 4; ++i) ra[i] = al.load(i, r0 + 32 * i, (ks + 1) * 8 + kc);
#pragma unroll
            for (int i = 0; i < NBCH; ++i) rb[i] = bl.load(i, r0 + 32 * i, (ks + 1) * 8 + kc);
        }
        const unsigned char* sa = lds + cur * STAGE;
        const unsigned char* sb = sa + A_BYTES;
#pragma unroll
        for (int kk = 0; kk < 4; ++kk) {
            const int co = ((2 * kk + lh) ^ rsw) << 4;
            bf16x8 fa[2], fb[NT];
#pragma unroll
            for (int mi = 0; mi < 2; ++mi) fa[mi] = *(const bf16x8*)(sa + (wr * 64 + mi * 32 + lr) * 128 + co);
#pragma unroll
            for (int ni = 0; ni < NT; ++ni) fb[ni] = *(const bf16x8*)(sb + (wc * (BN / 2) + ni * 32 + lr) * 128 + co);
#pragma unroll
            for (int mi = 0; mi < 2; ++mi)
#pragma unroll
                for (int ni = 0; ni < NT; ++ni) acc[mi][ni] = __builtin_amdgcn_mfma_f32_32x32x16_bf16(fa[mi], fb[ni], acc[mi][ni], 0, 0, 0);
        }
        if (ks + 1 < nk) {
            unsigned char* da = lds + (cur ^ 1) * STAGE;
#pragma unroll
            for (int i = 0; i < 4; ++i) *(uint4*)(da + (r0 + 32 * i) * 128 + wsw) = ra[i];
#pragma unroll
            for (int i = 0; i < NBCH; ++i) *(uint4*)(da + A_BYTES + (r0 + 32 * i) * 128 + wsw) = rb[i];
        }
        __syncthreads();
    }
    float* ct = (float*)lds;
#pragma unroll
    for (int mi = 0; mi < 2; ++mi)
#pragma unroll
        for (int ni = 0; ni < NT; ++ni)
#pragma unroll
            for (int e = 0; e < 16; ++e) {
                const int row = wr * 64 + mi * 32 + (e & 3) + 8 * (e >> 2) + 4 * lh;
                const int col = wc * (BN / 2) + ni * 32 + lr;
                ct[row * BN + col] = acc[mi][ni][e];
            }
    __syncthreads();
    ep(ct, tid);
}
DEV void ld8f(const float* ct, int off, float* v) {
    const float4 a = *(const float4*)(ct + off), b = *(const float4*)(ct + off + 4);
    v[0] = a.x; v[1] = a.y; v[2] = a.z; v[3] = a.w; v[4] = b.x; v[5] = b.y; v[6] = b.z; v[7] = b.w;
}

struct LdRows {
    const bf16_t* base; size_t ld; int row0, nrows;
    DEV uint4 load(int, int r, int kcg) const {
        if (row0 + r >= nrows) return make_uint4(0, 0, 0, 0);
        return *(const uint4*)(base + (size_t)(row0 + r) * ld + kcg * 8);
    }
};
struct EpStoreBf16 {
    bf16_t* O; size_t ld; int row0, col0, nrows;
    DEV void operator()(const float* ct, int tid) const {
#pragma unroll
        for (int i = 0; i < 8; ++i) {
            const int id = tid + 256 * i, r = id >> 4, c8 = id & 15;
            float v[8]; ld8f(ct, r * 128 + c8 * 8, v);
            if (row0 + r < nrows) *(uint4*)(O + (size_t)(row0 + r) * ld + col0 + c8 * 8) = pack8(v);
        }
    }
};

DEV void transpose_tile(unsigned char* lds, const float* src, int ld_src, bf16_t* dst, int ld_dst, int r0, int c0) {
    float* t = (float*)lds;
    const int tid = threadIdx.x;
    __syncthreads();
#pragma unroll
    for (int i = 0; i < 4; ++i) {
        const int r = (tid >> 4) + 16 * i, c4 = (tid & 15) * 4;
        const float4 v = *(const float4*)(src + (size_t)(r0 + r) * ld_src + c0 + c4);
        t[r * 65 + c4] = v.x; t[r * 65 + c4 + 1] = v.y; t[r * 65 + c4 + 2] = v.z; t[r * 65 + c4 + 3] = v.w;
    }
    __syncthreads();
#pragma unroll
    for (int j = 0; j < 2; ++j) {
        const int c = (tid >> 3) + 32 * j, r8 = (tid & 7) * 8;
        float v[8];
#pragma unroll
        for (int e = 0; e < 8; ++e) v[e] = t[(r8 + e) * 65 + c];
        *(uint4*)(dst + (size_t)(c0 + c) * ld_dst + r0 + r8) = pack8(v);
    }
}
DEV void phase_p0(const P& p, int layer, unsigned char* lds) {
    bf16_t* WIN = (bf16_t*)(p.ws + WS_WIN); bf16_t* WOUT = (bf16_t*)(p.ws + WS_WOUT);
    bf16_t* WG = (bf16_t*)(p.ws + WS_WG); bf16_t* WU = (bf16_t*)(p.ws + WS_WU); bf16_t* WD = (bf16_t*)(p.ws + WS_WD);
    constexpr int T0 = 576, T1 = T0 + 256, T2 = T1 + 4096, T3 = T2 + 4096, T4 = T3 + 4096, T5 = T4 + 64, T6 = T5 + 64, T7 = T6 + 64;
    const int nextra = (layer == 0) ? (192 + 256) : 0;
    for (int it = blockIdx.x; it < T7 + nextra; it += gridDim.x) {
        if (it < T0) { const int rt = it / 36, ct = it % 36; transpose_tile(lds, p.w_in + (size_t)layer * DM * NINF, NINF, WIN, DM, rt * 64, ct * 64); }
        else if (it < T1) { const int ti = it - T0, rt = ti >> 4, ct = ti & 15; transpose_tile(lds, p.w_out + (size_t)layer * DM * DM, DM, WOUT, DM, rt * 64, ct * 64); }
        else if (it < T2) { const int ti = it - T1, e = ti >> 6, rem = ti & 63, rt = rem >> 2, ct = rem & 3;
            transpose_tile(lds, p.w_gate + ((size_t)layer * 64 + e) * DM * FE, FE, WG + (size_t)e * FE * DM, DM, rt * 64, ct * 64); }
        else if (it < T3) { const int ti = it - T2, e = ti >> 6, rem = ti & 63, rt = rem >> 2, ct = rem & 3;
            transpose_tile(lds, p.w_up + ((size_t)layer * 64 + e) * DM * FE, FE, WU + (size_t)e * FE * DM, DM, rt * 64, ct * 64); }
        else if (it < T4) { const int ti = it - T3, e = ti >> 6, rem = ti & 63, rt = rem >> 4, ct = rem & 15;
            transpose_tile(lds, p.w_down + ((size_t)layer * 64 + e) * FE * DM, DM, WD + (size_t)e * DM * FE, FE, rt * 64, ct * 64); }
        else if (it < T5) { const int ti = it - T4, rt = ti >> 2, ct = ti & 3; transpose_tile(lds, p.ws_gate + (size_t)layer * DM * FE, FE, WG + (size_t)64 * FE * DM, DM, rt * 64, ct * 64); }
        else if (it < T6) { const int ti = it - T5, rt = ti >> 2, ct = ti & 3; transpose_tile(lds, p.ws_up + (size_t)layer * DM * FE, FE, WU + (size_t)64 * FE * DM, DM, rt * 64, ct * 64); }
        else if (it < T7) { const int ti = it - T6, rt = ti >> 4, ct = ti & 15; transpose_tile(lds, p.ws_down + (size_t)layer * FE * DM, DM, WD + (size_t)64 * DM * FE, FE, rt * 64, ct * 64); }
        else if (it < T7 + 192) {
            const int mi = it - T7, l = mi / 96, cg = mi % 96, tid = threadIdx.x, lane = tid & 63, wid = tid >> 6;
            float* sc = (float*)lds;
            float* part = sc + 9 * 1024;
            __syncthreads();
            for (int i = tid; i < 9 * 1024; i += 256) { const float v = (i < 8192) ? p.c[i] : p.c_ctx[i - 8192]; sc[i] = silu_f(v); }
            __syncthreads();
            float a9[9];
#pragma unroll
            for (int r = 0; r < 9; ++r) a9[r] = 0.f;
            const float* wm = p.w_mod + (size_t)l * DM * 6144 + cg * 64 + lane;
            for (int k = wid * 256; k < wid * 256 + 256; ++k) {
                const float w = wm[(size_t)k * 6144];
#pragma unroll
                for (int r = 0; r < 9; ++r) a9[r] += sc[r * 1024 + k] * w;
            }
#pragma unroll
            for (int r = 0; r < 9; ++r) part[(wid * 9 + r) * 64 + lane] = a9[r];
            __syncthreads();
            float* MOD = (float*)(p.ws + WS_MOD);
            for (int i = tid; i < 9 * 64; i += 256) {
                const int r = i >> 6, j = i & 63;
                const float s = ((part[(0 * 9 + r) * 64 + j] + part[(1 * 9 + r) * 64 + j]) + part[(2 * 9 + r) * 64 + j]) + part[(3 * 9 + r) * 64 + j];
                MOD[((size_t)l * 9 + r) * 6144 + cg * 64 + j] = s + p.b_mod[l * 6144 + cg * 64 + j];
            }
        } else {
            const int idx = (it - T7 - 192) * 256 + threadIdx.x, pos = idx >> 5, i = idx & 31, f = i & 15;
            const float inv = powf(10000.f, -(float)f / 16.f);
            const float ang = (float)((i < 16) ? (pos >> 6) : (pos & 63)) * inv;
            float2* ROPE = (float2*)(p.ws + WS_ROPE);
            ROPE[idx] = make_float2(cosf(ang), sinf(ang));
        }
    }
}

DEV void ld_row16(const float* row, int lane, float* v) {
#pragma unroll
    for (int i = 0; i < 4; ++i) { const float4 q = *(const float4*)(row + 4 * lane + 256 * i); v[4 * i] = q.x; v[4 * i + 1] = q.y; v[4 * i + 2] = q.z; v[4 * i + 3] = q.w; }
}
DEV void st_row16(float* row, int lane, const float* v) {
#pragma unroll
    for (int i = 0; i < 4; ++i) *(float4*)(row + 4 * lane + 256 * i) = make_float4(v[4 * i], v[4 * i + 1], v[4 * i + 2], v[4 * i + 3]);
}
DEV void ld_row16_bf(const bf16_t* row, int lane, float* v) {
#pragma unroll
    for (int i = 0; i < 4; ++i) { const uint2 q = *(const uint2*)(row + 4 * lane + 256 * i); v[4 * i] = bflo(q.x); v[4 * i + 1] = bfhi(q.x); v[4 * i + 2] = bflo(q.y); v[4 * i + 3] = bfhi(q.y); }
}
DEV void st_row16_bf(bf16_t* row, int lane, const float* v) {
#pragma unroll
    for (int i = 0; i < 4; ++i) *(uint2*)(row + 4 * lane + 256 * i) = make_uint2(pk2(v[4 * i], v[4 * i + 1]), pk2(v[4 * i + 2], v[4 * i + 3]));
}
DEV float rstd16(const float* v) {
    float s = 0.f;
#pragma unroll
    for (int e = 0; e < 16; ++e) s += v[e] * v[e];
    s = wave_sum(s);
    return rsqrtf(s * (1.f / 1024.f) + EPS);
}
DEV void resid_update(float* x, const float* y, const float* gate, const float* gpost, int lane) {
    float g[16], gp[16];
    ld_row16(gate, lane, g); ld_row16(gpost, lane, gp);
    const float rs = rstd16(y);
#pragma unroll
    for (int e = 0; e < 16; ++e) x[e] += g[e] * (y[e] * rs * gp[e]);
}
DEV void norm_mod(const float* x, float* h, const float* gpre, const float* sh, const float* sc, int lane) {
    float g[16], a[16], b[16];
    ld_row16(gpre, lane, g); ld_row16(sh, lane, a); ld_row16(sc, lane, b);
    const float rs = rstd16(x);
#pragma unroll
    for (int e = 0; e < 16; ++e) h[e] = (x[e] * rs * g[e]) * (1.f + b[e]) + a[e];
}
DEV void stage_wdt(const P& p, int layer, float* wl) {
    const float* w = p.w_in + (size_t)layer * DM * NINF + NIN;
    __syncthreads();
    for (int i = threadIdx.x; i < 1024 * 4; i += 256) { const int c = i >> 2, q = i & 3; *(float4*)(wl + c * 16 + q * 4) = *(const float4*)(w + (size_t)c * NINF + q * 4); }
    __syncthreads();
}
DEV void dt_tail(const float* h, const float* wl, const float* bias, float* dtrow, int lane) {
    float a[16];
#pragma unroll
    for (int j = 0; j < 16; ++j) a[j] = 0.f;
#pragma unroll
    for (int i = 0; i < 4; ++i)
#pragma unroll
        for (int jj = 0; jj < 4; ++jj) {
            const int c = 4 * lane + 256 * i + jj; const float hv = h[4 * i + jj];
#pragma unroll
            for (int q = 0; q < 4; ++q) { const float4 w = *(const float4*)(wl + c * 16 + q * 4); a[4 * q] += hv * w.x; a[4 * q + 1] += hv * w.y; a[4 * q + 2] += hv * w.z; a[4 * q + 3] += hv * w.w; }
            asm volatile("" ::: "memory");
        }
#pragma unroll
    for (int j = 0; j < 16; ++j) a[j] = wave_sum(a[j]);
    if (lane < 16) {
        float v = a[0];
#pragma unroll
        for (int j = 1; j < 16; ++j) v = (lane == j) ? a[j] : v;
        dtrow[lane] = softplus_f(v + bias[lane]);
    }
}
DEV void phase_pa0(const P& p, unsigned char* lds) {
    float* wl = (float*)lds; stage_wdt(p, 0, wl);
    const int lane = threadIdx.x & 63, gw = blockIdx.x * 4 + (threadIdx.x >> 6);
    const float* MOD = (const float*)(p.ws + WS_MOD);
    bf16_t* H = (bf16_t*)(p.ws + WS_H); float* DT = (float*)(p.ws + WS_DT);
    for (int tok = gw; tok < TT; tok += NWAVE_TOT) {
        const float* xr = tok < TL ? p.x + (size_t)tok * DM : p.ctx + (size_t)(tok - TL) * DM;
        const int mr = tok < TL ? tok / SEQ : 8;
        const float* md = MOD + (size_t)mr * 6144;
        float x[16], h[16];
        ld_row16(xr, lane, x);
        norm_mod(x, h, p.g_pre_mix, md + 0, md + 1024, lane);
        st_row16_bf(H + (size_t)tok * DM, lane, h);
        dt_tail(h, wl, p.dt_bias, DT + (size_t)tok * 16, lane);
    }
}
DEV void phase_pm(const P& p, int layer, unsigned char* lds) {
    const bool last = (layer == 1);
    float* wl = (float*)lds; if (!last) stage_wdt(p, layer + 1, wl);
    const int lane = threadIdx.x & 63, gw = blockIdx.x * 4 + (threadIdx.x >> 6);
    const float* MOD = (const float*)(p.ws + WS_MOD);
    const float* MO = (const float*)(p.ws + WS_MO);
    float* XC = (float*)(p.ws + WS_XC);
    bf16_t* H = (bf16_t*)(p.ws + WS_H); float* DT = (float*)(p.ws + WS_DT);
    const int nt = last ? TL : TT;
    for (int tok = gw; tok < nt; tok += NWAVE_TOT) {
        float* xr = tok < TL ? p.out + (size_t)tok * DM : XC + (size_t)(tok - TL) * DM;
        const int mr = tok < TL ? tok / SEQ : 8;
        const float* md = MOD + ((size_t)layer * 9 + mr) * 6144;
        float x[16], y[16];
        ld_row16(xr, lane, x); ld_row16(MO + (size_t)tok * DM, lane, y);
        resid_update(x, y, md + 5120, p.g_post_ffn + layer * DM, lane);
        st_row16(xr, lane, x);
        if (!last) {
            const float* md1 = MOD + ((size_t)(layer + 1) * 9 + mr) * 6144;
            float h[16];
            norm_mod(x, h, p.g_pre_mix + (layer + 1) * DM, md1 + 0, md1 + 1024, lane);
            st_row16_bf(H + (size_t)tok * DM, lane, h);
            dt_tail(h, wl, p.dt_bias + (layer + 1) * 16, DT + (size_t)tok * 16, lane);
        }
    }
}
DEV void phase_pi(const P& p, int layer, unsigned char* lds) {
    const int tid = threadIdx.x, lane = tid & 63, wid = tid >> 6, gw = blockIdx.x * 4 + wid;
    const float* MOD = (const float*)(p.ws + WS_MOD);
    const bf16_t* ML = (const bf16_t*)(p.ws + WS_ML);
    float* XC = (float*)(p.ws + WS_XC);
    bf16_t* H = (bf16_t*)(p.ws + WS_H);
    unsigned* TOPK = (unsigned*)(p.ws + WS_TOPK);
    uint2* LIST = (uint2*)(p.ws + WS_LIST);
    unsigned* cnt = (unsigned*)(p.ws + WS_CTL) + CW_CNT + layer * 128;
    float* hl = (float*)lds + wid * 4096;
    const int nt = (layer == 0) ? TT : TL;
    const float* rw = p.router_w + (size_t)layer * DM * NEXP;
    const float rbias = p.router_bias[layer * NEXP + lane];
    __syncthreads();
    for (int grp = gw; grp < nt / 4; grp += NWAVE_TOT) {
        for (int rr = 0; rr < 4; ++rr) {
            const int tok = grp * 4 + rr;
            const float* xin = (layer == 0) ? (tok < TL ? p.x + (size_t)tok * DM : p.ctx + (size_t)(tok - TL) * DM)
                                            : (tok < TL ? p.out + (size_t)tok * DM : XC + (size_t)(tok - TL) * DM);
            float* xout = tok < TL ? p.out + (size_t)tok * DM : XC + (size_t)(tok - TL) * DM;
            const int mr = tok < TL ? tok / SEQ : 8;
            const float* md = MOD + ((size_t)layer * 9 + mr) * 6144;
            float x[16], y[16], h[16];
            ld_row16(xin, lane, x); ld_row16_bf(ML + (size_t)tok * DM, lane, y);
            resid_update(x, y, md + 2048, p.g_post_mix + layer * DM, lane);
            st_row16(xout, lane, x);
            norm_mod(x, h, p.g_pre_ffn + layer * DM, md + 3072, md + 4096, lane);
            st_row16_bf(H + (size_t)tok * DM, lane, h);
            st_row16(hl + rr * 1024, lane, h);
        }
        float lg[4] = {0.f, 0.f, 0.f, 0.f};
        for (int k = 0; k < DM; k += 4) {
            float w[4];
#pragma unroll
            for (int q = 0; q < 4; ++q) w[q] = rw[(size_t)(k + q) * NEXP + lane];
#pragma unroll
            for (int rr = 0; rr < 4; ++rr) {
                const float4 hv = *(const float4*)(hl + rr * 1024 + k);
                lg[rr] += hv.x * w[0]; lg[rr] += hv.y * w[1]; lg[rr] += hv.z * w[2]; lg[rr] += hv.w * w[3];
            }
        }
#pragma unroll
        for (int rr = 0; rr < 4; ++rr) {
            const int tok = grp * 4 + rr;
            const float score = sigmoid_f(lg[rr]), choice = score + rbias;
            int grank = 0;
#pragma unroll
            for (int t = 0; t < 8; ++t) { const int j = (lane & ~7) + t; const float v = __shfl(choice, j); grank += (v > choice || (v == choice && j < lane)) ? 1 : 0; }
            float gs = grank < 2 ? choice : 0.f;
            gs += __shfl_xor(gs, 1); gs += __shfl_xor(gs, 2); gs += __shfl_xor(gs, 4);
            int gr = 0;
#pragma unroll
            for (int t = 0; t < 8; ++t) { const float v = __shfl(gs, t * 8); gr += (v > gs || (v == gs && t < (lane >> 3))) ? 1 : 0; }
            const bool ok = gr < 4;
            const float m = ok ? choice : -INFINITY;
            int rank = 0;
            for (int j = 0; j < 64; ++j) { const float v = __shfl(m, j); rank += (v > m || (v == m && j < lane)) ? 1 : 0; }
            const bool sel = ok && rank < 8;
            const float wsum = wave_sum(sel ? score : 0.f);
            const unsigned long long bal = __ballot(sel);
            if (sel) {
                const float gate = score / wsum * 2.5f;
                const int pos = __popcll(bal & ((1ull << lane) - 1ull));
                const unsigned rk = atomicAdd(&cnt[lane], 1u);
                LIST[(size_t)lane * CAP + rk] = make_uint2((unsigned)tok, __builtin_bit_cast(unsigned, gate));
                TOPK[(size_t)tok * 8 + pos] = (unsigned)lane | (rk << 8);
            }
        }
    }
}

DEV void phase_pb(const P& p, unsigned char* lds) {
    const bf16_t* H = (const bf16_t*)(p.ws + WS_H); const bf16_t* WIN = (const bf16_t*)(p.ws + WS_WIN); bf16_t* O = (bf16_t*)(p.ws + WS_QKVZX);
    constexpr int NTN = NIN / 128;
    for (int u = blockIdx.x; u < (TT / 128) * NTN; u += gridDim.x) {
        const int tm = u / NTN, tn = u % NTN;
        LdRows al{H, DM, tm * 128, TT}, bl{WIN, DM, tn * 128, NIN};
        EpStoreBf16 ep{O, NIN, tm * 128, tn * 128, TT};
        gemm_tile<128>(lds, DM / 64, al, bl, ep);
    }
}

DEV void store_transposed(unsigned char* lds, const float (*v)[8], bf16_t* dst, size_t stride) {
    bf16_t* t = (bf16_t*)lds;
    const int tid = threadIdx.x;
    __syncthreads();
#pragma unroll
    for (int i = 0; i < 4; ++i) *(uint4*)(t + ((tid >> 3) + 32 * i) * 72 + (tid & 7) * 8) = pack8(v[i]);
    __syncthreads();
    const int c = tid >> 2, sp = (tid & 3) * 32;
#pragma unroll
    for (int jj = 0; jj < 4; ++jj) {
        unsigned w[4];
#pragma unroll
        for (int e = 0; e < 4; ++e) w[e] = (unsigned)t[(sp + jj * 8 + 2 * e) * 72 + c] | ((unsigned)t[(sp + jj * 8 + 2 * e + 1) * 72 + c] << 16);
        *(uint4*)(dst + (size_t)c * stride + sp + jj * 8) = make_uint4(w[0], w[1], w[2], w[3]);
    }
}
DEV void phase_pc(const P& p, int layer, unsigned char* lds) {
    const bf16_t* QK = (const bf16_t*)(p.ws + WS_QKVZX);
    bf16_t* QP = (bf16_t*)(p.ws + WS_QP); bf16_t* KP = (bf16_t*)(p.ws + WS_KP); bf16_t* VT = (bf16_t*)(p.ws + WS_VT);
    bf16_t* XT = (bf16_t*)(p.ws + WS_XT); bf16_t* BT = (bf16_t*)(p.ws + WS_BT); bf16_t* BC = (bf16_t*)(p.ws + WS_BC);
    const float2* ROPE = (const float2*)(p.ws + WS_ROPE);
    const float* DT = (const float*)(p.ws + WS_DT);
    float* CUM = (float*)(p.ws + WS_CUM); float* WST = (float*)(p.ws + WS_WST); float* DTT = (float*)(p.ws + WS_DTT); float* TOT = (float*)(p.ws + WS_TOT);
    const int tid = threadIdx.x, c8 = (tid & 7) * 8, s0 = tid >> 3;
    for (int u = blockIdx.x; u < NCH * 29; u += gridDim.x) {
        const int ch = u / 29, sub = u % 29;
        const bool lat = ch < NCHL;
        const int tok0 = ch * 128;
        const int pos0 = lat ? (ch & 15) * 128 : ((ch - NCHL) & 1) * 128;
        const int slen = lat ? SEQ : LC;
        if (sub < 16) {
            const int cg = sub, cc = cg * 64 + c8;
            float w0[8], w1[8], w2[8], bb[8];
#pragma unroll
            for (int e = 0; e < 8; ++e) { w0[e] = p.conv_w[(layer * 3 + 0) * 1024 + cc + e]; w1[e] = p.conv_w[(layer * 3 + 1) * 1024 + cc + e]; w2[e] = p.conv_w[(layer * 3 + 2) * 1024 + cc + e]; bb[e] = p.conv_b[layer * 1024 + cc + e]; }
            float o[4][8];
#pragma unroll
            for (int i = 0; i < 4; ++i) {
                const int s = s0 + 32 * i, pos = pos0 + s;
                const bf16_t* src = QK + (size_t)(tok0 + s) * NIN + C_X + cc;
                float a[8], b[8], c[8];
                unpack8(*(const uint4*)src, b);
                if (pos > 0) unpack8(*(const uint4*)(src - NIN), a); else {
#pragma unroll
                    for (int e = 0; e < 8; ++e) a[e] = 0.f; }
                if (pos < slen - 1) unpack8(*(const uint4*)(src + NIN), c); else {
#pragma unroll
                    for (int e = 0; e < 8; ++e) c[e] = 0.f; }
#pragma unroll
                for (int e = 0; e < 8; ++e) o[i][e] = silu_f(bb[e] + w0[e] * a[e] + w1[e] * b[e] + w2[e] * c[e]);
                if (cg >= 8) *(uint4*)(BC + (size_t)(tok0 + s) * 512 + (cc - 512)) = pack8(o[i]);
            }
            if (cg < 8) store_transposed(lds, o, XT + ((size_t)ch * 8 + cg) * 64 * 128, 128);
            else if (cg < 12) store_transposed(lds, o, BT + (((size_t)ch * 2 + ((cg - 8) >> 1)) * 128 + ((cg - 8) & 1) * 64) * 128, 128);
        } else if (sub < 28) {
            const int hs = sub - 16;
            const int col = hs < 8 ? C_Q + hs * 64 : (hs < 10 ? C_K + (hs - 8) * 64 : C_V + (hs - 10) * 64);
            float o[4][8];
#pragma unroll
            for (int i = 0; i < 4; ++i) {
                const int s = s0 + 32 * i;
                unpack8(*(const uint4*)(QK + (size_t)(tok0 + s) * NIN + col + c8), o[i]);
                if (hs < 10) {
                    float ss = 0.f;
#pragma unroll
                    for (int e = 0; e < 8; ++e) ss += o[i][e] * o[i][e];
                    ss += __shfl_xor(ss, 1); ss += __shfl_xor(ss, 2); ss += __shfl_xor(ss, 4);
                    const float rs = rsqrtf(ss * (1.f / 64.f) + EPS);
                    const float* g = (hs < 8 ? p.q_norm : p.k_norm) + layer * 64 + c8;
#pragma unroll
                    for (int e = 0; e < 8; ++e) o[i][e] = o[i][e] * rs * g[e];
                    if (lat) {
                        const int pos = pos0 + s, half = (tid & 7) >> 2;
                        const float2* rp = ROPE + (size_t)pos * 32 + (c8 & 31);
#pragma unroll
                        for (int e = 0; e < 8; ++e) {
                            const float other = __shfl_xor(o[i][e], 4);
                            const float2 cs = rp[e];
                            o[i][e] = half ? (other * cs.y + o[i][e] * cs.x) : (o[i][e] * cs.x - other * cs.y);
                        }
                    }
                    if (hs < 8) {
#pragma unroll
                        for (int e = 0; e < 8; ++e) o[i][e] *= QSCALE;
                        *(uint4*)(QP + (size_t)(tok0 + s) * 512 + hs * 64 + c8) = pack8(o[i]);
                    } else *(uint4*)(KP + (size_t)(tok0 + s) * 128 + (hs - 8) * 64 + c8) = pack8(o[i]);
                }
            }
            if (hs >= 10) {
                const int b = lat ? ch >> 4 : (ch - NCHL) >> 1;
                const int kp0 = lat ? LC + pos0 : pos0;
                store_transposed(lds, o, VT + ((size_t)(b * 2 + (hs - 10)) * 64) * NKEY + kp0, NKEY);
            }
        } else {
            float* la = (float*)lds;
            __syncthreads();
            for (int i = tid; i < 16 * 128; i += 256) {
                const int j = i >> 7, s = i & 127;
                const float dt = DT[(size_t)(tok0 + s) * 16 + j];
                DTT[((size_t)ch * 16 + j) * 128 + s] = dt;
                la[i] = dt * (-__expf(p.a_log[layer * 16 + j]));
            }
            __syncthreads();
            if (tid < 16) {
                float run = 0.f;
                if (tid < 8) { for (int s = 0; s < 128; ++s) { run += la[tid * 128 + s]; la[tid * 128 + s] = run; } }
                else { for (int s = 0; s < 128; ++s) { const float v = la[tid * 128 + s]; la[tid * 128 + s] = run; run += v; } }
                TOT[ch * 16 + tid] = run;
                la[16 * 128 + tid] = run;
            }
            __syncthreads();
            for (int i = tid; i < 16 * 128; i += 256) {
                const int j = i >> 7, s = i & 127;
                const float cu = la[i], tot = la[16 * 128 + j];
                const float dt = DT[(size_t)(tok0 + s) * 16 + j];
                CUM[((size_t)ch * 16 + j) * 128 + s] = cu;
                WST[((size_t)ch * 16 + j) * 128 + s] = dt * (j < 8 ? __expf(tot - cu) : __expf(cu));
            }
        }
    }
}

struct LdXTw {
    const bf16_t* xt; const float* w;
    DEV uint4 load(int i, int r, int kcg) const {
        float f[8]; unpack8(*(const uint4*)(xt + (size_t)r * 128 + kcg * 8), f);
        const float* wp = w + (r >> 6) * 128 + kcg * 8;
        const float4 a = *(const float4*)wp, b = *(const float4*)(wp + 4);
        f[0] *= a.x; f[1] *= a.y; f[2] *= a.z; f[3] *= a.w; f[4] *= b.x; f[5] *= b.y; f[6] *= b.z; f[7] *= b.w;
        return pack8(f);
    }
};
struct EpStoreF32 {
    float* O; size_t ld;
    DEV void operator()(const float* ct, int tid) const {
#pragma unroll
        for (int i = 0; i < 8; ++i) {
            const int id = tid + 256 * i, r = id >> 4, c8 = id & 15;
            *(float4*)(O + (size_t)r * ld + c8 * 8) = *(const float4*)(ct + r * 128 + c8 * 8);
            *(float4*)(O + (size_t)r * ld + c8 * 8 + 4) = *(const float4*)(ct + r * 128 + c8 * 8 + 4);
        }
    }
};
DEV void phase_pd(const P& p, unsigned char* lds) {
    const bf16_t* XT = (const bf16_t*)(p.ws + WS_XT); const bf16_t* BT = (const bf16_t*)(p.ws + WS_BT); const bf16_t* BC = (const bf16_t*)(p.ws + WS_BC);
    const float* WST = (const float*)(p.ws + WS_WST);
    bf16_t* SST = (bf16_t*)(p.ws + WS_SST); float* CB = (float*)(p.ws + WS_CB);
    for (int u = blockIdx.x; u < NCH * 10; u += gridDim.x) {
        const int ch = u / 10, sub = u % 10;
        if (sub < 8) {
            const int dir = sub >> 2, hp = sub & 3, h0 = hp * 2, g = hp >> 1;
            LdXTw al{XT + ((size_t)ch * 8 + h0) * 64 * 128, WST + ((size_t)ch * 16 + dir * 8 + h0) * 128};
            LdRows bl{BT + ((size_t)ch * 2 + g) * 128 * 128, 128, 0, 128};
            EpStoreBf16 ep{SST + (((size_t)ch * 2 + dir) * 8 + h0) * 64 * 128, 128, 0, 0, 128};
            gemm_tile<128>(lds, 2, al, bl, ep);
        } else {
            const int g = sub - 8;
            LdRows al{BC + (size_t)ch * 128 * 512 + 256 + g * 128, 512, 0, 128}, bl{BC + (size_t)ch * 128 * 512 + g * 128, 512, 0, 128};
            EpStoreF32 ep{CB + ((size_t)ch * 2 + g) * 128 * 128, 128};
            gemm_tile<128>(lds, 2, al, bl, ep);
        }
    }
}
DEV void phase_pe(const P& p) {
    bf16_t* SST = (bf16_t*)(p.ws + WS_SST); const float* TOT = (const float*)(p.ws + WS_TOT);
    for (int gid = blockIdx.x * 256 + threadIdx.x; gid < NB * 2 * 8 * 64 * 16; gid += gridDim.x * 256) {
        const int n8 = gid & 15, pp = (gid >> 4) & 63, h = (gid >> 10) & 7, dir = (gid >> 13) & 1, b = gid >> 14;
        float run[8];
#pragma unroll
        for (int e = 0; e < 8; ++e) run[e] = 0.f;
        for (int st = 0; st < 18; ++st) {
            int ch;
            if (dir == 0) ch = st < 2 ? NCHL + b * 2 + st : b * 16 + (st - 2);
            else ch = st < 2 ? NCHL + b * 2 + (1 - st) : b * 16 + (17 - st);
            bf16_t* ptr = SST + ((((size_t)ch * 2 + dir) * 8 + h) * 64 + pp) * 128 + n8 * 8;
            float loc[8]; unpack8(*(const uint4*)ptr, loc);
            *(uint4*)ptr = pack8(run);
            const float d = __expf(TOT[ch * 16 + dir * 8 + h]);
#pragma unroll
            for (int e = 0; e < 8; ++e) run[e] = d * run[e] + loc[e];
        }
    }
}
struct LdG {
    const float* cb; const bf16_t* cm; const float* cumf; const float* cumb; const float* dtf; const float* dtb; float totb, dsk;
    DEV uint4 load(int i, int r, int kcg) const {
        const int seg = kcg >> 4, kk = (kcg & 15) * 8;
        float f[8];
        if (seg == 0 || seg == 2) {
            const float4 a = *(const float4*)(cb + (size_t)r * 128 + kk), b = *(const float4*)(cb + (size_t)r * 128 + kk + 4);
            const float cbv[8] = {a.x, a.y, a.z, a.w, b.x, b.y, b.z, b.w};
            const float* cu = seg == 0 ? cumf : cumb; const float* dt = seg == 0 ? dtf : dtb;
            const float cl = cu[r];
#pragma unroll
            for (int e = 0; e < 8; ++e) {
                const int s = kk + e;
                const bool on = seg == 0 ? (s <= r) : (s >= r);
                const float ex = seg == 0 ? __expf(cl - cu[s]) : __expf(cu[s] - cl);
                float v = on ? cbv[e] * ex * dt[s] : 0.f;
                if (seg == 0 && s == r) v += dsk;
                f[e] = v;
            }
        } else {
            unpack8(*(const uint4*)(cm + (size_t)r * 512 + kk), f);
            const float sc = seg == 1 ? __expf(cumf[r]) : __expf(totb - cumb[r]);
#pragma unroll
            for (int e = 0; e < 8; ++e) f[e] *= sc;
        }
        return pack8(f);
    }
};
struct LdXS {
    const bf16_t* xt; const bf16_t* sf; const bf16_t* sb;
    DEV uint4 load(int i, int r, int kcg) const {
        const int seg = kcg >> 4, kk = (kcg & 15) * 8;
        const bf16_t* base = (seg == 1) ? sf : (seg == 3 ? sb : xt);
        return *(const uint4*)(base + (size_t)r * 128 + kk);
    }
};
struct EpSsd {
    const bf16_t* z; bf16_t* o; float* ssq;
    DEV void operator()(const float* ct, int tid) const {
#pragma unroll
        for (int i = 0; i < 4; ++i) {
            const int id = tid + 256 * i, r = id >> 3, c8 = id & 7;
            float v[8], zz[8]; ld8f(ct, r * 64 + c8 * 8, v);
            unpack8(*(const uint4*)(z + (size_t)r * NIN + c8 * 8), zz);
            float ss = 0.f;
#pragma unroll
            for (int e = 0; e < 8; ++e) { v[e] *= silu_f(zz[e]); ss += v[e] * v[e]; }
            *(uint4*)(o + (size_t)r * DM + c8 * 8) = pack8(v);
            ss += __shfl_xor(ss, 1); ss += __shfl_xor(ss, 2); ss += __shfl_xor(ss, 4);
            if (c8 == 0) ssq[(size_t)r * 8] = ss;
        }
    }
};
DEV void phase_pf(const P& p, int layer, unsigned char* lds) {
    const bf16_t* XT = (const bf16_t*)(p.ws + WS_XT); const bf16_t* BC = (const bf16_t*)(p.ws + WS_BC); const bf16_t* SST = (const bf16_t*)(p.ws + WS_SST);
    const float* CB = (const float*)(p.ws + WS_CB); const float* CUM = (const float*)(p.ws + WS_CUM); const float* DTT = (const float*)(p.ws + WS_DTT); const float* TOT = (const float*)(p.ws + WS_TOT);
    const bf16_t* QK = (const bf16_t*)(p.ws + WS_QKVZX); bf16_t* AS = (bf16_t*)(p.ws + WS_AS); float* SSQ = (float*)(p.ws + WS_SSQ);
    const int nch = (layer == 0) ? NCH : NCHL;
    for (int u = blockIdx.x; u < nch * 8; u += gridDim.x) {
        const int ch = u >> 3, h = u & 7, g = h >> 2, tok0 = ch * 128;
        LdG al{CB + ((size_t)ch * 2 + g) * 128 * 128, BC + (size_t)tok0 * 512 + 256 + g * 128, CUM + ((size_t)ch * 16 + h) * 128, CUM + ((size_t)ch * 16 + 8 + h) * 128,
               DTT + ((size_t)ch * 16 + h) * 128, DTT + ((size_t)ch * 16 + 8 + h) * 128, TOT[ch * 16 + 8 + h], p.d_skip[layer * 8 + h]};
        LdXS bl{XT + ((size_t)ch * 8 + h) * 64 * 128, SST + (((size_t)ch * 2 + 0) * 8 + h) * 64 * 128, SST + (((size_t)ch * 2 + 1) * 8 + h) * 64 * 128};
        EpSsd ep{QK + (size_t)tok0 * NIN + C_Z + h * 64, AS + (size_t)tok0 * DM + 512 + h * 64, SSQ + (size_t)tok0 * 8 + h};
        gemm_tile<64>(lds, 8, al, bl, ep);
    }
}

DEV void phase_pg(const P& p, int layer) {
    const bf16_t* QP = (const bf16_t*)(p.ws + WS_QP); const bf16_t* KP = (const bf16_t*)(p.ws + WS_KP); const bf16_t* QK = (const bf16_t*)(p.ws + WS_QKVZX);
    bf16_t* AS = (bf16_t*)(p.ws + WS_AS);
    const int nu = (layer == 0) ? 512 + 64 : 512;
    for (int u = blockIdx.x; u < nu; u += gridDim.x) {
        const bool lat = u < 512;
        const int uu = lat ? u : u - 512;
        const int b = lat ? uu >> 6 : uu >> 3, hq = lat ? (uu >> 3) & 7 : uu & 7, qb = lat ? uu & 7 : 0, kvh = hq >> 2;
        const int tok = lat ? b * SEQ + qb * 256 + threadIdx.x : TL + b * LC + threadIdx.x;
        const int nkeys = lat ? NKEY : LC;
        float q[64], o[64];
#pragma unroll
        for (int c = 0; c < 8; ++c) unpack8(*(const uint4*)(QP + (size_t)tok * 512 + hq * 64 + c * 8), q + c * 8);
#pragma unroll
        for (int d = 0; d < 64; ++d) o[d] = 0.f;
        float m = -1e30f, l = 0.f;
        for (int j = 0; j < nkeys; ++j) {
            const int kt = j < LC ? TL + b * LC + j : b * SEQ + (j - LC);
            const bf16_t* kr = KP + (size_t)kt * 128 + kvh * 64;
            float s = 0.f;
#pragma unroll
            for (int c = 0; c < 8; ++c) { float kf[8]; unpack8(*(const uint4*)(kr + c * 8), kf);
#pragma unroll
                for (int e = 0; e < 8; ++e) s += q[c * 8 + e] * kf[e]; }
            const float mn = fmaxf(m, s), al = exp2f(m - mn), pe = exp2f(s - mn);
            l = l * al + pe; m = mn;
            const bf16_t* vr = QK + (size_t)kt * NIN + C_V + kvh * 64;
#pragma unroll
            for (int c = 0; c < 8; ++c) { float vf[8]; unpack8(*(const uint4*)(vr + c * 8), vf);
#pragma unroll
                for (int e = 0; e < 8; ++e) o[c * 8 + e] = o[c * 8 + e] * al + pe * vf[e]; }
        }
        const float il = 1.f / l;
#pragma unroll
        for (int c = 0; c < 8; ++c) { float t[8];
#pragma unroll
            for (int e = 0; e < 8; ++e) t[e] = o[c * 8 + e] * il;
            *(uint4*)(AS + (size_t)tok * DM + hq * 64 + c * 8) = pack8(t); }
    }
}

struct LdAS {
    const bf16_t* as; const float* ssq; const float* gn; int row0; float rs[4];
    DEV void init(int r0) {
#pragma unroll
        for (int i = 0; i < 4; ++i) { const float* q = ssq + (size_t)(row0 + r0 + 32 * i) * 8; const float4 a = *(const float4*)q, b = *(const float4*)(q + 4);
            rs[i] = rsqrtf((((a.x + a.y) + (a.z + a.w)) + ((b.x + b.y) + (b.z + b.w))) * (1.f / 512.f) + EPS); }
    }
    DEV uint4 load(int i, int r, int kcg) const {
        const uint4 q = *(const uint4*)(as + (size_t)(row0 + r) * DM + kcg * 8);
        if (kcg < 64) return q;
        float f[8]; unpack8(q, f);
        const float* g = gn + (kcg - 64) * 8;
#pragma unroll
        for (int e = 0; e < 8; ++e) f[e] *= rs[i] * g[e];
        return pack8(f);
    }
};
DEV void phase_ph(const P& p, int layer, unsigned char* lds) {
    const bf16_t* AS = (const bf16_t*)(p.ws + WS_AS); const bf16_t* WOUT = (const bf16_t*)(p.ws + WS_WOUT); bf16_t* ML = (bf16_t*)(p.ws + WS_ML);
    const float* SSQ = (const float*)(p.ws + WS_SSQ);
    const int nt = (layer == 0) ? TT : TL;
    for (int u = blockIdx.x; u < (nt / 128) * 8; u += gridDim.x) {
        const int tm = u >> 3, tn = u & 7;
        LdAS al{AS, SSQ, p.ssd_norm + layer * 512, tm * 128, {0.f, 0.f, 0.f, 0.f}}; al.init(threadIdx.x >> 3);
        LdRows bl{WOUT, DM, tn * 128, DM};
        EpStoreBf16 ep{ML, DM, tm * 128, tn * 128, nt};
        gemm_tile<128>(lds, DM / 64, al, bl, ep);
    }
}

struct MoeMap { int offs[66]; int tp[66]; };
DEV void build_map(const P& p, int layer, MoeMap* mm) {
    const unsigned* cnt = (const unsigned*)(p.ws + WS_CTL) + CW_CNT + layer * 128;
    const int nt = (layer == 0) ? TT : TL;
    __syncthreads();
    if (threadIdx.x == 0) {
        int o = 0, t = 0;
        for (int e = 0; e < 65; ++e) {
            const int c = e < 64 ? (int)__hip_atomic_load(&cnt[e], __ATOMIC_RELAXED, __HIP_MEMORY_SCOPE_AGENT) : nt;
            mm->offs[e] = o; mm->tp[e] = t; o += c; t += (c + 127) >> 7;
        }
        mm->offs[65] = o; mm->tp[65] = t;
    }
    __syncthreads();
}
DEV int find_expert(const MoeMap* mm, int ti) { int e = 0; while (e < 64 && mm->tp[e + 1] <= ti) ++e; return e; }

struct LdGather {
    const bf16_t* H; int tok[4];
    DEV uint4 load(int i, int, int kcg) const { if (tok[i] < 0) return make_uint4(0, 0, 0, 0); return *(const uint4*)(H + (size_t)tok[i] * DM + kcg * 8); }
};
struct LdGU {
    const bf16_t* wg; const bf16_t* wu;
    DEV uint4 load(int, int r, int kcg) const { const bf16_t* b = r < 64 ? wg + (size_t)r * DM : wu + (size_t)(r - 64) * DM; return *(const uint4*)(b + kcg * 8); }
};
struct EpAct {
    bf16_t* act; const uint2* list; int nvalid;
    DEV void operator()(const float* ct, int tid) const {
#pragma unroll
        for (int i = 0; i < 4; ++i) {
            const int id = tid + 256 * i, r = id >> 3, c8 = id & 7;
            if (r < nvalid) {
                float g[8], u[8]; ld8f(ct, r * 128 + c8 * 8, g); ld8f(ct, r * 128 + 64 + c8 * 8, u);
                const float gate = list ? __builtin_bit_cast(float, list[r].y) : 1.f;
#pragma unroll
                for (int e = 0; e < 8; ++e) g[e] = silu_f(g[e]) * u[e] * gate;
                *(uint4*)(act + (size_t)r * FE + c8 * 8) = pack8(g);
            }
        }
    }
};
DEV void phase_pj(const P& p, int layer, unsigned char* lds, MoeMap* mm) {
    const bf16_t* H = (const bf16_t*)(p.ws + WS_H); const bf16_t* WG = (const bf16_t*)(p.ws + WS_WG); const bf16_t* WU = (const bf16_t*)(p.ws + WS_WU);
    bf16_t* ACT = (bf16_t*)(p.ws + WS_ACT); const uint2* LIST = (const uint2*)(p.ws + WS_LIST);
    build_map(p, layer, mm);
    const int ntile = mm->tp[65];
    for (int u = blockIdx.x; u < ntile * 4; u += gridDim.x) {
        const int ti = u >> 2, fq = u & 3, e = find_expert(mm, ti), tt = ti - mm->tp[e];
        const int cnt_e = mm->offs[e + 1] - mm->offs[e], nvalid = min(128, cnt_e - tt * 128);
        LdGather al; al.H = H;
#pragma unroll
        for (int i = 0; i < 4; ++i) { const int r = (threadIdx.x >> 3) + 32 * i; al.tok[i] = r < nvalid ? (e < 64 ? (int)LIST[(size_t)e * CAP + tt * 128 + r].x : tt * 128 + r) : -1; }
        LdGU bl{WG + ((size_t)e * FE + fq * 64) * DM, WU + ((size_t)e * FE + fq * 64) * DM};
        EpAct ep{ACT + (size_t)(mm->offs[e] + tt * 128) * FE + fq * 64, e < 64 ? LIST + (size_t)e * CAP + tt * 128 : nullptr, nvalid};
        gemm_tile<128>(lds, DM / 64, al, bl, ep);
    }
}
DEV void phase_pk(const P& p, int layer, int hf, unsigned char* lds, MoeMap* mm) {
    const bf16_t* ACT = (const bf16_t*)(p.ws + WS_ACT); const bf16_t* WD = (const bf16_t*)(p.ws + WS_WD); bf16_t* YH = (bf16_t*)(p.ws + WS_YH);
    build_map(p, layer, mm);
    const int ntile = mm->tp[65];
    for (int u = blockIdx.x; u < ntile * 4; u += gridDim.x) {
        const int ti = u >> 2, nt4 = u & 3, e = find_expert(mm, ti), tt = ti - mm->tp[e];
        const int cnt_e = mm->offs[e + 1] - mm->offs[e], nvalid = min(128, cnt_e - tt * 128), slot0 = mm->offs[e] + tt * 128;
        LdRows al{ACT + (size_t)slot0 * FE, FE, 0, nvalid};
        LdRows bl{WD + ((size_t)e * DM + hf * 512 + nt4 * 128) * FE, FE, 0, 128};
        EpStoreBf16 ep{YH + (size_t)slot0 * 512, 512, 0, nt4 * 128, nvalid};
        gemm_tile<128>(lds, FE / 64, al, bl, ep);
    }
}
DEV void phase_pl(const P& p, int layer, int hf, MoeMap* mm) {
    const bf16_t* YH = (const bf16_t*)(p.ws + WS_YH); const unsigned* TOPK = (const unsigned*)(p.ws + WS_TOPK); float* MO = (float*)(p.ws + WS_MO);
    build_map(p, layer, mm);
    const int lane = threadIdx.x & 63, gw = blockIdx.x * 4 + (threadIdx.x >> 6);
    const int nt = (layer == 0) ? TT : TL;
    for (int tok = gw; tok < nt; tok += NWAVE_TOT) {
        float a[8];
#pragma unroll
        for (int e = 0; e < 8; ++e) a[e] = 0.f;
#pragma unroll
        for (int k = 0; k < 9; ++k) {
            int slot;
            if (k < 8) { const unsigned tk = TOPK[(size_t)tok * 8 + k]; slot = mm->offs[tk & 255u] + (int)(tk >> 8); } else slot = mm->offs[64] + tok;
            float f[8]; unpack8(*(const uint4*)(YH + (size_t)slot * 512 + lane * 8), f);
#pragma unroll
            for (int e = 0; e < 8; ++e) a[e] += f[e];
        }
        float* o = MO + (size_t)tok * DM + hf * 512 + lane * 8;
        *(float4*)o = make_float4(a[0], a[1], a[2], a[3]); *(float4*)(o + 4) = make_float4(a[4], a[5], a[6], a[7]);
    }
}

constexpr int LDS_MAIN = 65536, LDS_BYTES = LDS_MAIN + 1024;
enum { K_P0 = 0, K_PA0, K_PB, K_PC, K_PDG, K_PE, K_PF, K_PH, K_PI, K_PJ, K_PK0, K_PL0, K_PK1, K_PL1, K_PM };
template <int PH> __global__ void __launch_bounds__(NTHR, 2) k_phase(P p, int layer) {
    extern __shared__ __attribute__((aligned(16))) unsigned char smem[];
    MoeMap* mm = (MoeMap*)(smem + LDS_MAIN);
    if (PH == K_P0) phase_p0(p, layer, smem);
    if (PH == K_PA0) phase_pa0(p, smem);
    if (PH == K_PB) phase_pb(p, smem);
    if (PH == K_PC) phase_pc(p, layer, smem);
    if (PH == K_PDG) { phase_pd(p, smem); phase_pg(p, layer); }
    if (PH == K_PE) phase_pe(p);
    if (PH == K_PF) phase_pf(p, layer, smem);
    if (PH == K_PH) phase_ph(p, layer, smem);
    if (PH == K_PI) phase_pi(p, layer, smem);
    if (PH == K_PJ) phase_pj(p, layer, smem, mm);
    if (PH == K_PK0) phase_pk(p, layer, 0, smem, mm);
    if (PH == K_PL0) phase_pl(p, layer, 0, mm);
    if (PH == K_PK1) phase_pk(p, layer, 1, smem, mm);
    if (PH == K_PL1) phase_pl(p, layer, 1, mm);
    if (PH == K_PM) { phase_pm(p, layer, smem); if (layer == 0) phase_p0(p, 1, smem); }
}
template <int PH> static void launch(const P& p, int layer, hipStream_t s) {
    static bool attr = false;
    if (!attr) { hipFuncSetAttribute((const void*)k_phase<PH>, hipFuncAttributeMaxDynamicSharedMemorySize, LDS_BYTES); attr = true; }
    hipLaunchKernelGGL((k_phase<PH>), dim3(GRID), dim3(NTHR), LDS_BYTES, s, p, layer);
}

extern "C" void kernel_launch(void* const* d_in, const int* in_sizes, int n_in, void* d_out, int out_size, void* d_ws, size_t ws_size, hipStream_t stream) {
    if (ws_size < WS_END) { fprintf(stderr, "workspace too small: %zu < %zu\n", ws_size, (size_t)WS_END); return; }
    P p{};
    const float** pp = (const float**)&p;
    for (int i = 0; i < 28; ++i) pp[i] = (const float*)d_in[i];
    p.out = (float*)d_out; p.ws = (unsigned char*)d_ws;
    hipMemsetAsync(d_ws, 0, CTL_BYTES, stream);
    launch<K_P0>(p, 0, stream);
    launch<K_PA0>(p, 0, stream);
    for (int l = 0; l < 2; ++l) {
        launch<K_PB>(p, l, stream);
        launch<K_PC>(p, l, stream);
        launch<K_PDG>(p, l, stream);
        launch<K_PE>(p, l, stream);
        launch<K_PF>(p, l, stream);
        launch<K_PH>(p, l, stream);
        launch<K_PI>(p, l, stream);
        launch<K_PJ>(p, l, stream);
        launch<K_PK0>(p, l, stream);
        launch<K_PL0>(p, l, stream);
        launch<K_PK1>(p, l, stream);
        launch<K_PL1>(p, l, stream);
        launch<K_PM>(p, l, stream);
    }
}
```

```cpp
#include <hip/hip_runtime.h>
#include <stdint.h>
#include <stdio.h>

#define DEV __device__ __forceinline__
typedef unsigned short bf16_t;
typedef short bf16x8 __attribute__((ext_vector_type(8)));
typedef float f32x16 __attribute__((ext_vector_type(16)));
typedef __bf16 bf16x2_t __attribute__((ext_vector_type(2)));
typedef float f32x2_t __attribute__((ext_vector_type(2)));
typedef unsigned u32x4 __attribute__((ext_vector_type(4)));
typedef unsigned u32x2 __attribute__((ext_vector_type(2)));
typedef float f32x4v __attribute__((ext_vector_type(4)));

constexpr int NB = 8, SEQ = 2048, LC = 256, DM = 1024;
constexpr int TL = NB * SEQ, TC = NB * LC, TT = TL + TC;
constexpr int NCH = TT / 128, NCHL = TL / 128;
constexpr int NIN = 2304, NINF = 2320;
constexpr int C_Q = 0, C_K = 512, C_V = 640, C_Z = 768, C_X = 1280;
constexpr int NKEY = LC + SEQ;
constexpr int NEXP = 64, FE = 256, CAP = TT;
constexpr float EPS = 1e-6f;
constexpr float QSCALE = 0.125f * 1.4426950408889634f;
constexpr int NTHR = 512;
#define NWAVE_TOT (vgrid() * 4)

constexpr size_t al256(size_t x) { return (x + 255) & ~(size_t)255; }
constexpr size_t WS_CTL = 0, CTL_BYTES = 65536;
constexpr size_t WS_MOD = WS_CTL + CTL_BYTES;
constexpr size_t WS_ROPE = WS_MOD + al256((size_t)2 * 9 * 6144 * 4);
constexpr size_t WS_RW2 = WS_ROPE + (size_t)2048 * 32 * 8;
constexpr size_t WS_WD2 = WS_RW2 + (size_t)2 * 65536 * 4;
constexpr size_t WS_WIN = WS_WD2 + (size_t)2 * 16384 * 4;
constexpr size_t WS_WOUT = WS_WIN + (size_t)NIN * DM * 2;
constexpr size_t WS_WD = WS_WOUT + (size_t)DM * DM * 2;
constexpr size_t WS_XB = WS_WD + (size_t)65 * FE * DM * 2;
constexpr size_t WS_DT = WS_XB + (size_t)TT * DM * 2;
constexpr size_t WS_TOPK = WS_DT + (size_t)TT * 16 * 4;
constexpr size_t WS_LIST = WS_TOPK + (size_t)TT * 8 * 4;
constexpr size_t WS_CUM = WS_LIST + (size_t)NEXP * CAP * 8;
constexpr size_t WS_WST = WS_CUM + (size_t)NCH * 16 * 128 * 4;
constexpr size_t WS_DTT = WS_WST + (size_t)NCH * 16 * 128 * 4;
constexpr size_t WS_TOT = WS_DTT + (size_t)NCH * 16 * 128 * 4;
constexpr size_t WS_SSQ = WS_TOT + al256((size_t)NCH * 16 * 4);
constexpr size_t WS_ACT = WS_SSQ + (size_t)TT * 8 * 4;
constexpr size_t WS_HIN1 = WS_ACT;
constexpr size_t WS_WG = WS_ACT + (size_t)TT * 9 * FE * 2;
constexpr size_t WS_YH = WS_WG;
constexpr size_t WS_WU = WS_WG + (size_t)65 * FE * DM * 2;
constexpr size_t WS_H = WS_WU + (size_t)65 * FE * DM * 2;
constexpr size_t WS_R1 = WS_H + (size_t)TT * DM * 2;
constexpr size_t WS_QKVZX = WS_R1;
constexpr size_t WS_ML = WS_R1;
constexpr size_t WS_QP = WS_QKVZX + (size_t)TT * NIN * 2;
constexpr size_t WS_KP = WS_QP + (size_t)TT * 512 * 2;
constexpr size_t WS_VT = WS_KP + (size_t)TT * 128 * 2;
constexpr size_t WS_XT = WS_VT + (size_t)NB * 2 * 64 * NKEY * 2;
constexpr size_t WS_BT = WS_XT + (size_t)NCH * 8 * 64 * 128 * 2;
constexpr size_t WS_BC = WS_BT + (size_t)NCH * 2 * 128 * 128 * 2;
constexpr size_t WS_SST = WS_BC + (size_t)TT * 512 * 2;
constexpr size_t WS_CB = WS_SST + (size_t)NCH * 2 * 8 * 64 * 128 * 2;
constexpr size_t WS_AS = WS_CB + (size_t)NCH * 2 * 128 * 128 * 4;
constexpr size_t WS_CF = WS_BC;
constexpr size_t WS_BF = WS_BC + (size_t)NCH * 2 * 128 * 128 * 2;
constexpr size_t WS_R1A_END = WS_AS + (size_t)TT * DM * 2;
constexpr size_t WS_YH_END = WS_YH + (size_t)TT * 9 * DM * 2;
constexpr size_t WS_END = WS_R1A_END > WS_YH_END ? WS_R1A_END : WS_YH_END;
static_assert(WS_END <= (size_t)536 * 1024 * 1024, "workspace map too large");
constexpr float H8_SCALE = 4.f, W8_SCALE = 256.f, GU_DESCALE = 1.f / (H8_SCALE * W8_SCALE);
constexpr float A8_SCALE = 16.f, WD8_SCALE = 128.f, YH8_SCALE = 16.f, DN_RESCALE = YH8_SCALE / (A8_SCALE * WD8_SCALE);
constexpr int CW_CNT = 4096, CNT_STRIDE = 32, CNT_LAYER = 64 * CNT_STRIDE;

struct P {
    const float *x, *c, *ctx, *c_ctx, *w_mod, *b_mod, *g_pre_mix, *g_post_mix, *g_pre_ffn, *g_post_ffn, *w_in, *q_norm, *k_norm, *conv_w, *conv_b,
        *dt_bias, *a_log, *d_skip, *ssd_norm, *w_out, *router_w, *router_bias, *w_gate, *w_up, *w_down, *ws_gate, *ws_up, *ws_down;
    float* out;
    unsigned char* ws;
};

#define LAS __attribute__((address_space(3)))
extern __shared__ __attribute__((aligned(16))) unsigned char smem_all[];
constexpr int LDS_MAIN = 73728, LDS_HALF = LDS_MAIN + 1024, LDS_XB = 2 * LDS_HALF, LDS_PT = LDS_XB + 64, LDS_WT = LDS_PT + 256, LDS_QB = LDS_WT + 256, LDS_BYTES = LDS_QB + 64;
DEV int hw_slot() { return (int)__builtin_amdgcn_s_getreg((5 << 11) | 4) & 63; }
DEV int hw_wave() { return __builtin_amdgcn_readfirstlane(((const LAS int*)(smem_all + LDS_WT))[hw_slot()]); }
DEV int hw_lane() { unsigned z = 0u; asm volatile("" : "+v"(z)); return (int)__builtin_amdgcn_mbcnt_hi(~0u, __builtin_amdgcn_mbcnt_lo(~0u, z)); }
DEV int tid512() { int t = hw_wave() * 64 + hw_lane(); asm volatile("" : "+v"(t)); return t; }
DEV int tidx() { int t = (hw_wave() & 3) * 64 + hw_lane(); asm volatile("" : "+v"(t)); return t; }
DEV int vhalf() { int h = hw_wave() >> 2; asm volatile("" : "+s"(h)); return h; }
DEV int vbid() { return (int)blockIdx.x * 2 + vhalf(); }
DEV int vgrid() { return (int)gridDim.x * 2; }
#define GAS __attribute__((address_space(1)))
DEV unsigned char* wsp(const P& p) { GAS unsigned char* w = (GAS unsigned char*)p.ws; asm volatile("" : "+s"(w)); return (unsigned char*)w; }
DEV unsigned pk2(float lo, float hi) { f32x2_t v = {lo, hi}; bf16x2_t b = __builtin_convertvector(v, bf16x2_t); return __builtin_bit_cast(unsigned, b); }
DEV float bflo(unsigned u) { return __builtin_bit_cast(float, u << 16); }
DEV float bfhi(unsigned u) { return __builtin_bit_cast(float, u & 0xffff0000u); }
DEV void unpack8(uint4 q, float* f) { f[0] = bflo(q.x); f[1] = bfhi(q.x); f[2] = bflo(q.y); f[3] = bfhi(q.y); f[4] = bflo(q.z); f[5] = bfhi(q.z); f[6] = bflo(q.w); f[7] = bfhi(q.w); }
DEV unsigned pk4_f8(float a, float b, float c, float d) {
    a = fminf(fmaxf(a, -448.f), 448.f); b = fminf(fmaxf(b, -448.f), 448.f); c = fminf(fmaxf(c, -448.f), 448.f); d = fminf(fmaxf(d, -448.f), 448.f);
    int w = 0; w = __builtin_amdgcn_cvt_pk_fp8_f32(a, b, w, false); w = __builtin_amdgcn_cvt_pk_fp8_f32(c, d, w, true); return (unsigned)w;
}
DEV uint4 pack8(const float* f) { uint4 q; q.x = pk2(f[0], f[1]); q.y = pk2(f[2], f[3]); q.z = pk2(f[4], f[5]); q.w = pk2(f[6], f[7]); return q; }
DEV float wave_sum(float v) {
#pragma unroll
    for (int o = 32; o > 0; o >>= 1) v += __shfl_xor(v, o);
    return v;
}
DEV float silu_f(float v) { return v / (1.f + __expf(-v)); }
DEV float sigmoid_f(float v) { return 1.f / (1.f + __expf(-v)); }
DEV float softplus_f(float v) { return v > 20.f ? v : log1pf(__expf(v)); }

struct RawV { u32x4 q0, q1, q2; };
template <int BN, int NK, class AL, class BL, class EP>
DEV void gemm_tile(unsigned char* lds, AL& al, BL& bl, EP& ep) {
    constexpr int NT = BN / 64;
    constexpr int NBCH = BN / 32;
    constexpr int A_BYTES = 128 * 128, B_BYTES = BN * 128, STAGE = A_BYTES + B_BYTES;
    const int tid = tidx(), lane = tid & 63, wid = tid >> 6, wr = wid >> 1, wc = wid & 1;
    const int kc = tid & 7, r0 = tid >> 3;
    const int wsw = (kc ^ ((r0 >> 1) & 7)) << 4;
    const int rsw = (lane >> 1) & 7, lr = lane & 31, lh = lane >> 5;
    f32x16 acc[2][NT];
#pragma unroll
    for (int mi = 0; mi < 2; ++mi)
#pragma unroll
        for (int ni = 0; ni < NT; ++ni)
#pragma unroll
            for (int e = 0; e < 16; ++e) acc[mi][ni][e] = 0.f;
    RawV xa[2][4], xb[2][NBCH];
#define GT_RAW(set, ks_) do { _Pragma("unroll") for (int i = 0; i < 4; ++i) xa[set][i] = al.raw(i, r0 + 32 * i, (ks_) * 8 + kc); \
                              _Pragma("unroll") for (int i = 0; i < NBCH; ++i) xb[set][i] = bl.raw(i, r0 + 32 * i, (ks_) * 8 + kc); } while (0)
#define GT_PUT(set, ks_, stg) do { unsigned char* da_ = lds + (stg) * STAGE; \
        _Pragma("unroll") for (int i = 0; i < 4; ++i) *(uint4*)(da_ + (r0 + 32 * i) * 128 + wsw) = al.fin(xa[set][i], i, r0 + 32 * i, (ks_) * 8 + kc); \
        _Pragma("unroll") for (int i = 0; i < NBCH; ++i) *(uint4*)(da_ + A_BYTES + (r0 + 32 * i) * 128 + wsw) = bl.fin(xb[set][i], i, r0 + 32 * i, (ks_) * 8 + kc); } while (0)
    GT_RAW(0, 0);
    if (NK > 1) GT_RAW(1, 1);
    ep.pre(tid);
    __syncthreads();
    GT_PUT(0, 0, 0);
    __syncthreads();
#pragma unroll
    for (int ks = 0; ks < NK; ++ks) {
        const int cur = ks & 1;
        if (ks + 2 < NK) GT_RAW(cur, ks + 2);
        const unsigned char* sa = lds + cur * STAGE;
        const unsigned char* sb = sa + A_BYTES;
#pragma unroll
        for (int kk = 0; kk < 4; ++kk) {
            const int co = ((2 * kk + lh) ^ rsw) << 4;
            bf16x8 fa[2], fb[NT];
#pragma unroll
            for (int mi = 0; mi < 2; ++mi) fa[mi] = *(const bf16x8*)(sa + (wr * 64 + mi * 32 + lr) * 128 + co);
#pragma unroll
            for (int ni = 0; ni < NT; ++ni) fb[ni] = *(const bf16x8*)(sb + (wc * (BN / 2) + ni * 32 + lr) * 128 + co);
#pragma unroll
            for (int mi = 0; mi < 2; ++mi)
#pragma unroll
                for (int ni = 0; ni < NT; ++ni) acc[mi][ni] = __builtin_amdgcn_mfma_f32_32x32x16_bf16(fa[mi], fb[ni], acc[mi][ni], 0, 0, 0);
        }
        if (ks + 1 < NK) GT_PUT(cur ^ 1, ks + 1, cur ^ 1);
        __syncthreads();
    }
#undef GT_RAW
#undef GT_PUT
    float* ct = (float*)lds;
#pragma unroll
    for (int mi = 0; mi < 2; ++mi)
#pragma unroll
        for (int ni = 0; ni < NT; ++ni)
#pragma unroll
            for (int e = 0; e < 16; ++e) {
                const int row = wr * 64 + mi * 32 + (e & 3) + 8 * (e >> 2) + 4 * lh;
                const int col = wc * (BN / 2) + ni * 32 + lr;
                ct[row * (BN + 4) + col] = acc[mi][ni][e];
            }
    __syncthreads();
    ep(ct, tid);
}
DEV void ld8f(const float* ct, int off, float* v) {
    const float4 a = *(const float4*)(ct + off), b = *(const float4*)(ct + off + 4);
    v[0] = a.x; v[1] = a.y; v[2] = a.z; v[3] = a.w; v[4] = b.x; v[5] = b.y; v[6] = b.z; v[7] = b.w;
}

namespace g8 {
typedef float f32x4 __attribute__((ext_vector_type(4)));
constexpr int BM = 256, BK = 64, HALF = 128, HTB = HALF * BK * 2, STAGE_BYTES = 8 * HTB;
DEV int lds_byte(int r, int c) { const int st = (r >> 4) * 2 + (c >> 5), rr = r & 15, cc = c & 31, ob = rr * 64 + cc * 2; return st * 1024 + (ob ^ (((ob >> 9) & 1) << 5)); }
DEV void stage_rc(int b, int& R, int& C) { const int st = b / 1024, sb = b % 1024, swz = sb ^ (((sb >> 9) & 1) << 5); R = (st >> 1) * 16 + swz / 64; C = (st & 1) * 32 + (swz % 64) / 2; }
DEV int perm32(int rho) { const int n = rho >> 4, i = rho & 15; return 8 * (i >> 2) + 4 * n + (i & 3); }
struct Unit { const char* a; const char* b0; const char* b1; const void* aux; int row0, col0, nvalid, sub; };
typedef int i32x8 __attribute__((ext_vector_type(8)));
typedef int i32x4 __attribute__((ext_vector_type(4)));
DEV i32x8 cat8(const bf16x8 a, const bf16x8 b) { return __builtin_shufflevector(__builtin_bit_cast(i32x4, a), __builtin_bit_cast(i32x4, b), 0, 1, 2, 3, 4, 5, 6, 7); }
DEV const char* uni(const char* p) { const unsigned long long v = (unsigned long long)p; const unsigned lo = __builtin_amdgcn_readfirstlane((unsigned)v), hi = __builtin_amdgcn_readfirstlane((unsigned)(v >> 32)); return (const char*)(GAS const char*)(((unsigned long long)hi << 32) | lo); }
template <class Epi, class Sched>
DEV void gemm(LAS unsigned char* lds, const Sched& S, const Epi& E, const int nt  , const int ldb  ) {
    const int tid = tid512(), wid = __builtin_amdgcn_readfirstlane(tid >> 6), lane = tid & 63, wr = wid >> 2, wc = wid & 3, fr = lane & 15, fq = lane >> 4;
    unsigned voffB[2];
#pragma unroll
    for (int i = 0; i < 2; ++i) { int R, C; stage_rc(tid * 16 + i * 8192, R, C); const int Rb = (R & ~31) + perm32(R & 31); voffB[i] = (unsigned)(Rb * ldb + C) * 2u; }
    const size_t kstep = (size_t)(BK * 2);
    const unsigned ldsw = (unsigned)wid * 1024u;
    const int swz = lds_byte(fr, fq * 8); const int aS = wr * 8192, bS = wc * 4096;
    const unsigned pko = (unsigned)tid * 32u;
#define G8_PSLOT(sl) ((LAS u32x4*)(lds + STAGE_BYTES + pko) + (sl))
#define G8_AOFF(dst, sl, half) unsigned dst[2]; { const u32x2 _q = *((const LAS u32x2*)G8_PSLOT(sl) + (half)); dst[0] = _q[0]; dst[1] = _q[1]; }
#define G8_SA(b, h) (((b) * 2 + (h)) * HTB)
#define G8_SB(b, h) ((4 + (b) * 2 + (h)) * HTB)
#define G8_STAGE(bufoff, gbase, voff) do { _Pragma("unroll") for (int _i = 0; _i < 2; ++_i) { unsigned _o = (voff)[_i]; asm volatile("" : "+v"(_o));   \
        __builtin_amdgcn_global_load_lds((const unsigned*)((const char*)(gbase) + _o), (LAS unsigned*)(lds + (bufoff) + ldsw + _i * 8192), 16, 0, 0); } } while (0)
#define G8_LDA(dst, b, h) do { _Pragma("unroll") for (int m = 0; m < 4; ++m) _Pragma("unroll") for (int k = 0; k < 2; ++k) dst[m][k] = *(const LAS bf16x8*)(lds + (G8_SA(b, h) + aS) + swz + m * 2048 + k * 1024); } while (0)
#define G8_LDB(dst, b, h) do { _Pragma("unroll") for (int n = 0; n < 2; ++n) _Pragma("unroll") for (int k = 0; k < 2; ++k) dst[n][k] = *(const LAS bf16x8*)(lds + (G8_SB(b, h) + bS) + swz + n * 2048 + k * 1024); } while (0)
#define G8_MMA(ai, bj, At, Bt) do { __builtin_amdgcn_s_setprio(1); _Pragma("unroll") for (int m = 0; m < 4; ++m) _Pragma("unroll") for (int n = 0; n < 2; ++n) { \
        if constexpr (Sched::F8) acc[ai][bj][m][n] = __builtin_amdgcn_mfma_scale_f32_16x16x128_f8f6f4(cat8(Bt[n][0], Bt[n][1]), cat8(At[m][0], At[m][1]), acc[ai][bj][m][n], 0, 0, 0, 0, 0, 0); \
        else { _Pragma("unroll") for (int k = 0; k < 2; ++k) acc[ai][bj][m][n] = __builtin_amdgcn_mfma_f32_16x16x32_bf16(Bt[n][k], At[m][k], acc[ai][bj][m][n], 0, 0, 0); } } __builtin_amdgcn_s_setprio(0); } while (0)
#define G8_WAIT_V(n) asm volatile("s_waitcnt vmcnt(" #n ")" ::: "memory")
#define G8_WAIT_L(n) asm volatile("s_waitcnt lgkmcnt(" #n ")" ::: "memory")
#define G8_BAR __builtin_amdgcn_s_barrier()
#define G8_SCHED __builtin_amdgcn_sched_barrier(0)
    Unit cur, nxt; int ui = 0;
    if (!S.next(0, cur)) return;
    f32x4 acc[2][2][4][2];
#pragma unroll
    for (int a = 0; a < 2; ++a)
#pragma unroll
        for (int b = 0; b < 2; ++b)
#pragma unroll
            for (int m = 0; m < 4; ++m)
#pragma unroll
                for (int n = 0; n < 2; ++n) acc[a][b][m][n] = (f32x4){0.f, 0.f, 0.f, 0.f};
    bf16x8 At[4][2], B0[2][2], B1[2][2];
    unsigned va0[2], va1x[2];
    S.a_off(cur, va0, va1x);
    unsigned (&va1)[2] = Sched::GATHER ? va1x : va0;
    if constexpr (Sched::GATHER) *G8_PSLOT(0) = (u32x4){va0[0], va0[1], va1x[0], va1x[1]};
    const char* cA0 = uni(cur.a); const char* cA1 = uni(cur.a + S.a_half());
    const char* cB0 = uni(cur.b0); const char* cB1 = uni(cur.b1);
    G8_STAGE(G8_SB(0, 0), cB0, voffB); G8_STAGE(G8_SB(0, 1), cB1, voffB); G8_STAGE(G8_SA(0, 0), cA0, va0); G8_STAGE(G8_SA(0, 1), cA1, va1);
    if (wr == 1) G8_BAR;
    G8_WAIT_V(2); G8_BAR;
    G8_STAGE(G8_SB(1, 0), uni(cB0 + kstep), voffB); G8_STAGE(G8_SA(1, 0), uni(cA0 + kstep), va0); G8_STAGE(G8_SB(1, 1), uni(cB1 + kstep), voffB);
    G8_WAIT_V(6); G8_BAR;
    for (;;) {
        const bool has_next = S.next(ui + 1, nxt);
        if constexpr (Sched::GATHER) {
            if (!has_next) nxt = cur;
            unsigned n0[2], n1[2];
            S.a_off(nxt, n0, n1);
            *G8_PSLOT((ui + 1) & 1) = (u32x4){n0[0], n0[1], n1[0], n1[1]};
        }
        const char* nA0 = has_next ? nxt.a : cA0 - 0; const char* nB0 = has_next ? nxt.b0 : cB0; const char* nB1 = has_next ? nxt.b1 : cB1;
        if (!has_next) nA0 = cur.a;
        const char* nA1 = nA0 + S.a_half();
        for (int t = 0; t < nt; t += 2) {
            const bool last = (t == nt - 2);
            if constexpr (Epi::MID_T > 0) { if (t == Epi::MID_T) E.mid(acc, cur, wr, fr); }
            const char* a11 = uni(cA1 + (size_t)(t + 1) * kstep);
            const char* a20 = uni(last ? nA0 : cA0 + (size_t)(t + 2) * kstep); const char* a21 = uni(last ? nA1 : cA1 + (size_t)(t + 2) * kstep);
            const char* b20 = uni(last ? nB0 : cB0 + (size_t)(t + 2) * kstep); const char* b21 = uni(last ? nB1 : cB1 + (size_t)(t + 2) * kstep);
            const char* a30 = uni(a20 + kstep); const char* b30 = uni(b20 + kstep); const char* b31 = uni(b21 + kstep);
            const int slc = ui & 1, sln = last ? (slc ^ 1) : slc;
#define G8_STAGE_A(bufoff, gbase, sl, half) do { if constexpr (Sched::GATHER) { G8_AOFF(_ao, sl, half); G8_STAGE(bufoff, gbase, _ao); } else { G8_STAGE(bufoff, gbase, va0); } } while (0)
            G8_LDB(B0, 0, 0); G8_LDB(B1, 0, 1); G8_SCHED; G8_LDA(At, 0, 0); G8_STAGE_A(G8_SA(1, 1), a11, slc, 1);
            G8_WAIT_V(8); G8_WAIT_L(0); G8_BAR; G8_MMA(0, 0, At, B0); G8_MMA(0, 1, At, B1); G8_BAR; G8_SCHED;
            G8_LDA(At, 0, 1); G8_STAGE(G8_SB(0, 0), b20, voffB); G8_STAGE(G8_SB(0, 1), b21, voffB); G8_STAGE_A(G8_SA(0, 0), a20, sln, 0);
            G8_WAIT_V(8); G8_WAIT_L(0); G8_BAR; G8_MMA(1, 0, At, B0); G8_MMA(1, 1, At, B1); G8_BAR; G8_SCHED;
            G8_LDB(B0, 1, 0); G8_LDB(B1, 1, 1); G8_SCHED; G8_LDA(At, 1, 0); G8_STAGE_A(G8_SA(0, 1), a21, sln, 1);
            G8_WAIT_V(8); G8_WAIT_L(0); G8_BAR; G8_MMA(0, 0, At, B0); G8_MMA(0, 1, At, B1); G8_BAR; G8_SCHED;
            G8_LDA(At, 1, 1); G8_STAGE(G8_SB(1, 0), b30, voffB); G8_STAGE(G8_SB(1, 1), b31, voffB); G8_STAGE_A(G8_SA(1, 0), a30, sln, 0);
            G8_WAIT_V(8); G8_WAIT_L(0); G8_BAR; G8_MMA(1, 0, At, B0); G8_MMA(1, 1, At, B1); G8_BAR; G8_SCHED;
#undef G8_STAGE_A
        }
        if (wr == 0) G8_BAR;
        { const int l2 = hw_lane(); E(acc, cur, wr, wc, l2 & 15, l2 >> 4); }
        if (!has_next) break;
#pragma unroll
        for (int a = 0; a < 2; ++a)
#pragma unroll
            for (int b = 0; b < 2; ++b)
#pragma unroll
                for (int m = 0; m < 4; ++m)
#pragma unroll
                    for (int n = 0; n < 2; ++n) acc[a][b][m][n] = (f32x4){0.f, 0.f, 0.f, 0.f};
        cur = nxt; cA0 = nA0; cA1 = nA1; cB0 = nB0; cB1 = nB1; ++ui;
        if (wr == 1) G8_BAR;
    }
    G8_WAIT_V(0);
    G8_BAR;
#undef G8_PSLOT
#undef G8_AOFF
#undef G8_SA
#undef G8_SB
#undef G8_STAGE
#undef G8_LDA
#undef G8_LDB
#undef G8_MMA
#undef G8_WAIT_V
#undef G8_WAIT_L
#undef G8_BAR
#undef G8_SCHED
}
DEV int deal(int i, int G, int c, int nwg) {
    const long L = (long)i * G + c; if (L >= nwg) return -1;
    const int w = (int)L, q = nwg / 8, r = nwg % 8, xcd = w % 8, off = w / 8;
    return (xcd < r ? xcd * (q + 1) : r * (q + 1) + (xcd - r) * q) + off;
}
struct EpiStore {
    static constexpr int MID_T = 0;
    bf16_t* O; int ld;
    DEV void operator()(const f32x4 (&acc)[2][2][4][2], const Unit& u, int wr, int wc, int fr, int fq) const {
#pragma unroll
        for (int ai = 0; ai < 2; ++ai)
#pragma unroll
            for (int m = 0; m < 4; ++m) {
                const int r = ai * HALF + wr * 64 + m * 16 + fr;
                if (r < u.nvalid) {
                    bf16_t* rowp = O + (size_t)(u.row0 + r) * ld + u.col0 + wc * 32 + 8 * fq;
#pragma unroll
                    for (int bj = 0; bj < 2; ++bj) {
                        const f32x4 v0 = acc[ai][bj][m][0], v1 = acc[ai][bj][m][1];
                        *(u32x4*)(rowp + bj * HALF) = (u32x4){pk2(v0[0], v0[1]), pk2(v0[2], v0[3]), pk2(v1[0], v1[1]), pk2(v1[2], v1[3])};
                    }
                }
            }
    }
};
struct EpiStore8 {
    static constexpr int MID_T = 0;
    unsigned char* O; int ld; float sc;
    DEV void operator()(const f32x4 (&acc)[2][2][4][2], const Unit& u, int wr, int wc, int fr, int fq) const {
#pragma unroll
        for (int ai = 0; ai < 2; ++ai)
#pragma unroll
            for (int m = 0; m < 4; ++m) {
                const int r = ai * HALF + wr * 64 + m * 16 + fr;
                if (r < u.nvalid) {
                    unsigned char* rowp = O + (size_t)(u.row0 + r) * ld + u.col0 + wc * 32 + 8 * fq;
#pragma unroll
                    for (int bj = 0; bj < 2; ++bj) {
                        const f32x4 v0 = acc[ai][bj][m][0] * sc, v1 = acc[ai][bj][m][1] * sc;
                        int w0 = 0, w1 = 0;
                        w0 = __builtin_amdgcn_cvt_pk_fp8_f32(v0[0], v0[1], w0, false); w0 = __builtin_amdgcn_cvt_pk_fp8_f32(v0[2], v0[3], w0, true);
                        w1 = __builtin_amdgcn_cvt_pk_fp8_f32(v1[0], v1[1], w1, false); w1 = __builtin_amdgcn_cvt_pk_fp8_f32(v1[2], v1[3], w1, true);
                        *(uint2*)(rowp + bj * HALF) = make_uint2((unsigned)w0, (unsigned)w1);
                    }
                }
            }
    }
};
struct SchedDense {
    static constexpr bool GATHER = false, F8 = false;
    const bf16_t* A; const bf16_t* Bt; int lda, ldb, nM, nN, G, c;
    DEV bool next(int i, Unit& u) const {
        const int w = deal(i, G, c, nM * nN); if (w < 0) return false;
        const int nig = 8 * nN, gid = w / nig, fm = gid * 8, gsz = (nM - fm) < 8 ? (nM - fm) : 8;
        const int pm = fm + ((w % nig) % gsz), pn = (w % nig) / gsz;
        u.a = (const char*)(A + (size_t)pm * BM * lda); u.b0 = (const char*)(Bt + (size_t)pn * BM * ldb); u.b1 = u.b0 + (size_t)HALF * ldb * 2;
        u.aux = nullptr; u.row0 = pm * BM; u.col0 = pn * BM; u.nvalid = BM; u.sub = 0; return true;
    }
    DEV size_t a_half() const { return (size_t)HALF * lda * 2; }
    DEV void a_off(const Unit&, unsigned (&v0)[2], unsigned (&v1)[2]) const {
        const int tz = tid512();
#pragma unroll
        for (int i = 0; i < 2; ++i) { int R, C; stage_rc(tz * 16 + i * 8192, R, C); v0[i] = (unsigned)(R * lda + C) * 2u; v1[i] = v0[i]; }
    }
};
}

DEV uint4 as_uint4(const u32x4 q) { return make_uint4(q[0], q[1], q[2], q[3]); }
struct LdRows {
    const bf16_t* base; size_t ld; int cs;
    DEV RawV raw(int, int r, int kcg) const { RawV x; x.q0 = *(const u32x4*)(base + (size_t)r * ld + kcg * cs); return x; }
    DEV uint4 fin(const RawV& x, int, int, int) const { return as_uint4(x.q0); }
};
struct EpStoreBf16 {
    bf16_t* O;
    DEV void pre(int) {}
    DEV void operator()(const float* ct, int tid) const {
#pragma unroll
        for (int i = 0; i < 8; ++i) {
            const int id = tid + 256 * i, c8 = id >> 7, r = id & 127;
            float v[8]; ld8f(ct, r * 132 + c8 * 8, v);
            *(uint4*)(O + (size_t)(r >> 6) * 8192 + c8 * 512 + (r & 63) * 8) = pack8(v);
        }
    }
};

struct Strip { const float* src; unsigned char* dst; const float* rscale; int ld_src, ld_dst; float f8; };
DEV void strip_of(const P& p, int layer, int it, Strip& st) {
    bf16_t* WIN = (bf16_t*)(wsp(p) + WS_WIN); bf16_t* WOUT = (bf16_t*)(wsp(p) + WS_WOUT);
    bf16_t* WG = (bf16_t*)(wsp(p) + WS_WG); bf16_t* WU = (bf16_t*)(wsp(p) + WS_WU); bf16_t* WD = (bf16_t*)(wsp(p) + WS_WD);
    constexpr int T0 = 144, T1 = T0 + 64, T2 = T1 + 1024, T3 = T2 + 1024, T4 = T3 + 1024, T5 = T4 + 16, T6 = T5 + 16;
    const float* src; bf16_t* dst; int ls, ld, r0, c0, rd0 = -1; st.rscale = nullptr;
    const bool f8 = it >= T1;
    unsigned char* WG8 = (unsigned char*)WG; unsigned char* WU8 = (unsigned char*)WU; unsigned char* WD8 = (unsigned char*)WD; unsigned char* dst8 = nullptr;
    if (it < T0) { r0 = (it / 9) * 64; c0 = (it % 9) * 256; src = p.w_in + (size_t)layer * DM * NINF; ls = NINF; dst = WIN; ld = DM; }
    else if (it < T1) { const int ti = it - T0, rt = ti >> 2; r0 = rt * 64; c0 = (ti & 3) * 256; src = p.w_out + (size_t)layer * DM * DM; ls = DM; dst = WOUT; ld = DM;
        rd0 = (r0 + 512) & 1023; if (rt >= 8) st.rscale = p.ssd_norm + layer * 512 + (rt - 8) * 64; }
    else if (it < T2) { const int ti = it - T1, e = ti >> 4; r0 = (ti & 15) * 64; c0 = 0; src = p.w_gate + ((size_t)layer * 64 + e) * DM * FE; ls = FE; dst = nullptr; dst8 = WG8 + (size_t)e * FE * DM; ld = DM; }
    else if (it < T3) { const int ti = it - T2, e = ti >> 4; r0 = (ti & 15) * 64; c0 = 0; src = p.w_up + ((size_t)layer * 64 + e) * DM * FE; ls = FE; dst = nullptr; dst8 = WU8 + (size_t)e * FE * DM; ld = DM; }
    else if (it < T4) { const int ti = it - T3, e = ti >> 4; r0 = ((ti >> 2) & 3) * 64; c0 = (ti & 3) * 256; src = p.w_down + ((size_t)layer * 64 + e) * FE * DM; ls = DM; dst = nullptr; dst8 = WD8 + (size_t)e * DM * FE; ld = FE; }
    else if (it < T5) { r0 = (it - T4) * 64; c0 = 0; src = p.ws_gate + (size_t)layer * DM * FE; ls = FE; dst = nullptr; dst8 = WG8 + (size_t)64 * FE * DM; ld = DM; }
    else if (it < T6) { r0 = (it - T5) * 64; c0 = 0; src = p.ws_up + (size_t)layer * DM * FE; ls = FE; dst = nullptr; dst8 = WU8 + (size_t)64 * FE * DM; ld = DM; }
    else { const int ti = it - T6; r0 = (ti >> 2) * 64; c0 = (ti & 3) * 256; src = p.ws_down + (size_t)layer * FE * DM; ls = DM; dst = nullptr; dst8 = WD8 + (size_t)64 * DM * FE; ld = FE; }
    if (rd0 < 0) rd0 = r0;
    st.src = src + (size_t)r0 * ls + c0; st.dst = f8 ? dst8 + (size_t)c0 * ld + rd0 : (unsigned char*)(dst + (size_t)c0 * ld + rd0); st.ld_src = ls; st.ld_dst = ld; st.f8 = !f8 ? 0.f : (ld == FE ? WD8_SCALE : W8_SCALE);
}
DEV const char* uni_ptr(const void* p) { const unsigned long long v = (unsigned long long)p; const unsigned lo = __builtin_amdgcn_readfirstlane((unsigned)v), hi = __builtin_amdgcn_readfirstlane((unsigned)(v >> 32)); return (const char*)(GAS const char*)(((unsigned long long)hi << 32) | lo); }
DEV void strip_load(const Strip& st, int tid, float4 (&v)[16]) {
    const char* sb = uni_ptr(st.src);
    unsigned off = (unsigned)((tid >> 6) * st.ld_src + (tid & 63) * 4) * 4u; const unsigned step = (unsigned)st.ld_src * 16u;
#pragma unroll
    for (int i = 0; i < 16; ++i) { const f32x4v q = __builtin_nontemporal_load((const f32x4v*)(sb + off)); v[i] = make_float4(q[0], q[1], q[2], q[3]); off += step; }
}
DEV void strip_park(float* t, int tid, const float4 (&v)[16]) {
    const int lane = tid & 63, rot = (lane >> 3) & 3;
    float* base = t + (tid >> 6) * 257 + 4 * lane;
    const int o0 = rot, o1 = (rot + 1) & 3, o2 = (rot + 2) & 3, o3 = (rot + 3) & 3;
#pragma unroll
    for (int i = 0; i < 16; ++i) {
        float a = v[i].x, b = v[i].y, c = v[i].z, d = v[i].w;
        if (rot & 1) { const float t0 = a; a = b; b = c; c = d; d = t0; }
        if (rot & 2) { const float t0 = a, t1 = b; a = c; b = d; c = t0; d = t1; }
        float* q = base + i * 4 * 257;
        q[o0] = a; q[o1] = b; q[o2] = c; q[o3] = d;
    }
}
DEV void strip_emit(const float* t, int tid, const Strip& cur) {
#pragma unroll
    for (int i = 0; i < 8; ++i) {
        const int idx = tid + 256 * i, c = idx >> 3, r8 = (idx & 7) * 8;
        float o[8];
#pragma unroll
        for (int e = 0; e < 8; ++e) o[e] = t[(r8 + e) * 257 + c] * (cur.rscale ? cur.rscale[r8 + e] : 1.f);
        if (cur.f8 != 0.f) { const float sc = cur.f8; *(uint2*)(cur.dst + (size_t)c * cur.ld_dst + r8) = make_uint2(pk4_f8(o[0] * sc, o[1] * sc, o[2] * sc, o[3] * sc), pk4_f8(o[4] * sc, o[5] * sc, o[6] * sc, o[7] * sc)); }
        else *(uint4*)((bf16_t*)cur.dst + (size_t)c * cur.ld_dst + r8) = pack8(o);
    }
}
DEV int strip_index(int part, int i) {
    if (part == 0) return i < 208 ? i : (i < 208 + 1024 ? 2256 + (i - 208) : 3312 + (i - 1232));
    return i < 2048 ? 208 + i : 3280 + (i - 2048);
}
DEV void strips_loop(const P& p, int layer, unsigned char* lds, int id0, int n, int stride, int part) {
    float* t = (float*)lds;
    const int tid = tidx();
    Strip cur, nxt; float4 v[16];
    if (n > 0) { strip_of(p, layer, part < 0 ? id0 : strip_index(part, id0), cur); strip_load(cur, tid, v); }
    for (int k = 0; k < n; ++k) {
        __syncthreads();
        strip_park(t, tid, v);
        const bool more = k + 1 < n;
        if (more) { const int id = id0 + (k + 1) * stride; strip_of(p, layer, part < 0 ? id : strip_index(part, id), nxt); strip_load(nxt, tid, v); }
        __syncthreads();
        strip_emit(t, tid, cur);
        if (more) cur = nxt;
    }
}
constexpr int CW_QH = 8192, NQ_PAIRS = (3328 - 208) / 2;
DEV void fill_strips(const P& p, unsigned char* lds, int budget) {
    volatile LAS int* bc = (volatile LAS int*)(smem_all + LDS_QB);
    unsigned* qh = (unsigned*)(wsp(p) + WS_CTL) + CW_QH;
    const int want = budget < 0 ? 2 : budget;
    for (;;) {
        __syncthreads();
        if (tid512() == 0) *bc = (int)__hip_atomic_fetch_add(qh, (unsigned)want, __ATOMIC_RELAXED, __HIP_MEMORY_SCOPE_AGENT);
        __syncthreads();
        const int q0 = __builtin_amdgcn_readfirstlane(*bc);
        if (q0 >= NQ_PAIRS) break;
        const int n = min(want, NQ_PAIRS - q0);
        strips_loop(p, 0, lds, 208 + 2 * q0 + vhalf(), n, 2, -1);
        if (budget >= 0) break;
    }
}
DEV void phase_p0(const P& p, int layer, unsigned char* lds, int part, bool extras) {
    constexpr int T7 = 3328;
    const int nstrip = part == 0 ? 1248 : (part == 1 ? 2080 : 208);
    const int nextra = extras ? (192 + 256 + 128 + 32) : 0;
    { const int v0 = vbid(); const int n = v0 < nstrip ? (nstrip - v0 + vgrid() - 1) / vgrid() : 0; strips_loop(p, layer, lds, v0, n, vgrid(), part == 2 ? 0 : part); }
    for (int it = T7 + (vbid() + vgrid() - (nstrip % vgrid())) % vgrid(); it < T7 + nextra; it += vgrid()) {
        if (false) {}
        else if (it < T7 + 192) {
            const int mi = it - T7, l = mi / 96, cg = mi % 96, tid = tidx(), lane = tid & 63, wid = tid >> 6;
            float* sc = (float*)lds;
            float* part = sc + 9 * 1024;
            __syncthreads();
            for (int i = tid; i < 9 * 1024; i += 256) { const float v = (i < 8192) ? p.c[i] : p.c_ctx[i - 8192]; sc[i] = silu_f(v); }
            __syncthreads();
            float a9[9];
#pragma unroll
            for (int r = 0; r < 9; ++r) a9[r] = 0.f;
            const float* wm = p.w_mod + (size_t)l * DM * 6144 + cg * 64 + lane;
#pragma unroll 1
            for (int k0 = wid * 256; k0 < wid * 256 + 256; k0 += 16) {
                float w[16];
#pragma unroll
                for (int j = 0; j < 16; ++j) w[j] = wm[(size_t)(k0 + j) * 6144];
#pragma unroll
                for (int j = 0; j < 16; ++j)
#pragma unroll
                    for (int r = 0; r < 9; ++r) a9[r] += sc[r * 1024 + k0 + j] * w[j];
            }
#pragma unroll
            for (int r = 0; r < 9; ++r) part[(wid * 9 + r) * 64 + lane] = a9[r];
            __syncthreads();
            float* MOD = (float*)(wsp(p) + WS_MOD);
            for (int i = tid; i < 9 * 64; i += 256) {
                const int r = i >> 6, j = i & 63;
                const float s = ((part[(0 * 9 + r) * 64 + j] + part[(1 * 9 + r) * 64 + j]) + part[(2 * 9 + r) * 64 + j]) + part[(3 * 9 + r) * 64 + j];
                const float v = s + p.b_mod[l * 6144 + cg * 64 + j];
                const int T = cg >> 4, c = (cg & 15) * 64 + j;
                float o = v;
                if (T == 1) o = p.g_pre_mix[l * DM + c] * (1.f + v);
                if (T == 2) o = v * p.g_post_mix[l * DM + c];
                if (T == 4) o = p.g_pre_ffn[l * DM + c] * (1.f + v);
                if (T == 5) o = v * p.g_post_ffn[l * DM + c];
                MOD[((size_t)l * 9 + r) * 6144 + cg * 64 + j] = o;
            }
        } else if (it >= T7 + 192 + 256) {
            const int idx = (it - T7 - 192 - 256) * 256 + tidx();
            if (idx < 32768) {
                const int l = idx >> 14, wid = (idx >> 12) & 3, q = (idx >> 6) & 63, lane = idx & 63;
                const float* src = p.router_w + (size_t)l * DM * NEXP + (size_t)(16 * q + 4 * (lane >> 4)) * NEXP + 16 * wid + (lane & 15);
                ((float4*)(wsp(p) + WS_RW2))[idx] = make_float4(src[0], src[NEXP], src[2 * NEXP], src[3 * NEXP]);
            } else {
                const int id2 = idx - 32768, l = id2 >> 12, wid = (id2 >> 10) & 3, q = (id2 >> 6) & 15, lane = id2 & 63;
                const float* src = p.w_in + (size_t)l * DM * NINF + (size_t)(256 * wid + 16 * q + 4 * (lane >> 4)) * NINF + NIN + (lane & 15);
                ((float4*)(wsp(p) + WS_WD2))[id2] = make_float4(src[0], src[NINF], src[2 * NINF], src[3 * NINF]);
            }
        } else {
            const int idx = (it - T7 - 192) * 256 + tidx(), pos = idx >> 5, i = idx & 31, f = i & 15;
            const float inv = powf(10000.f, -(float)f / 16.f);
            const float ang = (float)((i < 16) ? (pos >> 6) : (pos & 63)) * inv;
            float2* ROPE = (float2*)(wsp(p) + WS_ROPE);
            ROPE[idx] = make_float2(cosf(ang), sinf(ang));
        }
    }
}

DEV void ld_row16(const float* row, int lane, float* v) {
#pragma unroll
    for (int i = 0; i < 4; ++i) { const float4 q = *(const float4*)(row + 4 * lane + 256 * i); v[4 * i] = q.x; v[4 * i + 1] = q.y; v[4 * i + 2] = q.z; v[4 * i + 3] = q.w; }
}
DEV void st_row16(float* row, int lane, const float* v) {
#pragma unroll
    for (int i = 0; i < 4; ++i) *(float4*)(row + 4 * lane + 256 * i) = make_float4(v[4 * i], v[4 * i + 1], v[4 * i + 2], v[4 * i + 3]);
}
DEV void ld_row16_bf(const bf16_t* row, int lane, float* v) {
#pragma unroll
    for (int i = 0; i < 4; ++i) { const uint2 q = *(const uint2*)(row + 4 * lane + 256 * i); v[4 * i] = bflo(q.x); v[4 * i + 1] = bfhi(q.x); v[4 * i + 2] = bflo(q.y); v[4 * i + 3] = bfhi(q.y); }
}
DEV void st_row16_bf(bf16_t* row, int lane, const float* v) {
#pragma unroll
    for (int i = 0; i < 4; ++i) *(uint2*)(row + 4 * lane + 256 * i) = make_uint2(pk2(v[4 * i], v[4 * i + 1]), pk2(v[4 * i + 2], v[4 * i + 3]));
}
DEV float rstd16(const float* v) {
    float s = 0.f;
#pragma unroll
    for (int e = 0; e < 16; ++e) s += v[e] * v[e];
    s = wave_sum(s);
    return rsqrtf(s * (1.f / 1024.f) + EPS);
}
constexpr int HLS = 1028;
constexpr int HL_BYTES = 16 * HLS * 4;
DEV f32x4v mfma4(const float4 a, const float4 b, f32x4v acc) {
    acc = __builtin_amdgcn_mfma_f32_16x16x4f32(a.x, b.x, acc, 0, 0, 0); acc = __builtin_amdgcn_mfma_f32_16x16x4f32(a.y, b.y, acc, 0, 0, 0);
    acc = __builtin_amdgcn_mfma_f32_16x16x4f32(a.z, b.z, acc, 0, 0, 0); acc = __builtin_amdgcn_mfma_f32_16x16x4f32(a.w, b.w, acc, 0, 0, 0);
    return acc;
}
template <int RPW> DEV void dt_tail16(const float* hl, const float4* wd2  , const float* bias, float* part, float* DT, int tok0, int tid) {
    const int lane = tid & 63, wid = tid >> 6, ar = lane & 15, kq = lane >> 4;
    f32x4v acc = {0.f, 0.f, 0.f, 0.f};
    const float* ap = hl + ar * HLS + wid * 256 + 4 * kq;
    const float4* bp = wd2 + (size_t)wid * 16 * 64 + lane;
#pragma unroll 8
    for (int q = 0; q < 16; ++q) acc = mfma4(*(const float4*)(ap + 16 * q), bp[q * 64], acc);
#pragma unroll
    for (int e = 0; e < 4; ++e) part[(wid * 16 + kq * 4 + e) * 16 + ar] = acc[e];
    __syncthreads();
    const int r = tid >> 4, j = tid & 15;
    const float v = ((part[(0 * 16 + r) * 16 + j] + part[(1 * 16 + r) * 16 + j]) + part[(2 * 16 + r) * 16 + j]) + part[(3 * 16 + r) * 16 + j];
    if (r < 4 * RPW) DT[(size_t)(tok0 + r) * 16 + j] = softplus_f(v + bias[j]);
}
template <int RPW> DEV void phase_pa0(const P& p, unsigned char* lds, int row0, int nrows) {
    const int tid = tidx(), lane = tid & 63, wid = tid >> 6;
    const float* MOD = (const float*)(wsp(p) + WS_MOD);
    bf16_t* H = (bf16_t*)(wsp(p) + WS_H); float* DT = (float*)(wsp(p) + WS_DT);
    float* hl = (float*)lds; float* part = (float*)(lds + HL_BYTES);
    for (int task = vbid(); task < nrows / (4 * RPW); task += vgrid()) {
        const int tok0 = row0 + task * (4 * RPW) + wid * RPW;
        const float* xb = tok0 < TL ? p.x + (size_t)tok0 * DM : p.ctx + (size_t)(tok0 - TL) * DM;
        const float* md = MOD + (size_t)(tok0 < TL ? tok0 / SEQ : 8) * 6144;
        float x[RPW][16], pb[16], pc[16];
#pragma unroll
        for (int rr = 0; rr < RPW; ++rr) ld_row16(xb + (size_t)rr * DM, lane, x[rr]);
        ld_row16(md + 1024, lane, pb); ld_row16(md + 0, lane, pc);
        __syncthreads();
#pragma unroll
        for (int rr = 0; rr < RPW; ++rr) {
            const float rs = rstd16(x[rr]);
            float h[16];
#pragma unroll
            for (int e = 0; e < 16; ++e) h[e] = x[rr][e] * rs * pb[e] + pc[e];
            st_row16_bf(H + (size_t)(tok0 + rr) * DM, lane, h);
            st_row16(hl + (wid * RPW + rr) * HLS, lane, h);
        }
        __syncthreads();
        dt_tail16<RPW>(hl, (const float4*)(wsp(p) + WS_WD2), p.dt_bias, part, DT, row0 + task * (4 * RPW), tid);
    }
}
template <int RPW> DEV void phase_pi(const P& p, int layer, unsigned char* lds, int row0, int nrows) {
    const int tid = tidx(), lane = tid & 63, wid = tid >> 6;
    const float* MOD = (const float*)(wsp(p) + WS_MOD);
    const bf16_t* ML = (const bf16_t*)(wsp(p) + WS_ML);
    bf16_t* XB = (bf16_t*)(wsp(p) + WS_XB);
    bf16_t* H = (bf16_t*)(wsp(p) + WS_H);
    unsigned* TOPK = (unsigned*)(wsp(p) + WS_TOPK);
    uint2* LIST = (uint2*)(wsp(p) + WS_LIST);
    unsigned* cnt = (unsigned*)(wsp(p) + WS_CTL) + CW_CNT + layer * CNT_LAYER;
    float* hl = (float*)lds; float* lgl = (float*)(lds + HL_BYTES);
    unsigned* lcnt = (unsigned*)(lds + HL_BYTES + 4096); unsigned* lbase = lcnt + 64;
    if (tid < 64) lcnt[tid] = 0u;
    const float4* rw2 = (const float4*)(wsp(p) + WS_RW2) + (size_t)layer * 16384 + (size_t)wid * 4096 + lane;
    const float rbias = p.router_bias[layer * NEXP + lane];
    for (int task = vbid(); task < nrows / (4 * RPW); task += vgrid()) {
        const int tok0 = row0 + task * (4 * RPW) + wid * RPW;
        const float* xin = tok0 < TL ? p.x + (size_t)tok0 * DM : p.ctx + (size_t)(tok0 - TL) * DM;
        bf16_t* xout = XB + (size_t)tok0 * DM;
        const float* md = MOD + ((size_t)layer * 9 + (tok0 < TL ? tok0 / SEQ : 8)) * 6144;
        float pa[16], pb[16], pc[16];
        ld_row16(md + 2048, lane, pa); ld_row16(md + 4096, lane, pb); ld_row16(md + 3072, lane, pc);
        __syncthreads();
#pragma unroll 1
        for (int hp = 0; hp < 2; ++hp) {
            float x[2][16]; uint2 yp[2][4];
#pragma unroll
            for (int r2 = 0; r2 < 2; ++r2) {
                const int rr = hp * 2 + r2;
                if (rr < RPW) {
                    if (layer == 0) ld_row16(xin + (size_t)rr * DM, lane, x[r2]); else ld_row16_bf(xout + (size_t)rr * DM, lane, x[r2]);
#pragma unroll
                    for (int i = 0; i < 4; ++i) yp[r2][i] = *(const uint2*)(ML + (size_t)(tok0 + rr) * DM + 4 * lane + 256 * i);
                }
            }
#pragma unroll
            for (int r2 = 0; r2 < 2; ++r2) {
                const int rr = hp * 2 + r2;
                if (rr >= RPW) continue;
                float y[16];
#pragma unroll
                for (int i = 0; i < 4; ++i) { y[4 * i] = bflo(yp[r2][i].x); y[4 * i + 1] = bfhi(yp[r2][i].x); y[4 * i + 2] = bflo(yp[r2][i].y); y[4 * i + 3] = bfhi(yp[r2][i].y); }
                const float rsy = rstd16(y);
#pragma unroll
                for (int e = 0; e < 16; ++e) x[r2][e] += pa[e] * (y[e] * rsy);
                st_row16_bf(xout + (size_t)rr * DM, lane, x[r2]);
                const float rs = rstd16(x[r2]);
                float h[16];
#pragma unroll
                for (int e = 0; e < 16; ++e) h[e] = x[r2][e] * rs * pb[e] + pc[e];
                {
                    unsigned char* h8 = (unsigned char*)H + (size_t)(tok0 + rr) * DM + 4 * lane;
#pragma unroll
                    for (int i = 0; i < 4; ++i) *(unsigned*)(h8 + 256 * i) = pk4_f8(h[4 * i] * H8_SCALE, h[4 * i + 1] * H8_SCALE, h[4 * i + 2] * H8_SCALE, h[4 * i + 3] * H8_SCALE);
                }
                st_row16(hl + (wid * RPW + rr) * HLS, lane, h);
            }
        }
        __syncthreads();
        {
            const int ar = lane & 15, kq = lane >> 4;
            f32x4v acc = {0.f, 0.f, 0.f, 0.f};
            const float* ap = hl + ar * HLS + 4 * kq;
#pragma unroll 8
            for (int q = 0; q < 64; ++q) acc = mfma4(*(const float4*)(ap + 16 * q), rw2[q * 64], acc);
#pragma unroll
            for (int e = 0; e < 4; ++e) lgl[(kq * 4 + e) * 64 + wid * 16 + ar] = acc[e];
        }
        __syncthreads();
        unsigned selm = 0; float gatev[RPW]; int posv[RPW]; unsigned lrk[RPW];
#pragma unroll
        for (int rr = 0; rr < RPW; ++rr) {
            const float score = sigmoid_f(lgl[(wid * RPW + rr) * 64 + lane]), choice = score + rbias;
            int grank = 0;
#pragma unroll
            for (int t = 0; t < 8; ++t) { const int j = (lane & ~7) + t; const float v = __shfl(choice, j); grank += (v > choice || (v == choice && j < lane)) ? 1 : 0; }
            float gs = grank < 2 ? choice : 0.f;
            gs += __shfl_xor(gs, 1); gs += __shfl_xor(gs, 2); gs += __shfl_xor(gs, 4);
            int gr = 0;
#pragma unroll
            for (int t = 0; t < 8; ++t) { const float v = __shfl(gs, t * 8); gr += (v > gs || (v == gs && t < (lane >> 3))) ? 1 : 0; }
            const bool ok = gr < 4;
            const float m = ok ? choice : -INFINITY;
            int rank = 0;
            for (int j = 0; j < 64; ++j) { const float v = __shfl(m, j); rank += (v > m || (v == m && j < lane)) ? 1 : 0; }
            const bool sel = ok && rank < 8;
            const float wsum = wave_sum(sel ? score : 0.f);
            const unsigned long long bal = __ballot(sel);
            gatev[rr] = score / wsum * 2.5f;
            posv[rr] = __popcll(bal & ((1ull << lane) - 1ull));
            lrk[rr] = 0;
            if (sel) { selm |= 1u << rr; lrk[rr] = atomicAdd(&lcnt[lane], 1u); }
        }
        __syncthreads();
        if (tid < 64) { const unsigned c = lcnt[tid]; lbase[tid] = c ? atomicAdd(&cnt[tid * CNT_STRIDE], c) : 0u; lcnt[tid] = 0u; }
        __syncthreads();
        const unsigned base = lbase[lane];
#pragma unroll
        for (int rr = 0; rr < RPW; ++rr)
            if (selm & (1u << rr)) {
                const unsigned rk = base + lrk[rr];
                LIST[(size_t)lane * CAP + rk] = make_uint2((unsigned)(tok0 + rr), __builtin_bit_cast(unsigned, gatev[rr]));
                TOPK[(size_t)(tok0 + rr) * 8 + posv[rr]] = (unsigned)lane | (rk << 8);
            }
    }
}

DEV void phase_pb(const P& p, int layer, LAS unsigned char* lds) {
    const bf16_t* H = (const bf16_t*)(wsp(p) + (layer == 0 ? WS_H : WS_HIN1)); const bf16_t* WIN = (const bf16_t*)(wsp(p) + WS_WIN); bf16_t* O = (bf16_t*)(wsp(p) + WS_QKVZX);
    g8::SchedDense S{H, WIN, DM, DM, TT / 256, NIN / 256, (int)gridDim.x, (int)blockIdx.x};
    g8::EpiStore E{O, NIN};
    g8::gemm(lds, S, E, DM / 64, DM);
}

template <int FRAG = 0> DEV void store_transposed(unsigned char* lds, const float (*v)[8], bf16_t* dst, size_t stride) {
    bf16_t* t = (bf16_t*)lds;
    const int tid = tidx();
    __syncthreads();
#pragma unroll
    for (int i = 0; i < 4; ++i) *(uint4*)(t + ((tid >> 3) + 32 * i) * 72 + (tid & 7) * 8) = pack8(v[i]);
    __syncthreads();
    const int c = tid >> 2, sp = (tid & 3) * 32;
#pragma unroll
    for (int jj = 0; jj < 4; ++jj) {
        unsigned w[4];
#pragma unroll
        for (int e = 0; e < 4; ++e) w[e] = (unsigned)t[(sp + jj * 8 + 2 * e) * 72 + c] | ((unsigned)t[(sp + jj * 8 + 2 * e + 1) * 72 + c] << 16);
        if (FRAG) *(uint4*)(dst + (size_t)((sp >> 3) + jj) * FRAG + c * 8) = make_uint4(w[0], w[1], w[2], w[3]);
        else *(uint4*)(dst + (size_t)c * stride + sp + jj * 8) = make_uint4(w[0], w[1], w[2], w[3]);
    }
}
DEV void phase_pc(const P& p, int layer, unsigned char* lds) {
    const bf16_t* QK = (const bf16_t*)(wsp(p) + WS_QKVZX);
    bf16_t* QP = (bf16_t*)(wsp(p) + WS_QP); bf16_t* KP = (bf16_t*)(wsp(p) + WS_KP); bf16_t* VT = (bf16_t*)(wsp(p) + WS_VT);
    bf16_t* XT = (bf16_t*)(wsp(p) + WS_XT); bf16_t* BT = (bf16_t*)(wsp(p) + WS_BT); bf16_t* BF = (bf16_t*)(wsp(p) + WS_BF); bf16_t* CF = (bf16_t*)(wsp(p) + WS_CF);
    const float2* ROPE = (const float2*)(wsp(p) + WS_ROPE);
    const float* DT = (const float*)(wsp(p) + WS_DT);
    float* CUM = (float*)(wsp(p) + WS_CUM); float* WST = (float*)(wsp(p) + WS_WST); float* DTT = (float*)(wsp(p) + WS_DTT); float* TOT = (float*)(wsp(p) + WS_TOT);
    const int tid = tidx(), c8 = (tid & 7) * 8, s0 = tid >> 3;
    for (int u = vbid(); u < NCH * 29; u += vgrid()) {
        const int ch = u / 29, sub = u % 29;
        const bool lat = ch < NCHL;
        const int tok0 = ch * 128;
        const int pos0 = lat ? (ch & 15) * 128 : ((ch - NCHL) & 1) * 128;
        const int slen = lat ? SEQ : LC;
        if (sub < 16) {
            const int cg = sub, cc = cg * 64 + c8;
            float w0[8], w1[8], w2[8], bb[8];
            {
                const float* cw = p.conv_w + (size_t)layer * 3 * 1024 + cc; const float* cbp = p.conv_b + layer * 1024 + cc;
                const float4 q0 = *(const float4*)cw, q1 = *(const float4*)(cw + 4), q2 = *(const float4*)(cw + 1024), q3 = *(const float4*)(cw + 1028), q4 = *(const float4*)(cw + 2048), q5 = *(const float4*)(cw + 2052),
                             q6 = *(const float4*)cbp, q7 = *(const float4*)(cbp + 4);
                w0[0] = q0.x; w0[1] = q0.y; w0[2] = q0.z; w0[3] = q0.w; w0[4] = q1.x; w0[5] = q1.y; w0[6] = q1.z; w0[7] = q1.w;
                w1[0] = q2.x; w1[1] = q2.y; w1[2] = q2.z; w1[3] = q2.w; w1[4] = q3.x; w1[5] = q3.y; w1[6] = q3.z; w1[7] = q3.w;
                w2[0] = q4.x; w2[1] = q4.y; w2[2] = q4.z; w2[3] = q4.w; w2[4] = q5.x; w2[5] = q5.y; w2[6] = q5.z; w2[7] = q5.w;
                bb[0] = q6.x; bb[1] = q6.y; bb[2] = q6.z; bb[3] = q6.w; bb[4] = q7.x; bb[5] = q7.y; bb[6] = q7.z; bb[7] = q7.w;
            }
            float o[4][8];
            uint4 ra[4], rb[4], rc[4];
#pragma unroll
            for (int i = 0; i < 4; ++i) {
                const int s = s0 + 32 * i, pos = pos0 + s;
                const bf16_t* src = QK + (size_t)(tok0 + s) * NIN + C_X + cc;
                rb[i] = *(const uint4*)src; ra[i] = *(const uint4*)(pos > 0 ? src - NIN : src); rc[i] = *(const uint4*)(pos < slen - 1 ? src + NIN : src);
            }
#pragma unroll
            for (int i = 0; i < 4; ++i) {
                const int s = s0 + 32 * i, pos = pos0 + s;
                float a[8], b[8], c[8];
                unpack8(ra[i], a); unpack8(rb[i], b); unpack8(rc[i], c);
                const float ma = pos > 0 ? 1.f : 0.f, mc = pos < slen - 1 ? 1.f : 0.f;
#pragma unroll
                for (int e = 0; e < 8; ++e) { a[e] *= ma; c[e] *= mc; }
#pragma unroll
                for (int e = 0; e < 8; ++e) o[i][e] = silu_f(bb[e] + w0[e] * a[e] + w1[e] * b[e] + w2[e] * c[e]);
                if (cg >= 12) *(uint4*)(CF + (((size_t)ch * 2 + ((cg - 12) >> 1)) * 16 + (((cc - 768) & 127) >> 3)) * 1024 + s * 8) = pack8(o[i]);
                else if (cg >= 8) *(uint4*)(BF + (((size_t)ch * 2 + ((cg - 8) >> 1)) * 16 + (((cc - 512) & 127) >> 3)) * 1024 + s * 8) = pack8(o[i]);
            }
            if (cg < 8) store_transposed<512>(lds, o, XT + ((size_t)ch * 8 + cg) * 64 * 128, 128);
            else if (cg < 12) store_transposed<1024>(lds, o, BT + ((size_t)ch * 2 + ((cg - 8) >> 1)) * 128 * 128 + ((cg - 8) & 1) * 64 * 8, 128);
            else { __syncthreads(); __syncthreads(); }
            __syncthreads();
        } else if (sub < 28) {
            const int hs = sub - 16;
            const int col = hs < 8 ? C_Q + hs * 64 : (hs < 10 ? C_K + (hs - 8) * 64 : C_V + (hs - 10) * 64);
            float o[4][8];
#pragma unroll
            for (int i = 0; i < 4; ++i) {
                const int s = s0 + 32 * i;
                unpack8(*(const uint4*)(QK + (size_t)(tok0 + s) * NIN + col + c8), o[i]);
                if (hs < 10) {
                    float ss = 0.f;
#pragma unroll
                    for (int e = 0; e < 8; ++e) ss += o[i][e] * o[i][e];
                    ss += __shfl_xor(ss, 1); ss += __shfl_xor(ss, 2); ss += __shfl_xor(ss, 4);
                    const float rs = rsqrtf(ss * (1.f / 64.f) + EPS);
                    const float* g = (hs < 8 ? p.q_norm : p.k_norm) + layer * 64 + c8;
#pragma unroll
                    for (int e = 0; e < 8; ++e) o[i][e] = o[i][e] * rs * g[e];
                    if (lat) {
                        const int pos = pos0 + s, half = (tid & 7) >> 2;
                        const float2* rp = ROPE + (size_t)pos * 32 + (c8 & 31);
#pragma unroll
                        for (int e = 0; e < 8; ++e) {
                            const float other = __shfl_xor(o[i][e], 4);
                            const float2 cs = rp[e];
                            o[i][e] = half ? (other * cs.y + o[i][e] * cs.x) : (o[i][e] * cs.x - other * cs.y);
                        }
                    }
                    if (hs < 8) {
#pragma unroll
                        for (int e = 0; e < 8; ++e) o[i][e] *= QSCALE;
                        *(uint4*)(QP + (size_t)(tok0 + s) * 512 + hs * 64 + c8) = pack8(o[i]);
                    } else *(uint4*)(KP + (size_t)(tok0 + s) * 128 + (hs - 8) * 64 + c8) = pack8(o[i]);
                }
            }
            if (hs >= 10) {
                const int b = lat ? ch >> 4 : (ch - NCHL) >> 1;
                const int kp0 = lat ? LC + pos0 : pos0;
                store_transposed(lds, o, VT + ((size_t)(b * 2 + (hs - 10)) * 64) * NKEY + kp0, NKEY);
            } else { __syncthreads(); __syncthreads(); }
            __syncthreads();
        } else {
            float* la = (float*)lds;
            __syncthreads();
            for (int i = tid; i < 16 * 128; i += 256) {
                const int j = i >> 7, s = i & 127;
                const float dt = DT[(size_t)(tok0 + s) * 16 + j];
                DTT[((size_t)ch * 16 + j) * 128 + s] = dt;
                la[i] = dt * (-__expf(p.a_log[layer * 16 + j]));
            }
            __syncthreads();
            if (tid < 16) {
                float run = 0.f;
                if (tid < 8) { for (int s = 0; s < 128; ++s) { run += la[tid * 128 + s]; la[tid * 128 + s] = run; } }
                else { for (int s = 0; s < 128; ++s) { const float v = la[tid * 128 + s]; la[tid * 128 + s] = run; run += v; } }
                TOT[ch * 16 + tid] = run;
                la[16 * 128 + tid] = run;
            }
            __syncthreads();
            for (int i = tid; i < 16 * 128; i += 256) {
                const int j = i >> 7, s = i & 127;
                const float cu = la[i], tot = la[16 * 128 + j];
                const float dt = DT[(size_t)(tok0 + s) * 16 + j];
                CUM[((size_t)ch * 16 + j) * 128 + s] = cu;
                WST[((size_t)ch * 16 + j) * 128 + s] = dt * (j < 8 ? __expf(tot - cu) : __expf(cu));
            }
        }
    }
}

struct LdXTw {
    const bf16_t* xt; const float* w;
    DEV RawV raw(int, int r, int kcg) const {
        RawV x; x.q0 = *(const u32x4*)(xt + (size_t)(r >> 6) * 8192 + kcg * 512 + (r & 63) * 8);
        const float* wp = w + (r >> 6) * 128 + kcg * 8;
        x.q1 = *(const u32x4*)wp; x.q2 = *(const u32x4*)(wp + 4); return x;
    }
    DEV uint4 fin(const RawV& x, int, int, int) const {
        float f[8]; unpack8(as_uint4(x.q0), f);
#pragma unroll
        for (int e = 0; e < 4; ++e) { f[e] *= __uint_as_float(x.q1[e]); f[4 + e] *= __uint_as_float(x.q2[e]); }
        return pack8(f);
    }
};
struct EpStoreF32 {
    float* O;
    DEV void pre(int) {}
    DEV void operator()(const float* ct, int tid) const {
#pragma unroll
        for (int i = 0; i < 8; ++i) {
            const int id = tid + 256 * i, c8 = id >> 7, r = id & 127;
            *(float4*)(O + (size_t)c8 * 1024 + r * 8) = *(const float4*)(ct + r * 132 + c8 * 8);
            *(float4*)(O + (size_t)c8 * 1024 + r * 8 + 4) = *(const float4*)(ct + r * 132 + c8 * 8 + 4);
        }
    }
};
DEV void phase_pd(const P& p, unsigned char* lds) {
    (void)lds;
    const char* XT = (const char*)(wsp(p) + WS_XT); const char* BT = (const char*)(wsp(p) + WS_BT); const char* BF = (const char*)(wsp(p) + WS_BF); const char* CF = (const char*)(wsp(p) + WS_CF);
    const float* WST = (const float*)(wsp(p) + WS_WST);
    bf16_t* SST = (bf16_t*)(wsp(p) + WS_SST); float* CB = (float*)(wsp(p) + WS_CB);
    const int tid = tidx(), lane = tid & 63, wid = tid >> 6, lr = lane & 31, lh = lane >> 5;
    unsigned o128 = (unsigned)(lh * 128 + lr) * 16u, o64 = (unsigned)(lh * 64 + lr) * 16u;
    asm volatile("" : "+v"(o128), "+v"(o64));
#define PD_LD16(base, voff, imm) (*(const u32x4*)((base) + (voff) + (imm)))
    for (int wu = vbid() * 4 + wid; wu < NCH * 80; wu += vgrid() * 4) {
        const int ch = wu / 80, r = wu % 80;
        f32x16 acc[2];
#pragma unroll
        for (int e = 0; e < 16; ++e) { acc[0][e] = 0.f; acc[1][e] = 0.f; }
        if (r < 64) {
            const int dir = r >> 5, h = (r >> 2) & 7, nt = r & 3, g = h >> 2;
            const char* aU = uni_ptr(BT + (((size_t)ch * 2 + g) * 128 * 128 + nt * 32 * 8) * 2);
            const char* bU = uni_ptr(XT + ((size_t)ch * 8 + h) * 64 * 128 * 2);
            const char* wU = uni_ptr(WST + ((size_t)ch * 16 + dir * 8 + h) * 128);
            u32x4 ra[8], rb0[8], rb1[8], rw0[8], rw1[8];
            unsigned ow = (unsigned)lh * 32u; asm volatile("" : "+v"(ow));
#pragma unroll
            for (int i = 0; i < 8; ++i) { ra[i] = PD_LD16(aU, o128, 4096 * i); rb0[i] = PD_LD16(bU, o64, 2048 * i); rb1[i] = PD_LD16(bU, o64, 2048 * i + 512); rw0[i] = PD_LD16(wU, ow, 64 * i); rw1[i] = PD_LD16(wU, ow, 64 * i + 16); }
#pragma unroll
            for (int i = 0; i < 8; ++i) {
                float x0[8], x1[8];
                unpack8(as_uint4(rb0[i]), x0); unpack8(as_uint4(rb1[i]), x1);
#pragma unroll
                for (int j = 0; j < 4; ++j) { const float wa = __uint_as_float(rw0[i][j]), wb = __uint_as_float(rw1[i][j]); x0[j] *= wa; x1[j] *= wa; x0[4 + j] *= wb; x1[4 + j] *= wb; }
                const bf16x8 af = __builtin_bit_cast(bf16x8, ra[i]);
                acc[0] = __builtin_amdgcn_mfma_f32_32x32x16_bf16(af, __builtin_bit_cast(bf16x8, pack8(x0)), acc[0], 0, 0, 0);
                acc[1] = __builtin_amdgcn_mfma_f32_32x32x16_bf16(af, __builtin_bit_cast(bf16x8, pack8(x1)), acc[1], 0, 0, 0);
            }
            bf16_t* o = SST + (((size_t)ch * 2 + dir) * 8 + h) * 64 * 128 + (size_t)(nt * 4) * 512 + lr * 8 + 4 * lh;
#pragma unroll
            for (int pt = 0; pt < 2; ++pt)
#pragma unroll
                for (int q = 0; q < 4; ++q)
                    *(uint2*)(o + q * 512 + pt * 256) = make_uint2(pk2(acc[pt][4 * q], acc[pt][4 * q + 1]), pk2(acc[pt][4 * q + 2], acc[pt][4 * q + 3]));
        } else {
            const int r2 = r - 64, g = r2 >> 3, st = (r2 >> 1) & 3, lp = r2 & 1;
            const char* aU = uni_ptr(BF + (((size_t)ch * 2 + g) * 128 * 128 + st * 32 * 8) * 2);
            const char* bU = uni_ptr(CF + (((size_t)ch * 2 + g) * 128 * 128 + lp * 64 * 8) * 2);
            u32x4 ra[8], rb0[8], rb1[8];
#pragma unroll
            for (int i = 0; i < 8; ++i) { ra[i] = PD_LD16(aU, o128, 4096 * i); rb0[i] = PD_LD16(bU, o128, 4096 * i); rb1[i] = PD_LD16(bU, o128, 4096 * i + 512); }
#pragma unroll
            for (int i = 0; i < 8; ++i) {
                const bf16x8 af = __builtin_bit_cast(bf16x8, ra[i]);
                acc[0] = __builtin_amdgcn_mfma_f32_32x32x16_bf16(af, __builtin_bit_cast(bf16x8, rb0[i]), acc[0], 0, 0, 0);
                acc[1] = __builtin_amdgcn_mfma_f32_32x32x16_bf16(af, __builtin_bit_cast(bf16x8, rb1[i]), acc[1], 0, 0, 0);
            }
            float* o = CB + ((size_t)ch * 2 + g) * 128 * 128 + (size_t)(st * 4) * 1024 + (lp * 64 + lr) * 8 + 4 * lh;
#pragma unroll
            for (int lt = 0; lt < 2; ++lt)
#pragma unroll
                for (int q = 0; q < 4; ++q)
                    *(float4*)(o + q * 1024 + lt * 256) = make_float4(acc[lt][4 * q], acc[lt][4 * q + 1], acc[lt][4 * q + 2], acc[lt][4 * q + 3]);
        }
    }
#undef PD_LD16
}
DEV void phase_pe(const P& p) {
    bf16_t* SST = (bf16_t*)(wsp(p) + WS_SST); const float* TOT = (const float*)(wsp(p) + WS_TOT);
    for (int gid = vbid() * 256 + tidx(); gid < NB * 2 * 8 * 64 * 16; gid += vgrid() * 256) {
        const int n8 = gid & 15, pp = (gid >> 4) & 63, h = (gid >> 10) & 7, dir = (gid >> 13) & 1, b = gid >> 14;
        u32x4 loc[18]; float dec[18];
#pragma unroll
        for (int st = 0; st < 18; ++st) {
            const int ch = dir == 0 ? (st < 2 ? NCHL + b * 2 + st : b * 16 + (st - 2)) : (st < 2 ? NCHL + b * 2 + (1 - st) : b * 16 + (17 - st));
            loc[st] = *(const u32x4*)(SST + ((((size_t)ch * 2 + dir) * 8 + h) * 64 + pp) * 128 + n8 * 8);
            dec[st] = TOT[ch * 16 + dir * 8 + h];
        }
        float run[8];
#pragma unroll
        for (int e = 0; e < 8; ++e) run[e] = 0.f;
#pragma unroll
        for (int st = 0; st < 18; ++st) {
            const int ch = dir == 0 ? (st < 2 ? NCHL + b * 2 + st : b * 16 + (st - 2)) : (st < 2 ? NCHL + b * 2 + (1 - st) : b * 16 + (17 - st));
            *(uint4*)(SST + ((((size_t)ch * 2 + dir) * 8 + h) * 64 + pp) * 128 + n8 * 8) = pack8(run);
            const float d = __expf(dec[st]);
            const u32x4 q = loc[st];
            run[0] = d * run[0] + bflo(q.x); run[1] = d * run[1] + bfhi(q.x); run[2] = d * run[2] + bflo(q.y); run[3] = d * run[3] + bfhi(q.y);
            run[4] = d * run[4] + bflo(q.z); run[5] = d * run[5] + bfhi(q.z); run[6] = d * run[6] + bflo(q.w); run[7] = d * run[7] + bfhi(q.w);
        }
    }
}
struct LdG {
    const float* cb; const bf16_t* cm; const float* sv; float totb, dsk;
    DEV RawV raw(int, int r, int kcg) const {
        const int seg = kcg >> 4, kk = (kcg & 15) * 8;
        RawV x;
        if (seg == 0 || seg == 2) { x.q0 = *(const u32x4*)(cb + (size_t)r * 128 + kk); x.q1 = *(const u32x4*)(cb + (size_t)r * 128 + kk + 4); }
        else x.q0 = *(const u32x4*)(cm + (size_t)r * 512 + kk);
        return x;
    }
    DEV uint4 fin(const RawV& x, int, int r, int kcg) const {
        const int seg = kcg >> 4, kk = (kcg & 15) * 8;
        float f[8];
        if (seg == 0 || seg == 2) {
            const bool fwd = seg == 0;
            if (fwd ? (kk > r) : (kk + 7 < r)) return make_uint4(0u, 0u, 0u, 0u);
            float cbv[8];
#pragma unroll
            for (int e = 0; e < 4; ++e) { cbv[e] = __uint_as_float(x.q0[e]); cbv[4 + e] = __uint_as_float(x.q1[e]); }
            const float* cu = sv + (fwd ? 0 : 128); const float* dt = sv + (fwd ? 256 : 384);
            const float4 c0 = *(const float4*)(cu + kk), c1 = *(const float4*)(cu + kk + 4), d0 = *(const float4*)(dt + kk), d1 = *(const float4*)(dt + kk + 4);
            const float cus[8] = {c0.x, c0.y, c0.z, c0.w, c1.x, c1.y, c1.z, c1.w}, dts[8] = {d0.x, d0.y, d0.z, d0.w, d1.x, d1.y, d1.z, d1.w};
            const float cl = cu[r];
#pragma unroll
            for (int e = 0; e < 8; ++e) {
                const int s = kk + e;
                const bool on = fwd ? (s <= r) : (s >= r);
                const float ex = fwd ? __expf(cl - cus[e]) : __expf(cus[e] - cl);
                float v = on ? cbv[e] * ex * dts[e] : 0.f;
                if (fwd && s == r) v += dsk;
                f[e] = v;
            }
        } else {
            unpack8(as_uint4(x.q0), f);
            const float sc = seg == 1 ? __expf(sv[r]) : __expf(totb - sv[128 + r]);
#pragma unroll
            for (int e = 0; e < 8; ++e) f[e] *= sc;
        }
        return pack8(f);
    }
};
struct LdXS {
    const bf16_t* xt; const bf16_t* sf; const bf16_t* sb;
    DEV RawV raw(int, int r, int kcg) const {
        const int seg = kcg >> 4, kk = (kcg & 15) * 8;
        const bf16_t* base = (seg == 1) ? sf : (seg == 3 ? sb : xt);
        RawV x; x.q0 = *(const u32x4*)(base + (size_t)r * 128 + kk); return x;
    }
    DEV uint4 fin(const RawV& x, int, int, int) const { return as_uint4(x.q0); }
};
struct EpSsd {
    const bf16_t* z; bf16_t* o; float* ssq;
    u32x4 zr[4];
    DEV void pre(int tid) {
#pragma unroll
        for (int i = 0; i < 4; ++i) { const int id = tid + 256 * i, r = id >> 3, c8 = id & 7; zr[i] = *(const u32x4*)(z + (size_t)r * NIN + c8 * 8); }
    }
    DEV void operator()(const float* ct, int tid) const {
#pragma unroll
        for (int i = 0; i < 4; ++i) {
            const int id = tid + 256 * i, r = id >> 3, c8 = id & 7;
            float v[8], zz[8]; ld8f(ct, r * 64 + c8 * 8, v);
            unpack8(as_uint4(zr[i]), zz);
            float ss = 0.f;
#pragma unroll
            for (int e = 0; e < 8; ++e) { v[e] *= silu_f(zz[e]); ss += v[e] * v[e]; }
            *(uint4*)(o + (size_t)r * DM + c8 * 8) = pack8(v);
            ss += __shfl_xor(ss, 1); ss += __shfl_xor(ss, 2); ss += __shfl_xor(ss, 4);
            if (c8 == 0) ssq[(size_t)r * 8] = ss;
        }
    }
};
DEV void phase_pf(const P& p, int layer, unsigned char* lds) {
    const bf16_t* XT = (const bf16_t*)(wsp(p) + WS_XT); const bf16_t* CF = (const bf16_t*)(wsp(p) + WS_CF); const bf16_t* SST = (const bf16_t*)(wsp(p) + WS_SST);
    const float* CB = (const float*)(wsp(p) + WS_CB); const float* CUM = (const float*)(wsp(p) + WS_CUM); const float* DTT = (const float*)(wsp(p) + WS_DTT); const float* TOT = (const float*)(wsp(p) + WS_TOT);
    const bf16_t* QK = (const bf16_t*)(wsp(p) + WS_QKVZX); bf16_t* AS = (bf16_t*)(wsp(p) + WS_AS); float* SSQ = (float*)(wsp(p) + WS_SSQ);
    const int nch = (layer == 0) ? NCH : NCHL;
    const int tid = tidx(), lane = tid & 63, wid = tid >> 6, lr = lane & 31, lh = lane >> 5;
    float* sv = (float*)(lds + wid * 2048);
    for (int u = vbid(); u < nch * 8; u += vgrid()) {
        const int ch = u >> 3, h = u & 7, g = h >> 2, tok0 = ch * 128, l = wid * 32 + lr;
        {
            const float* c0 = CUM + ((size_t)ch * 16 + h) * 128 + lane; const float* d0 = DTT + ((size_t)ch * 16 + h) * 128 + lane;
            const float a0 = c0[0], a1 = c0[64], b0 = c0[1024], b1 = c0[1088], e0 = d0[0], e1 = d0[64], f0 = d0[1024], f1 = d0[1088];
            sv[lane] = a0; sv[64 + lane] = a1; sv[128 + lane] = b0; sv[192 + lane] = b1; sv[256 + lane] = e0; sv[320 + lane] = e1; sv[384 + lane] = f0; sv[448 + lane] = f1;
        }
        const float totb = TOT[ch * 16 + 8 + h], dsk = p.d_skip[layer * 8 + h];
        const char* cbU = uni_ptr(CB + ((size_t)ch * 2 + g) * 128 * 128); const char* xtU = uni_ptr(XT + ((size_t)ch * 8 + h) * 64 * 128);
        const char* cmU = uni_ptr(CF + ((size_t)ch * 2 + g) * 128 * 128);
        const char* sfU = uni_ptr(SST + (((size_t)ch * 2 + 0) * 8 + h) * 64 * 128); const char* sbU = uni_ptr(SST + (((size_t)ch * 2 + 1) * 8 + h) * 64 * 128);
        unsigned ocb = (unsigned)(lh * 128 + l) * 32u, oxt = (unsigned)(lh * 64 + lr) * 16u, ocm = (unsigned)(lh * 128 + l) * 16u;
        asm volatile("" : "+v"(ocb), "+v"(oxt), "+v"(ocm));
#define PF_LD16(base, voff, imm) (*(const u32x4*)((base) + (voff) + (imm)))
        u32x4 rc0[8], rc1[8], rx0[8], rx1[8];
#pragma unroll
        for (int i = 0; i < 8; ++i) { rc0[i] = PF_LD16(cbU, ocb, 8192 * i); rc1[i] = PF_LD16(cbU, ocb, 8192 * i + 16); rx0[i] = PF_LD16(xtU, oxt, 2048 * i); rx1[i] = PF_LD16(xtU, oxt, 2048 * i + 512); }
        f32x16 acc[2];
#pragma unroll
        for (int e = 0; e < 16; ++e) { acc[0][e] = 0.f; acc[1][e] = 0.f; }
        const float cfl = sv[l], cbl = sv[128 + l];
        u32x4 rcm[8], rf0[8], rf1[8], rb0[8], rb1[8];
#pragma unroll
        for (int i = 0; i < 8; ++i) {
            const int sb = 16 * i + 8 * lh;
            const float4 q0 = *(const float4*)(sv + sb), q1 = *(const float4*)(sv + sb + 4), q2 = *(const float4*)(sv + 128 + sb), q3 = *(const float4*)(sv + 128 + sb + 4);
            const float4 q4 = *(const float4*)(sv + 256 + sb), q5 = *(const float4*)(sv + 256 + sb + 4), q6 = *(const float4*)(sv + 384 + sb), q7 = *(const float4*)(sv + 384 + sb + 4);
            const float cfs[8] = {q0.x, q0.y, q0.z, q0.w, q1.x, q1.y, q1.z, q1.w}, cbs[8] = {q2.x, q2.y, q2.z, q2.w, q3.x, q3.y, q3.z, q3.w};
            const float dfs[8] = {q4.x, q4.y, q4.z, q4.w, q5.x, q5.y, q5.z, q5.w}, dbs[8] = {q6.x, q6.y, q6.z, q6.w, q7.x, q7.y, q7.z, q7.w};
            float gv[8];
#pragma unroll
            for (int j = 0; j < 8; ++j) {
                const int s = sb + j;
                const float cbv = __uint_as_float(j < 4 ? rc0[i][j & 3] : rc1[i][j & 3]);
                const float arg = s < l ? cfl - cfs[j] : cbs[j] - cbl;
                float dtv = s < l ? dfs[j] : dbs[j];
                if (s == l) dtv += dfs[j];
                float v = cbv * __expf(arg) * dtv;
                if (s == l) v += dsk;
                gv[j] = v;
            }
            const bf16x8 gf = __builtin_bit_cast(bf16x8, pack8(gv));
            acc[0] = __builtin_amdgcn_mfma_f32_32x32x16_bf16(__builtin_bit_cast(bf16x8, rx0[i]), gf, acc[0], 0, 0, 0);
            acc[1] = __builtin_amdgcn_mfma_f32_32x32x16_bf16(__builtin_bit_cast(bf16x8, rx1[i]), gf, acc[1], 0, 0, 0);
            rcm[i] = PF_LD16(cmU, ocm, 4096 * i); rf0[i] = PF_LD16(sfU, oxt, 2048 * i); rf1[i] = PF_LD16(sfU, oxt, 2048 * i + 512);
            rb0[i] = PF_LD16(sbU, oxt, 2048 * i); rb1[i] = PF_LD16(sbU, oxt, 2048 * i + 512);
            __builtin_amdgcn_sched_barrier(0);
        }
        const char* zU = uni_ptr(QK + (size_t)tok0 * NIN + C_Z + h * 64);
        unsigned oz = (unsigned)(l * NIN + 4 * lh) * 2u; asm volatile("" : "+v"(oz));
        uint2 zr[8];
#pragma unroll
        for (int q = 0; q < 8; ++q) zr[q] = *(const uint2*)(zU + oz + 16 * q);
        const float af = __expf(cfl), ab = __expf(totb - cbl);
#pragma unroll
        for (int i = 0; i < 8; ++i) {
            float c[8], cf8[8], cb8[8];
            unpack8(as_uint4(rcm[i]), c);
#pragma unroll
            for (int j = 0; j < 8; ++j) { cf8[j] = c[j] * af; cb8[j] = c[j] * ab; }
            const bf16x8 ff = __builtin_bit_cast(bf16x8, pack8(cf8)), fb = __builtin_bit_cast(bf16x8, pack8(cb8));
            acc[0] = __builtin_amdgcn_mfma_f32_32x32x16_bf16(__builtin_bit_cast(bf16x8, rf0[i]), ff, acc[0], 0, 0, 0);
            acc[1] = __builtin_amdgcn_mfma_f32_32x32x16_bf16(__builtin_bit_cast(bf16x8, rf1[i]), ff, acc[1], 0, 0, 0);
            acc[0] = __builtin_amdgcn_mfma_f32_32x32x16_bf16(__builtin_bit_cast(bf16x8, rb0[i]), fb, acc[0], 0, 0, 0);
            acc[1] = __builtin_amdgcn_mfma_f32_32x32x16_bf16(__builtin_bit_cast(bf16x8, rb1[i]), fb, acc[1], 0, 0, 0);
        }
        bf16_t* op = AS + (size_t)(tok0 + l) * DM + h * 64 + 4 * lh;
#undef PF_LD16
        float ss = 0.f;
#pragma unroll
        for (int pt = 0; pt < 2; ++pt)
#pragma unroll
            for (int q = 0; q < 4; ++q) {
                const uint2 zz = zr[pt * 4 + q];
                const float z0 = bflo(zz.x), z1 = bfhi(zz.x), z2 = bflo(zz.y), z3 = bfhi(zz.y);
                const float y0 = acc[pt][4 * q] * silu_f(z0), y1 = acc[pt][4 * q + 1] * silu_f(z1), y2 = acc[pt][4 * q + 2] * silu_f(z2), y3 = acc[pt][4 * q + 3] * silu_f(z3);
                ss += (y0 * y0 + y1 * y1) + (y2 * y2 + y3 * y3);
                *(uint2*)(op + 32 * pt + 8 * q) = make_uint2(pk2(y0, y1), pk2(y2, y3));
            }
        ss += __shfl_xor(ss, 32);
        if (lh == 0) SSQ[(size_t)(tok0 + l) * 8 + h] = ss;
    }
}

DEV float fexp2(float x) { return __builtin_amdgcn_exp2f(x); }
#define ATT_SCORE(S_, qf_, m_, kb_) do { \
        _Pragma("unroll") for (int mt = 0; mt < 2; ++mt) _Pragma("unroll") for (int e = 0; e < 16; ++e) S_[mt][e] = -(m_); \
        __builtin_amdgcn_s_setprio(1); \
        _Pragma("unroll") for (int kk = 0; kk < 4; ++kk) _Pragma("unroll") for (int mt = 0; mt < 2; ++mt) \
            S_[mt] = __builtin_amdgcn_mfma_f32_32x32x16_bf16(kf[kk][mt], qf_[kk], S_[mt], 0, 0, 0); \
        __builtin_amdgcn_s_setprio(0); } while (0)
#define ATT_SOFTMAX(S_, m_, l_, ot_, pb_) do { \
        float mx = S_[0][0]; \
        _Pragma("unroll") for (int e = 1; e < 16; ++e) mx = fmaxf(mx, S_[0][e]); \
        _Pragma("unroll") for (int e = 0; e < 16; ++e) mx = fmaxf(mx, S_[1][e]); \
        mx = fmaxf(mx, __shfl_xor(mx, 32)); \
        if (!__all(mx <= 8.f)) { \
            const float dm = fmaxf(mx, 0.f), alpha = fexp2(-dm); \
            m_ += dm; l_ *= alpha; \
            _Pragma("unroll") for (int dt = 0; dt < 2; ++dt) _Pragma("unroll") for (int e = 0; e < 16; ++e) ot_[dt][e] *= alpha; \
            _Pragma("unroll") for (int mt = 0; mt < 2; ++mt) _Pragma("unroll") for (int e = 0; e < 16; ++e) S_[mt][e] -= dm; \
        } \
        float ps = 0.f; \
        _Pragma("unroll") for (int mt = 0; mt < 2; ++mt) _Pragma("unroll") for (int e = 0; e < 16; ++e) { S_[mt][e] = fexp2(S_[mt][e]); ps += S_[mt][e]; } \
        l_ += ps; \
        _Pragma("unroll") for (int mt = 0; mt < 2; ++mt) _Pragma("unroll") for (int sx = 0; sx < 2; ++sx) { \
            const u32x4 pbu = {pk2(S_[mt][8 * sx], S_[mt][8 * sx + 1]), pk2(S_[mt][8 * sx + 2], S_[mt][8 * sx + 3]), pk2(S_[mt][8 * sx + 4], S_[mt][8 * sx + 5]), pk2(S_[mt][8 * sx + 6], S_[mt][8 * sx + 7])}; \
            pb_[mt][sx] = __builtin_bit_cast(bf16x8, pbu); } } while (0)
DEV void attn_unit(unsigned char* lds, const bf16_t* QP, const bf16_t* KP, const bf16_t* VT, bf16_t* AS, int b, int kvh, int hqa, int hqb, int tokA0, int tokB0, bool lat) {
    const int tid = tid512(), lane = tid & 63, wid = tid >> 6, lr = lane & 31, lh = lane >> 5;
    const int ntl = lat ? NKEY / 64 : LC / 64;
    const int tokA = tokA0 + wid * 32 + lr, tokB = tokB0 + wid * 32 + lr;
    bf16x8 qa[4], qb[4];
#pragma unroll
    for (int kk = 0; kk < 4; ++kk) { qa[kk] = *(const bf16x8*)(QP + (size_t)tokA * 512 + hqa * 64 + (2 * kk + lh) * 8); qb[kk] = *(const bf16x8*)(QP + (size_t)tokB * 512 + hqb * 64 + (2 * kk + lh) * 8); }
    f32x16 oa[2], ob[2];
#pragma unroll
    for (int dt = 0; dt < 2; ++dt)
#pragma unroll
        for (int e = 0; e < 16; ++e) { oa[dt][e] = 0.f; ob[dt][e] = 0.f; }
    float ma = 0.f, la = 0.f, mb = 0.f, lb = 0.f;
    const int sr = tid >> 3, sc = tid & 7;
    const bf16_t* vbase = VT + ((size_t)(b * 2 + kvh) * 64) * NKEY;
    const int fsw = (sc ^ ((sr >> 1) & 7)) << 4;
    u32x4 rk, rv;
#define ATT_LD(t_) do { const int tq = (t_); const int ktok0 = tq < 4 ? TL + b * LC + tq * 64 : b * SEQ + (tq - 4) * 64; \
        rk = *(const u32x4*)(KP + (size_t)(ktok0 + sr) * 128 + kvh * 64 + sc * 8); \
        rv = *(const u32x4*)(vbase + (size_t)sr * NKEY + tq * 64 + sc * 8); } while (0)
#define ATT_ST(buf_) do { unsigned char* kb_ = lds + (buf_) * 16384; unsigned char* vb_ = kb_ + 8192; \
        *(u32x4*)(kb_ + sr * 128 + fsw) = rk; \
        *(u32x4*)(vb_ + sr * 128 + fsw) = ((sr >> 4) & 1) ? __builtin_shufflevector(rv, rv, 2, 3, 0, 1) : rv; } while (0)
    const int rsw = (lr >> 1) & 7, hsw = (lr >> 4) & 1;
    ATT_LD(0);
    __syncthreads();
    ATT_ST(0);
    ATT_LD(1);
    ATT_ST(1);
    __syncthreads();
    for (int t = 0; t < ntl; ++t) {
        if (t + 2 < ntl) ATT_LD(t + 2);
        const unsigned char* kb = lds + (t % 3) * 16384; const unsigned char* vb = kb + 8192;
        bf16x8 kf[4][2];
#pragma unroll
        for (int kk = 0; kk < 4; ++kk)
#pragma unroll
            for (int mt = 0; mt < 2; ++mt) kf[kk][mt] = *(const bf16x8*)(kb + (mt * 32 + lr) * 128 + (((2 * kk + lh) ^ rsw) << 4));
        f32x16 st[2]; bf16x8 pa[2][2], pbb[2][2];
        ATT_SCORE(st, qa, ma, kb);
        ATT_SOFTMAX(st, ma, la, oa, pa);
        ATT_SCORE(st, qb, mb, kb);
        ATT_SOFTMAX(st, mb, lb, ob, pbb);
#pragma unroll
        for (int mt = 0; mt < 2; ++mt)
#pragma unroll
            for (int sx = 0; sx < 2; ++sx) {
                bf16x8 va[2];
#pragma unroll
                for (int dt = 0; dt < 2; ++dt) {
                    const unsigned char* vr = vb + (dt * 32 + lr) * 128 + ((lh ^ hsw) << 3);
                    const int c0 = 4 * mt + 2 * sx;
                    const uint2 h0 = *(const uint2*)(vr + ((c0 ^ rsw) << 4)), h1 = *(const uint2*)(vr + (((c0 + 1) ^ rsw) << 4));
                    va[dt] = __builtin_bit_cast(bf16x8, (u32x4){h0.x, h0.y, h1.x, h1.y});
                }
#pragma unroll
                for (int dt = 0; dt < 2; ++dt) {
                    oa[dt] = __builtin_amdgcn_mfma_f32_32x32x16_bf16(va[dt], pa[mt][sx], oa[dt], 0, 0, 0);
                    ob[dt] = __builtin_amdgcn_mfma_f32_32x32x16_bf16(va[dt], pbb[mt][sx], ob[dt], 0, 0, 0);
                }
            }
        if (t + 2 < ntl) ATT_ST((t + 2) % 3);
        __syncthreads();
    }
#undef ATT_LD
#undef ATT_ST
    la += __shfl_xor(la, 32); lb += __shfl_xor(lb, 32);
    const float ila = 1.f / la, ilb = 1.f / lb;
    bf16_t* rowA = AS + (size_t)tokA * DM + 512 + hqa * 64; bf16_t* rowB = AS + (size_t)tokB * DM + 512 + hqb * 64;
#pragma unroll
    for (int dt = 0; dt < 2; ++dt)
#pragma unroll
        for (int g = 0; g < 4; ++g) {
            const int d0 = 32 * dt + 8 * g + 4 * lh;
            *(uint2*)(rowA + d0) = make_uint2(pk2(oa[dt][4 * g] * ila, oa[dt][4 * g + 1] * ila), pk2(oa[dt][4 * g + 2] * ila, oa[dt][4 * g + 3] * ila));
            *(uint2*)(rowB + d0) = make_uint2(pk2(ob[dt][4 * g] * ilb, ob[dt][4 * g + 1] * ilb), pk2(ob[dt][4 * g + 2] * ilb, ob[dt][4 * g + 3] * ilb));
        }
}
DEV void phase_pg(const P& p, int layer, unsigned char* lds) {
    const bf16_t* QP = (const bf16_t*)(wsp(p) + WS_QP); const bf16_t* KP = (const bf16_t*)(wsp(p) + WS_KP); const bf16_t* VT = (const bf16_t*)(wsp(p) + WS_VT);
    bf16_t* AS = (bf16_t*)(wsp(p) + WS_AS);
    const int nctx = (layer == 0) ? 32 : 0;
    for (int u0 = blockIdx.x; u0 < 256 + nctx; u0 += gridDim.x) {
        const int u = (u0 < 256 && gridDim.x == 256) ? (u0 & 7) * 32 + (u0 >> 3) : u0;
        if (u < 256) { const int b = u >> 5, hq = (u >> 2) & 7, qb = u & 3; attn_unit(lds, QP, KP, VT, AS, b, hq >> 2, hq, hq, b * SEQ + qb * 512, b * SEQ + qb * 512 + 256, true); }
        else { const int uu = u - 256, b = uu >> 2, hp = uu & 3; attn_unit(lds, QP, KP, VT, AS, b, hp >> 1, 2 * hp, 2 * hp + 1, TL + b * LC, TL + b * LC, false); }
    }
}

struct EpiOut {
    static constexpr int MID_T = 8;
    bf16_t* O; const float* ssq;
    DEV void mid(g8::f32x4 (&acc)[2][2][4][2], const g8::Unit& u, int wr, int fr) const {
#pragma unroll
        for (int ai = 0; ai < 2; ++ai)
#pragma unroll
            for (int m = 0; m < 4; ++m) {
                const float* q = ssq + (size_t)(u.row0 + ai * 128 + wr * 64 + m * 16 + fr) * 8;
                const float4 a = *(const float4*)q, b = *(const float4*)(q + 4);
                const float rs = rsqrtf((((a.x + a.y) + (a.z + a.w)) + ((b.x + b.y) + (b.z + b.w))) * (1.f / 512.f) + EPS);
#pragma unroll
                for (int bj = 0; bj < 2; ++bj)
#pragma unroll
                    for (int n = 0; n < 2; ++n) acc[ai][bj][m][n] = acc[ai][bj][m][n] * rs;
            }
    }
    DEV void operator()(const g8::f32x4 (&acc)[2][2][4][2], const g8::Unit& u, int wr, int wc, int fr, int fq) const { g8::EpiStore{O, DM}(acc, u, wr, wc, fr, fq); }
};
DEV void phase_ph(const P& p, int layer, LAS unsigned char* lds) {
    const int nt = (layer == 0) ? TT : TL;
    g8::SchedDense S{(const bf16_t*)(wsp(p) + WS_AS), (const bf16_t*)(wsp(p) + WS_WOUT), DM, DM, nt / 256, DM / 256, (int)gridDim.x, (int)blockIdx.x};
    EpiOut E{(bf16_t*)(wsp(p) + WS_ML), (const float*)(wsp(p) + WS_SSQ)};
    g8::gemm(lds, S, E, DM / 64, DM);
}

struct MoeMap { int offs[66]; int tp[66]; };
DEV void build_map(const P& p, int layer, MoeMap* mm) {
    const unsigned* cnt = (const unsigned*)(wsp(p) + WS_CTL) + CW_CNT + layer * CNT_LAYER;
    const int nt = (layer == 0) ? TT : TL;
    __syncthreads();
    if (tidx() == 0) {
        int o = 0, t = 0;
        for (int e = 0; e < 65; ++e) {
            const int c = e < 64 ? (int)__hip_atomic_load(&cnt[e * CNT_STRIDE], __ATOMIC_RELAXED, __HIP_MEMORY_SCOPE_AGENT) : nt;
            mm->offs[e] = o; mm->tp[e] = t; o += c; t += (c + 255) >> 8;
        }
        mm->offs[65] = o; mm->tp[65] = t;
    }
    __syncthreads();
}
template <class MP> DEV int find_expert(MP mm, int ti) {
    const int l = hw_lane(); const bool le = mm->tp[l + 1] <= ti;
    return (int)__popcll(__ballot(le));
}

template <int mode> struct SchedMoe {
    static constexpr bool GATHER = (mode == 0), F8 = true;
    const MoeMap* mm; int nsub, G, c;
    const bf16_t* A; const bf16_t* W0; const bf16_t* W1; const uint2* LIST;
    DEV bool next(int i, g8::Unit& u) const {
        const LAS MoeMap* mm; { unsigned o = (unsigned)(size_t)(const LAS MoeMap*)this->mm; asm volatile("" : "+s"(o)); mm = (const LAS MoeMap*)(size_t)o; }
        const int ntile = __builtin_amdgcn_readfirstlane(mm->tp[65]), w = g8::deal(i, G, c, ntile * nsub); if (w < 0) return false;
        const int ti = w / nsub, sub = w % nsub, e = __builtin_amdgcn_readfirstlane(find_expert(mm, ti)), tt = __builtin_amdgcn_readfirstlane(ti - mm->tp[e]);
        const int cnt_e = __builtin_amdgcn_readfirstlane(mm->offs[e + 1] - mm->offs[e]), nvalid = min(256, cnt_e - tt * 256), slot0 = __builtin_amdgcn_readfirstlane(mm->offs[e]) + tt * 256;
        u.row0 = slot0; u.nvalid = nvalid; u.sub = sub;
        if (mode == 0) {
            u.a = (const char*)A; u.b0 = (const char*)W0 + ((size_t)e * FE + sub * 128) * DM; u.b1 = (const char*)W1 + ((size_t)e * FE + sub * 128) * DM;
            u.aux = e < 64 ? (const void*)(LIST + (size_t)e * CAP + tt * 256) : nullptr; u.col0 = tt * 256;
        } else {
            u.a = (const char*)A + (size_t)slot0 * FE; u.b0 = (const char*)W0 + ((size_t)e * DM + sub * 256) * FE; u.b1 = u.b0 + (size_t)128 * FE;
            u.aux = nullptr; u.col0 = sub * 256;
        }
        return true;
    }
    DEV size_t a_half() const { return mode == 0 ? (size_t)0 : (size_t)128 * FE; }
    DEV void a_off(const g8::Unit& u, unsigned (&v0)[2], unsigned (&v1)[2]) const {
        const int tz = tid512();
        if (mode == 0) {
            const uint2* lst = (const uint2*)u.aux;
#pragma unroll
            for (int i = 0; i < 2; ++i) {
                int R, C; g8::stage_rc(tz * 16 + i * 8192, R, C);
                const int ra = R < u.nvalid ? R : 0, rb = (128 + R) < u.nvalid ? 128 + R : 0;
                const unsigned ta = lst ? lst[ra].x : (unsigned)(u.col0 + ra), tb = lst ? lst[rb].x : (unsigned)(u.col0 + rb);
                v0[i] = ta * (unsigned)DM + (unsigned)C * 2u; v1[i] = tb * (unsigned)DM + (unsigned)C * 2u;
            }
        } else {
#pragma unroll
            for (int i = 0; i < 2; ++i) { int R, C; g8::stage_rc(tz * 16 + i * 8192, R, C); v0[i] = (unsigned)(R * FE + C * 2); v1[i] = v0[i]; }
        }
    }
};
struct EpiAct {
    static constexpr int MID_T = 0;
    unsigned char* act;
    DEV void operator()(const g8::f32x4 (&acc)[2][2][4][2], const g8::Unit& u, int wr, int wc, int fr, int fq) const {
        const uint2* lst = (const uint2*)u.aux;
#pragma unroll
        for (int ai = 0; ai < 2; ++ai)
#pragma unroll
            for (int m = 0; m < 4; ++m) {
                const int r = ai * 128 + wr * 64 + m * 16 + fr;
                if (r < u.nvalid) {
                    const float gate = (lst ? __builtin_bit_cast(float, lst[r].y) : 1.f) * (GU_DESCALE * A8_SCALE);
                    float o[8];
#pragma unroll
                    for (int n = 0; n < 2; ++n)
#pragma unroll
                        for (int j = 0; j < 4; ++j) o[4 * n + j] = silu_f(acc[ai][0][m][n][j] * GU_DESCALE) * acc[ai][1][m][n][j] * gate;
                    *(uint2*)(act + (size_t)(u.row0 + r) * FE + u.sub * 128 + wc * 32 + 8 * fq) = make_uint2(pk4_f8(o[0], o[1], o[2], o[3]), pk4_f8(o[4], o[5], o[6], o[7]));
                }
            }
    }
};
DEV void phase_pj(const P& p, int layer, LAS unsigned char* lds, MoeMap* mm) {
    build_map(p, layer, mm);
    SchedMoe<0> S{mm, 2, (int)gridDim.x, (int)blockIdx.x, (const bf16_t*)(wsp(p) + WS_H), (const bf16_t*)(wsp(p) + WS_WG), (const bf16_t*)(wsp(p) + WS_WU), (const uint2*)(wsp(p) + WS_LIST)};
    EpiAct E{(unsigned char*)(wsp(p) + WS_ACT)};
    g8::gemm(lds, S, E, DM / 128, DM / 2);
}
template <bool FP8> DEV void phase_pk(const P& p, int layer, LAS unsigned char* lds, MoeMap* mm) {
    build_map(p, layer, mm);
    SchedMoe<1> S{mm, 4, (int)gridDim.x, (int)blockIdx.x, (const bf16_t*)(wsp(p) + WS_ACT), (const bf16_t*)(wsp(p) + WS_WD), nullptr, nullptr};
    static_assert(FP8, "the down projection runs on e4m3 operands and parks e4m3 outputs");
    g8::EpiStore8 E{(unsigned char*)(wsp(p) + WS_YH), DM, DN_RESCALE}; g8::gemm(lds, S, E, FE / 128, FE / 2);
}
template <int RPW> DEV void phase_pm(const P& p, int layer, unsigned char* lds, MoeMap* mm, int row0, int nrows) {
    const bool last = (layer == 1);
    const int tid = tidx(), lane = tid & 63, wid = tid >> 6;
    const float* MOD = (const float*)(wsp(p) + WS_MOD);
    const bf16_t* YH = (const bf16_t*)(wsp(p) + WS_YH); const unsigned* TOPK = (const unsigned*)(wsp(p) + WS_TOPK);
    bf16_t* XB = (bf16_t*)(wsp(p) + WS_XB);
    bf16_t* H = (bf16_t*)(wsp(p) + WS_HIN1); float* DT = (float*)(wsp(p) + WS_DT);
    float* hl = (float*)lds; float* part = (float*)(lds + HL_BYTES);
    build_map(p, layer, mm);
    for (int task = vbid(); task < nrows / (4 * RPW); task += vgrid()) {
        const int tok0 = row0 + task * (4 * RPW) + wid * RPW;
        bf16_t* xb = XB + (size_t)tok0 * DM;
        const int mr = tok0 < TL ? tok0 / SEQ : 8;
        const float* md = MOD + ((size_t)layer * 9 + mr) * 6144;
        const float* md1 = MOD + ((size_t)(last ? layer : layer + 1) * 9 + mr) * 6144;
        float pa[16], pb[16], pc[16];
        ld_row16(md + 5120, lane, pa); ld_row16(md1 + 1024, lane, pb); ld_row16(md1 + 0, lane, pc);
        __syncthreads();
#pragma unroll 1
        for (int rr = 0; rr < RPW; ++rr) {
            const int tok = tok0 + rr;
            float x[16], y[16];
            ld_row16_bf(xb + (size_t)rr * DM, lane, x);
#pragma unroll
            for (int e = 0; e < 16; ++e) y[e] = 0.f;
#pragma unroll
            for (int k = 0; k < 9; ++k) {
                int slot;
                if (k < 8) { const unsigned tk = TOPK[(size_t)tok * 8 + k]; slot = mm->offs[tk & 255u] + (int)(tk >> 8); } else slot = mm->offs[64] + tok;
#pragma unroll
                for (int i = 0; i < 4; ++i) {
                    if (true) {
                        typedef float f32x2v __attribute__((ext_vector_type(2)));
                        const int q = *(const int*)((const unsigned char*)YH + (size_t)slot * DM + 4 * lane + 256 * i);
                        const f32x2v lo = __builtin_amdgcn_cvt_pk_f32_fp8(q, false), hi = __builtin_amdgcn_cvt_pk_f32_fp8(q, true);
                        y[4 * i] += lo[0]; y[4 * i + 1] += lo[1]; y[4 * i + 2] += hi[0]; y[4 * i + 3] += hi[1];
                    } else {
                        const uint2 q = *(const uint2*)(YH + (size_t)slot * DM + 4 * lane + 256 * i);
                        y[4 * i] += bflo(q.x); y[4 * i + 1] += bfhi(q.x); y[4 * i + 2] += bflo(q.y); y[4 * i + 3] += bfhi(q.y); }
                }
            }
            {
#pragma unroll
                for (int e = 0; e < 16; ++e) y[e] *= 0.0625f; }
            const float rsy = rstd16(y);
#pragma unroll
            for (int e = 0; e < 16; ++e) x[e] += pa[e] * (y[e] * rsy);
            if (last) st_row16(p.out + (size_t)tok * DM, lane, x); else st_row16_bf(xb + (size_t)rr * DM, lane, x);
            if (!last) {
                const float rs = rstd16(x);
                float h[16];
#pragma unroll
                for (int e = 0; e < 16; ++e) h[e] = x[e] * rs * pb[e] + pc[e];
                st_row16_bf(H + (size_t)tok * DM, lane, h);
                st_row16(hl + (wid * RPW + rr) * HLS, lane, h);
            }
        }
        if (!last) {
            __syncthreads();
            dt_tail16<RPW>(hl, (const float4*)(wsp(p) + WS_WD2) + 4096 * (layer + 1), p.dt_bias + (layer + 1) * 16, part, DT, row0 + task * (4 * RPW), tid);
        }
    }
}

#define XB_TMO      128
#define XB_XCNT(j)  (256  + 64 * (j))
#define XB_XSUB(j)  (1280 + 64 * (j))
#define XB_XGEN(j)  (2304 + 64 * (j))
#define XB_TOP      3328
#define XB_TOPGEN   3392
#define XCD_BAR_WORDS 3456
#define XB_SPIN_CAP (1u << 18)
static_assert((CW_QH + 64) * 4 <= (int)CTL_BYTES && CW_CNT + 2 * CNT_LAYER <= CW_QH, "control words");
static_assert(XCD_BAR_WORDS <= CW_CNT, "barrier words below the expert counters");

__device__ __forceinline__ unsigned xb_ld(unsigned* p)              { return __hip_atomic_load(p, __ATOMIC_RELAXED, __HIP_MEMORY_SCOPE_AGENT); }
__device__ __forceinline__ unsigned xb_add(unsigned* p, unsigned v) { return __hip_atomic_fetch_add(p, v, __ATOMIC_RELAXED, __HIP_MEMORY_SCOPE_AGENT); }
__device__ __forceinline__ unsigned xb_xcc_id() { return (unsigned)__builtin_amdgcn_s_getreg((3 << 11) | 20) & 0xFu; }
#define XB_SPIN(cond, bar) do { unsigned _sp = 0; while (cond) { __builtin_amdgcn_s_sleep(1); \
    if ((++_sp & 255u) == 0u) { if (xb_ld(&(bar)[XB_TMO])) break; if (_sp > XB_SPIN_CAP) { atomicAdd(&(bar)[XB_TMO], 1u); break; } } } } while (0)

struct XcdBarrier {
    unsigned* bar; unsigned x;
    volatile LAS unsigned* st;
};
__device__ __forceinline__ XcdBarrier xcd_barrier_post(unsigned* bar, volatile LAS unsigned* st) {
    XcdBarrier b; b.bar = bar; b.x = xb_xcc_id(); b.st = st;
    if (tid512() == 0) (void)xb_add(&bar[XB_XCNT(b.x)], 1u);
    return b;
}
__device__ __forceinline__ void xcd_barrier_complete(unsigned* bar, unsigned x, unsigned& nloc, unsigned& nx) {
    const unsigned G = gridDim.x * gridDim.y * gridDim.z;
    unsigned sum, cnt, mine, sp = 0u;
    for (;;) {
        sum = 0u; cnt = 0u; mine = 0u;
#pragma unroll
        for (unsigned j = 0; j < 16; ++j) { const unsigned c = xb_ld(&bar[XB_XCNT(j)]); sum += c; cnt += (c > 0u) ? 1u : 0u; mine = (j == x) ? c : mine; }
        if (sum == G) break;
        __builtin_amdgcn_s_sleep(1);
        if ((++sp & 255u) == 0u) { if (xb_ld(&bar[XB_TMO])) break; if (sp > XB_SPIN_CAP) { atomicAdd(&bar[XB_TMO], 1u); break; } }
    }
    nloc = mine > 0u ? mine : 1u; nx = cnt > 0u ? cnt : 1u;
}
__device__ __forceinline__ void xcd_barrier(const XcdBarrier& b) {
    asm volatile("s_waitcnt vmcnt(0)" ::: "memory");
    __syncthreads();
    if (tid512() == 0) {
        unsigned* bar = b.bar;
        __builtin_amdgcn_s_waitcnt(0);
        unsigned nloc = b.st[0], nx = b.st[1];
        if (nloc == 0u) { xcd_barrier_complete(bar, b.x, nloc, nx); b.st[0] = nloc; b.st[1] = nx; }
        const unsigned old = xb_add(&bar[XB_XSUB(b.x)], 1u);
        const unsigned gen = old / nloc;
        if (old + 1u == (gen + 1u) * nloc) {
            __builtin_amdgcn_fence(__ATOMIC_RELEASE, "agent");
            asm volatile("s_waitcnt vmcnt(0)" ::: "memory");
            const unsigned og = xb_add(&bar[XB_TOP], 1u);
            const unsigned tg = og / nx;
            if (og + 1u == (tg + 1u) * nx) xb_add(&bar[XB_TOPGEN], 1u);
            else XB_SPIN(xb_ld(&bar[XB_TOPGEN]) == tg, bar);
            __builtin_amdgcn_fence(__ATOMIC_ACQUIRE, "agent");
            xb_add(&bar[XB_XGEN(b.x)], 1u);
            asm volatile("s_waitcnt vmcnt(0)" ::: "memory");
        } else {
            XB_SPIN(xb_ld(&bar[XB_XGEN(b.x)]) == gen, bar);
            __builtin_amdgcn_fence(__ATOMIC_ACQUIRE, "agent");
            asm volatile("s_waitcnt vmcnt(0)" ::: "memory");
        }
    }
    __syncthreads();
}

DEV unsigned long long rfl64(unsigned long long v) { const unsigned lo = __builtin_amdgcn_readfirstlane((unsigned)v), hi = __builtin_amdgcn_readfirstlane((unsigned)(v >> 32)); return ((unsigned long long)hi << 32) | lo; }
DEV void park_params(const P& p, LAS unsigned long long* tab) { tab[0] = (unsigned long long)p.x; tab[1] = (unsigned long long)p.c; tab[2] = (unsigned long long)p.ctx; tab[3] = (unsigned long long)p.c_ctx; tab[4] = (unsigned long long)p.w_mod; tab[5] = (unsigned long long)p.b_mod; tab[6] = (unsigned long long)p.g_pre_mix; tab[7] = (unsigned long long)p.g_post_mix; tab[8] = (unsigned long long)p.g_pre_ffn; tab[9] = (unsigned long long)p.g_post_ffn; tab[10] = (unsigned long long)p.w_in; tab[11] = (unsigned long long)p.q_norm; tab[12] = (unsigned long long)p.k_norm; tab[13] = (unsigned long long)p.conv_w; tab[14] = (unsigned long long)p.conv_b; tab[15] = (unsigned long long)p.dt_bias; tab[16] = (unsigned long long)p.a_log; tab[17] = (unsigned long long)p.d_skip; tab[18] = (unsigned long long)p.ssd_norm; tab[19] = (unsigned long long)p.w_out; tab[20] = (unsigned long long)p.router_w; tab[21] = (unsigned long long)p.router_bias; tab[22] = (unsigned long long)p.w_gate; tab[23] = (unsigned long long)p.w_up; tab[24] = (unsigned long long)p.w_down; tab[25] = (unsigned long long)p.ws_gate; tab[26] = (unsigned long long)p.ws_up; tab[27] = (unsigned long long)p.ws_down; tab[28] = (unsigned long long)p.out; tab[29] = (unsigned long long)p.ws; }
DEV P load_params(const LAS unsigned long long* tab) { P q; q.x = (const float*)(GAS const float*)rfl64(tab[0]); q.c = (const float*)(GAS const float*)rfl64(tab[1]); q.ctx = (const float*)(GAS const float*)rfl64(tab[2]); q.c_ctx = (const float*)(GAS const float*)rfl64(tab[3]); q.w_mod = (const float*)(GAS const float*)rfl64(tab[4]); q.b_mod = (const float*)(GAS const float*)rfl64(tab[5]); q.g_pre_mix = (const float*)(GAS const float*)rfl64(tab[6]); q.g_post_mix = (const float*)(GAS const float*)rfl64(tab[7]); q.g_pre_ffn = (const float*)(GAS const float*)rfl64(tab[8]); q.g_post_ffn = (const float*)(GAS const float*)rfl64(tab[9]); q.w_in = (const float*)(GAS const float*)rfl64(tab[10]); q.q_norm = (const float*)(GAS const float*)rfl64(tab[11]); q.k_norm = (const float*)(GAS const float*)rfl64(tab[12]); q.conv_w = (const float*)(GAS const float*)rfl64(tab[13]); q.conv_b = (const float*)(GAS const float*)rfl64(tab[14]); q.dt_bias = (const float*)(GAS const float*)rfl64(tab[15]); q.a_log = (const float*)(GAS const float*)rfl64(tab[16]); q.d_skip = (const float*)(GAS const float*)rfl64(tab[17]); q.ssd_norm = (const float*)(GAS const float*)rfl64(tab[18]); q.w_out = (const float*)(GAS const float*)rfl64(tab[19]); q.router_w = (const float*)(GAS const float*)rfl64(tab[20]); q.router_bias = (const float*)(GAS const float*)rfl64(tab[21]); q.w_gate = (const float*)(GAS const float*)rfl64(tab[22]); q.w_up = (const float*)(GAS const float*)rfl64(tab[23]); q.w_down = (const float*)(GAS const float*)rfl64(tab[24]); q.ws_gate = (const float*)(GAS const float*)rfl64(tab[25]); q.ws_up = (const float*)(GAS const float*)rfl64(tab[26]); q.ws_down = (const float*)(GAS const float*)rfl64(tab[27]); q.out = (float*)(GAS float*)rfl64(tab[28]); q.ws = (unsigned char*)(GAS unsigned char*)rfl64(tab[29]); return q; }
static_assert(g8::STAGE_BYTES + 512 * 16 <= LDS_HALF + LDS_MAIN, "the 8-wave GEMM's stage buffers + parking slots must stay below the second half's MoE map");
static_assert(HL_BYTES + 16 * 64 * 4 + 512 <= LDS_MAIN, "row-phase LDS");
__device__ __noinline__ void grid_bar() {
    const LAS unsigned long long* ptab = (const LAS unsigned long long*)(smem_all + LDS_PT);
    XcdBarrier bar_; bar_.bar = (unsigned*)(GAS unsigned*)rfl64(ptab[29]); bar_.x = xb_xcc_id(); bar_.st = (volatile LAS unsigned*)(smem_all + LDS_XB);
    xcd_barrier(bar_);
}
__global__ void __launch_bounds__(NTHR, 2) k_mega(P p0) {
    if ((threadIdx.x & 63) == 0) ((LAS int*)(smem_all + LDS_WT))[hw_slot()] = (int)(threadIdx.x >> 6);
    __syncthreads();
    unsigned char* smem = smem_all + vhalf() * LDS_HALF;
    MoeMap* mm = (MoeMap*)(smem + LDS_MAIN);
    LAS unsigned long long* ptab = (LAS unsigned long long*)(smem_all + LDS_PT);
    if (tid512() == 0) { *(uint4*)(smem_all + LDS_XB) = make_uint4(0u, 0u, 0u, 0u); park_params(p0, ptab); }
    __syncthreads();
    (void)xcd_barrier_post((unsigned*)(p0.ws + WS_CTL), (volatile LAS unsigned*)(smem_all + LDS_XB));
#define GRID_BAR() grid_bar()
    phase_p0(load_params(ptab), 0, smem, 2, true);
    GRID_BAR();
    phase_pa0<4>(load_params(ptab), smem, 0, TL); phase_pa0<1>(load_params(ptab), smem, TL, TC);
    GRID_BAR();
#define LAYER_BODY(layer) do { \
        phase_pb(load_params(ptab), layer, (LAS unsigned char*)smem_all); \
        if (layer == 0 && blockIdx.x >= 136) fill_strips(load_params(ptab), smem, 3); \
        if (layer == 1) phase_p0(load_params(ptab), 1, smem, 1, false);        \
        GRID_BAR(); \
        phase_pc(load_params(ptab), layer, smem); \
        GRID_BAR(); \
        phase_pd(load_params(ptab), smem); phase_pg(load_params(ptab), layer, smem_all); \
        GRID_BAR(); \
        phase_pe(load_params(ptab)); \
        GRID_BAR(); \
        phase_pf(load_params(ptab), layer, smem); \
        if (layer == 0 && blockIdx.x >= 64) fill_strips(load_params(ptab), smem, 1); \
        GRID_BAR(); \
        phase_ph(load_params(ptab), layer, (LAS unsigned char*)smem_all); \
        if (layer == 0 && blockIdx.x >= 32) fill_strips(load_params(ptab), smem, 3); \
        GRID_BAR(); \
        phase_pi<4>(load_params(ptab), layer, smem, 0, TL); if (layer == 0) phase_pi<1>(load_params(ptab), layer, smem, TL, TC); \
        if (layer == 0) fill_strips(load_params(ptab), smem, -1); \
        GRID_BAR(); \
        phase_pj(load_params(ptab), layer, (LAS unsigned char*)smem_all, (MoeMap*)(smem_all + LDS_HALF + LDS_MAIN)); \
        GRID_BAR(); \
        phase_pk<true>(load_params(ptab), layer, (LAS unsigned char*)smem_all, (MoeMap*)(smem_all + LDS_HALF + LDS_MAIN)); \
        GRID_BAR(); \
        phase_pm<4>(load_params(ptab), layer, smem, mm, 0, TL); if (layer == 0) phase_pm<1>(load_params(ptab), layer, smem, mm, TL, TC); \
        if (layer == 0) { phase_p0(load_params(ptab), 1, smem, 0, false); GRID_BAR(); } \
    } while (0)
    LAYER_BODY(0);
    LAYER_BODY(1);
#undef LAYER_BODY
}

extern "C" void kernel_launch(void* const* d_in, const int* in_sizes, int n_in, void* d_out, int out_size, void* d_ws, size_t ws_size, hipStream_t stream) {
    if (ws_size < WS_END) { fprintf(stderr, "workspace too small: %zu < %zu\n", ws_size, (size_t)WS_END); return; }
    static int grid = 0;
    if (!grid) {
        int dev = 0, cus = 0, per_cu = 0;
        (void)hipGetDevice(&dev);
        (void)hipDeviceGetAttribute(&cus, hipDeviceAttributeMultiprocessorCount, dev);
        (void)hipFuncSetAttribute((const void*)k_mega, hipFuncAttributeMaxDynamicSharedMemorySize, LDS_BYTES);
        (void)hipOccupancyMaxActiveBlocksPerMultiprocessor(&per_cu, (const void*)k_mega, NTHR, LDS_BYTES);
        if (per_cu < 1) per_cu = 1;
        grid = cus;
    }
    P p{};
    const float** pp = (const float**)&p;
    for (int i = 0; i < 28; ++i) pp[i] = (const float*)d_in[i];
    p.out = (float*)d_out; p.ws = (unsigned char*)d_ws;
    (void)hipMemsetAsync(d_ws, 0, CTL_BYTES, stream);
    hipLaunchKernelGGL(k_mega, dim3(grid), dim3(NTHR), LDS_BYTES, stream, p);
}
```

```cpp
#include <hip/hip_runtime.h>
#include <stdint.h>
#include <stdio.h>

#define DEV __device__ __forceinline__
typedef unsigned short bf16_t;
typedef short bf16x8 __attribute__((ext_vector_type(8)));
typedef float f32x16 __attribute__((ext_vector_type(16)));
typedef __bf16 bf16x2_t __attribute__((ext_vector_type(2)));
typedef float f32x2_t __attribute__((ext_vector_type(2)));
typedef unsigned u32x4 __attribute__((ext_vector_type(4)));
typedef unsigned u32x2 __attribute__((ext_vector_type(2)));
typedef float f32x4v __attribute__((ext_vector_type(4)));

constexpr int NB = 8, SEQ = 2048, LC = 256, DM = 1024;
constexpr int TL = NB * SEQ, TC = NB * LC, TT = TL + TC;
constexpr int NCH = TT / 128, NCHL = TL / 128;
constexpr int NIN = 2304, NINF = 2320;
constexpr int C_Q = 0, C_K = 512, C_V = 640, C_Z = 768, C_X = 1280;
constexpr int NKEY = LC + SEQ;
constexpr int NEXP = 64, FE = 256, CAP = TT;
constexpr float EPS = 1e-6f;
constexpr float QSCALE = 0.125f * 1.4426950408889634f;
constexpr int NTHR = 512;
#define NWAVE_TOT (vgrid() * 4)

constexpr size_t al256(size_t x) { return (x + 255) & ~(size_t)255; }
constexpr size_t WS_CTL = 0, CTL_BYTES = 65536;
constexpr size_t WS_MOD = WS_CTL + CTL_BYTES;
constexpr size_t WS_ROPE = WS_MOD + al256((size_t)2 * 9 * 6144 * 4);
constexpr size_t WS_RW2 = WS_ROPE + (size_t)2048 * 32 * 8;
constexpr size_t WS_WD2 = WS_RW2 + (size_t)2 * 65536 * 4;
constexpr size_t WS_WIN = WS_WD2 + (size_t)2 * 16384 * 4;
constexpr size_t WS_WOUT = WS_WIN + (size_t)NIN * DM * 2;
constexpr size_t WS_WD = WS_WOUT + (size_t)DM * DM * 2;
constexpr size_t WS_XB = WS_WD + (size_t)65 * FE * DM * 2;
constexpr size_t WS_DT = WS_XB + (size_t)TT * DM * 2;
constexpr size_t WS_TOPK = WS_DT + (size_t)TT * 16 * 4;
constexpr size_t WS_LIST = WS_TOPK + (size_t)TT * 8 * 4;
constexpr size_t WS_CUM = WS_LIST + (size_t)NEXP * CAP * 8;
constexpr size_t WS_WST = WS_CUM + (size_t)NCH * 16 * 128 * 4;
constexpr size_t WS_DTT = WS_WST + (size_t)NCH * 16 * 128 * 4;
constexpr size_t WS_TOT = WS_DTT + (size_t)NCH * 16 * 128 * 4;
constexpr size_t WS_SSQ = WS_TOT + al256((size_t)NCH * 16 * 4);
constexpr size_t WS_ACT = WS_SSQ + (size_t)TT * 8 * 4;
constexpr size_t WS_HIN1 = WS_ACT;
constexpr size_t WS_WG = WS_ACT + (size_t)TT * 9 * FE * 2;
constexpr size_t WS_YH = WS_WG;
constexpr size_t WS_WU = WS_WG + (size_t)65 * FE * DM * 2;
constexpr size_t WS_H = WS_WU + (size_t)65 * FE * DM * 2;
constexpr size_t WS_R1 = WS_H + (size_t)TT * DM * 2;
constexpr size_t WS_QKVZX = WS_R1;
constexpr size_t WS_ML = WS_R1;
constexpr size_t WS_QP = WS_QKVZX + (size_t)TT * NIN * 2;
constexpr size_t WS_KP = WS_QP + (size_t)TT * 512 * 2;
constexpr size_t WS_VT = WS_KP + (size_t)TT * 128 * 2;
constexpr size_t WS_XT = WS_VT + (size_t)NB * 2 * 64 * NKEY * 2;
constexpr size_t WS_BT = WS_XT + (size_t)NCH * 8 * 64 * 128 * 2;
constexpr size_t WS_BC = WS_BT + (size_t)NCH * 2 * 128 * 128 * 2;
constexpr size_t WS_SST = WS_BC + (size_t)TT * 512 * 2;
constexpr size_t WS_CB = WS_SST + (size_t)NCH * 2 * 8 * 64 * 128 * 2;
constexpr size_t WS_AS = WS_CB + (size_t)NCH * 2 * 128 * 128 * 4;
constexpr size_t WS_CF = WS_AS + (size_t)TT * DM * 2;
constexpr size_t WS_R1A_END = WS_CF + (size_t)NCH * 2 * 128 * 128 * 2;
constexpr size_t WS_YH_END = WS_YH + (size_t)TT * 9 * DM * 2;
constexpr size_t WS_END = WS_R1A_END > WS_YH_END ? WS_R1A_END : WS_YH_END;
static_assert(WS_END <= (size_t)536 * 1024 * 1024, "workspace map too large");
constexpr float H8_SCALE = 4.f, W8_SCALE = 256.f, GU_DESCALE = 1.f / (H8_SCALE * W8_SCALE);
constexpr float A8_SCALE = 16.f, WD8_SCALE = 128.f, YH8_SCALE = 16.f, DN_RESCALE = YH8_SCALE / (A8_SCALE * WD8_SCALE);
constexpr int CW_CNT = 4096, CNT_STRIDE = 32, CNT_LAYER = 64 * CNT_STRIDE;

struct P {
    const float *x, *c, *ctx, *c_ctx, *w_mod, *b_mod, *g_pre_mix, *g_post_mix, *g_pre_ffn, *g_post_ffn, *w_in, *q_norm, *k_norm, *conv_w, *conv_b,
        *dt_bias, *a_log, *d_skip, *ssd_norm, *w_out, *router_w, *router_bias, *w_gate, *w_up, *w_down, *ws_gate, *ws_up, *ws_down;
    float* out;
    unsigned char* ws;
};

#define LAS __attribute__((address_space(3)))
extern __shared__ __attribute__((aligned(16))) unsigned char smem_all[];
constexpr int LDS_MAIN = 73728, LDS_HALF = LDS_MAIN + 1024, LDS_XB = 2 * LDS_HALF, LDS_PT = LDS_XB + 64, LDS_WT = LDS_PT + 256, LDS_QB = LDS_WT + 256, LDS_BYTES = LDS_QB + 64;
DEV int hw_slot() { return (int)__builtin_amdgcn_s_getreg((5 << 11) | 4) & 63; }
DEV int hw_wave() { return __builtin_amdgcn_readfirstlane(((const LAS int*)(smem_all + LDS_WT))[hw_slot()]); }
DEV int hw_lane() { unsigned z = 0u; asm volatile("" : "+v"(z)); return (int)__builtin_amdgcn_mbcnt_hi(~0u, __builtin_amdgcn_mbcnt_lo(~0u, z)); }
DEV int tid512() { int t = hw_wave() * 64 + hw_lane(); asm volatile("" : "+v"(t)); return t; }
DEV int tidx() { int t = (hw_wave() & 3) * 64 + hw_lane(); asm volatile("" : "+v"(t)); return t; }
DEV int vhalf() { int h = hw_wave() >> 2; asm volatile("" : "+s"(h)); return h; }
DEV int vbid() { return (int)blockIdx.x * 2 + vhalf(); }
DEV int vgrid() { return (int)gridDim.x * 2; }
#define GAS __attribute__((address_space(1)))
DEV unsigned char* wsp(const P& p) { GAS unsigned char* w = (GAS unsigned char*)p.ws; asm volatile("" : "+s"(w)); return (unsigned char*)w; }
DEV unsigned pk2(float lo, float hi) { f32x2_t v = {lo, hi}; bf16x2_t b = __builtin_convertvector(v, bf16x2_t); return __builtin_bit_cast(unsigned, b); }
DEV float bflo(unsigned u) { return __builtin_bit_cast(float, u << 16); }
DEV float bfhi(unsigned u) { return __builtin_bit_cast(float, u & 0xffff0000u); }
DEV void unpack8(uint4 q, float* f) { f[0] = bflo(q.x); f[1] = bfhi(q.x); f[2] = bflo(q.y); f[3] = bfhi(q.y); f[4] = bflo(q.z); f[5] = bfhi(q.z); f[6] = bflo(q.w); f[7] = bfhi(q.w); }
DEV unsigned pk4_f8(float a, float b, float c, float d) {
    a = fminf(fmaxf(a, -448.f), 448.f); b = fminf(fmaxf(b, -448.f), 448.f); c = fminf(fmaxf(c, -448.f), 448.f); d = fminf(fmaxf(d, -448.f), 448.f);
    int w = 0; w = __builtin_amdgcn_cvt_pk_fp8_f32(a, b, w, false); w = __builtin_amdgcn_cvt_pk_fp8_f32(c, d, w, true); return (unsigned)w;
}
DEV uint4 pack8(const float* f) { uint4 q; q.x = pk2(f[0], f[1]); q.y = pk2(f[2], f[3]); q.z = pk2(f[4], f[5]); q.w = pk2(f[6], f[7]); return q; }
DEV float wave_sum(float v) {
#pragma unroll
    for (int o = 32; o > 0; o >>= 1) v += __shfl_xor(v, o);
    return v;
}
DEV float silu_f(float v) { return v / (1.f + __expf(-v)); }
DEV float sigmoid_f(float v) { return 1.f / (1.f + __expf(-v)); }
DEV float softplus_f(float v) { return v > 20.f ? v : log1pf(__expf(v)); }

struct RawV { u32x4 q0, q1, q2; };
template <int BN, int NK, class AL, class BL, class EP>
DEV void gemm_tile(unsigned char* lds, AL& al, BL& bl, EP& ep) {
    constexpr int NT = BN / 64;
    constexpr int NBCH = BN / 32;
    constexpr int A_BYTES = 128 * 128, B_BYTES = BN * 128, STAGE = A_BYTES + B_BYTES;
    const int tid = tidx(), lane = tid & 63, wid = tid >> 6, wr = wid >> 1, wc = wid & 1;
    const int kc = tid & 7, r0 = tid >> 3;
    const int wsw = (kc ^ ((r0 >> 1) & 7)) << 4;
    const int rsw = (lane >> 1) & 7, lr = lane & 31, lh = lane >> 5;
    f32x16 acc[2][NT];
#pragma unroll
    for (int mi = 0; mi < 2; ++mi)
#pragma unroll
        for (int ni = 0; ni < NT; ++ni)
#pragma unroll
            for (int e = 0; e < 16; ++e) acc[mi][ni][e] = 0.f;
    RawV xa[2][4], xb[2][NBCH];
#define GT_RAW(set, ks_) do { _Pragma("unroll") for (int i = 0; i < 4; ++i) xa[set][i] = al.raw(i, r0 + 32 * i, (ks_) * 8 + kc); \
                              _Pragma("unroll") for (int i = 0; i < NBCH; ++i) xb[set][i] = bl.raw(i, r0 + 32 * i, (ks_) * 8 + kc); } while (0)
#define GT_PUT(set, ks_, stg) do { unsigned char* da_ = lds + (stg) * STAGE; \
        _Pragma("unroll") for (int i = 0; i < 4; ++i) *(uint4*)(da_ + (r0 + 32 * i) * 128 + wsw) = al.fin(xa[set][i], i, r0 + 32 * i, (ks_) * 8 + kc); \
        _Pragma("unroll") for (int i = 0; i < NBCH; ++i) *(uint4*)(da_ + A_BYTES + (r0 + 32 * i) * 128 + wsw) = bl.fin(xb[set][i], i, r0 + 32 * i, (ks_) * 8 + kc); } while (0)
    GT_RAW(0, 0);
    if (NK > 1) GT_RAW(1, 1);
    ep.pre(tid);
    __syncthreads();
    GT_PUT(0, 0, 0);
    __syncthreads();
#pragma unroll
    for (int ks = 0; ks < NK; ++ks) {
        const int cur = ks & 1;
        if (ks + 2 < NK) GT_RAW(cur, ks + 2);
        const unsigned char* sa = lds + cur * STAGE;
        const unsigned char* sb = sa + A_BYTES;
#pragma unroll
        for (int kk = 0; kk < 4; ++kk) {
            const int co = ((2 * kk + lh) ^ rsw) << 4;
            bf16x8 fa[2], fb[NT];
#pragma unroll
            for (int mi = 0; mi < 2; ++mi) fa[mi] = *(const bf16x8*)(sa + (wr * 64 + mi * 32 + lr) * 128 + co);
#pragma unroll
            for (int ni = 0; ni < NT; ++ni) fb[ni] = *(const bf16x8*)(sb + (wc * (BN / 2) + ni * 32 + lr) * 128 + co);
#pragma unroll
            for (int mi = 0; mi < 2; ++mi)
#pragma unroll
                for (int ni = 0; ni < NT; ++ni) acc[mi][ni] = __builtin_amdgcn_mfma_f32_32x32x16_bf16(fa[mi], fb[ni], acc[mi][ni], 0, 0, 0);
        }
        if (ks + 1 < NK) GT_PUT(cur ^ 1, ks + 1, cur ^ 1);
        __syncthreads();
    }
#undef GT_RAW
#undef GT_PUT
    float* ct = (float*)lds;
#pragma unroll
    for (int mi = 0; mi < 2; ++mi)
#pragma unroll
        for (int ni = 0; ni < NT; ++ni)
#pragma unroll
            for (int e = 0; e < 16; ++e) {
                const int row = wr * 64 + mi * 32 + (e & 3) + 8 * (e >> 2) + 4 * lh;
                const int col = wc * (BN / 2) + ni * 32 + lr;
                ct[row * (BN + 4) + col] = acc[mi][ni][e];
            }
    __syncthreads();
    ep(ct, tid);
}
DEV void ld8f(const float* ct, int off, float* v) {
    const float4 a = *(const float4*)(ct + off), b = *(const float4*)(ct + off + 4);
    v[0] = a.x; v[1] = a.y; v[2] = a.z; v[3] = a.w; v[4] = b.x; v[5] = b.y; v[6] = b.z; v[7] = b.w;
}

namespace g8 {
typedef float f32x4 __attribute__((ext_vector_type(4)));
constexpr int BM = 256, BK = 64, HALF = 128, HTB = HALF * BK * 2, STAGE_BYTES = 8 * HTB;
DEV int lds_byte(int r, int c) { const int st = (r >> 4) * 2 + (c >> 5), rr = r & 15, cc = c & 31, ob = rr * 64 + cc * 2; return st * 1024 + (ob ^ (((ob >> 9) & 1) << 5)); }
DEV void stage_rc(int b, int& R, int& C) { const int st = b / 1024, sb = b % 1024, swz = sb ^ (((sb >> 9) & 1) << 5); R = (st >> 1) * 16 + swz / 64; C = (st & 1) * 32 + (swz % 64) / 2; }
DEV int perm32(int rho) { const int n = rho >> 4, i = rho & 15; return 8 * (i >> 2) + 4 * n + (i & 3); }
struct Unit { const char* a; const char* b0; const char* b1; const void* aux; int row0, col0, nvalid, sub; };
typedef int i32x8 __attribute__((ext_vector_type(8)));
typedef int i32x4 __attribute__((ext_vector_type(4)));
DEV i32x8 cat8(const bf16x8 a, const bf16x8 b) { return __builtin_shufflevector(__builtin_bit_cast(i32x4, a), __builtin_bit_cast(i32x4, b), 0, 1, 2, 3, 4, 5, 6, 7); }
DEV const char* uni(const char* p) { const unsigned long long v = (unsigned long long)p; const unsigned lo = __builtin_amdgcn_readfirstlane((unsigned)v), hi = __builtin_amdgcn_readfirstlane((unsigned)(v >> 32)); return (const char*)(GAS const char*)(((unsigned long long)hi << 32) | lo); }
template <class Epi, class Sched>
DEV void gemm(LAS unsigned char* lds, const Sched& S, const Epi& E, const int nt  , const int ldb  ) {
    const int tid = tid512(), wid = __builtin_amdgcn_readfirstlane(tid >> 6), lane = tid & 63, wr = wid >> 2, wc = wid & 3, fr = lane & 15, fq = lane >> 4;
    unsigned voffB[2];
#pragma unroll
    for (int i = 0; i < 2; ++i) { int R, C; stage_rc(tid * 16 + i * 8192, R, C); const int Rb = (R & ~31) + perm32(R & 31); voffB[i] = (unsigned)(Rb * ldb + C) * 2u; }
    const size_t kstep = (size_t)(BK * 2);
    const unsigned ldsw = (unsigned)wid * 1024u;
    const int swz = lds_byte(fr, fq * 8); const int aS = wr * 8192, bS = wc * 4096;
    const unsigned pko = (unsigned)tid * 32u;
#define G8_PSLOT(sl) ((LAS u32x4*)(lds + STAGE_BYTES + pko) + (sl))
#define G8_AOFF(dst, sl, half) unsigned dst[2]; { const u32x2 _q = *((const LAS u32x2*)G8_PSLOT(sl) + (half)); dst[0] = _q[0]; dst[1] = _q[1]; }
#define G8_SA(b, h) (((b) * 2 + (h)) * HTB)
#define G8_SB(b, h) ((4 + (b) * 2 + (h)) * HTB)
#define G8_STAGE(bufoff, gbase, voff) do { _Pragma("unroll") for (int _i = 0; _i < 2; ++_i) { unsigned _o = (voff)[_i]; asm volatile("" : "+v"(_o));   \
        __builtin_amdgcn_global_load_lds((const unsigned*)((const char*)(gbase) + _o), (LAS unsigned*)(lds + (bufoff) + ldsw + _i * 8192), 16, 0, 0); } } while (0)
#define G8_LDA(dst, b, h) do { _Pragma("unroll") for (int m = 0; m < 4; ++m) _Pragma("unroll") for (int k = 0; k < 2; ++k) dst[m][k] = *(const LAS bf16x8*)(lds + (G8_SA(b, h) + aS) + swz + m * 2048 + k * 1024); } while (0)
#define G8_LDB(dst, b, h) do { _Pragma("unroll") for (int n = 0; n < 2; ++n) _Pragma("unroll") for (int k = 0; k < 2; ++k) dst[n][k] = *(const LAS bf16x8*)(lds + (G8_SB(b, h) + bS) + swz + n * 2048 + k * 1024); } while (0)
#define G8_MMA(ai, bj, At, Bt) do { __builtin_amdgcn_s_setprio(1); _Pragma("unroll") for (int m = 0; m < 4; ++m) _Pragma("unroll") for (int n = 0; n < 2; ++n) { \
        if constexpr (Sched::F8) acc[ai][bj][m][n] = __builtin_amdgcn_mfma_scale_f32_16x16x128_f8f6f4(cat8(Bt[n][0], Bt[n][1]), cat8(At[m][0], At[m][1]), acc[ai][bj][m][n], 0, 0, 0, 0, 0, 0); \
        else { _Pragma("unroll") for (int k = 0; k < 2; ++k) acc[ai][bj][m][n] = __builtin_amdgcn_mfma_f32_16x16x32_bf16(Bt[n][k], At[m][k], acc[ai][bj][m][n], 0, 0, 0); } } __builtin_amdgcn_s_setprio(0); } while (0)
#define G8_WAIT_V(n) asm volatile("s_waitcnt vmcnt(" #n ")" ::: "memory")
#define G8_WAIT_L(n) asm volatile("s_waitcnt lgkmcnt(" #n ")" ::: "memory")
#define G8_BAR __builtin_amdgcn_s_barrier()
#define G8_SCHED __builtin_amdgcn_sched_barrier(0)
    Unit cur, nxt; int ui = 0;
    if (!S.next(0, cur)) return;
    f32x4 acc[2][2][4][2];
#pragma unroll
    for (int a = 0; a < 2; ++a)
#pragma unroll
        for (int b = 0; b < 2; ++b)
#pragma unroll
            for (int m = 0; m < 4; ++m)
#pragma unroll
                for (int n = 0; n < 2; ++n) acc[a][b][m][n] = (f32x4){0.f, 0.f, 0.f, 0.f};
    bf16x8 At[4][2], B0[2][2], B1[2][2];
    unsigned va0[2], va1x[2];
    S.a_off(cur, va0, va1x);
    unsigned (&va1)[2] = Sched::GATHER ? va1x : va0;
    if constexpr (Sched::GATHER) *G8_PSLOT(0) = (u32x4){va0[0], va0[1], va1x[0], va1x[1]};
    const char* cA0 = uni(cur.a); const char* cA1 = uni(cur.a + S.a_half());
    const char* cB0 = uni(cur.b0); const char* cB1 = uni(cur.b1);
    G8_STAGE(G8_SB(0, 0), cB0, voffB); G8_STAGE(G8_SB(0, 1), cB1, voffB); G8_STAGE(G8_SA(0, 0), cA0, va0); G8_STAGE(G8_SA(0, 1), cA1, va1);
    if (wr == 1) G8_BAR;
    G8_WAIT_V(2); G8_BAR;
    G8_STAGE(G8_SB(1, 0), uni(cB0 + kstep), voffB); G8_STAGE(G8_SA(1, 0), uni(cA0 + kstep), va0); G8_STAGE(G8_SB(1, 1), uni(cB1 + kstep), voffB);
    G8_WAIT_V(6); G8_BAR;
    for (;;) {
        const bool has_next = S.next(ui + 1, nxt);
        if constexpr (Sched::GATHER) {
            if (!has_next) nxt = cur;
            unsigned n0[2], n1[2];
            S.a_off(nxt, n0, n1);
            *G8_PSLOT((ui + 1) & 1) = (u32x4){n0[0], n0[1], n1[0], n1[1]};
        }
        const char* nA0 = has_next ? nxt.a : cA0 - 0; const char* nB0 = has_next ? nxt.b0 : cB0; const char* nB1 = has_next ? nxt.b1 : cB1;
        if (!has_next) nA0 = cur.a;
        const char* nA1 = nA0 + S.a_half();
        for (int t = 0; t < nt; t += 2) {
            const bool last = (t == nt - 2);
            if constexpr (Epi::MID_T > 0) { if (t == Epi::MID_T) E.mid(acc, cur, wr, fr); }
            const char* a11 = uni(cA1 + (size_t)(t + 1) * kstep);
            const char* a20 = uni(last ? nA0 : cA0 + (size_t)(t + 2) * kstep); const char* a21 = uni(last ? nA1 : cA1 + (size_t)(t + 2) * kstep);
            const char* b20 = uni(last ? nB0 : cB0 + (size_t)(t + 2) * kstep); const char* b21 = uni(last ? nB1 : cB1 + (size_t)(t + 2) * kstep);
            const char* a30 = uni(a20 + kstep); const char* b30 = uni(b20 + kstep); const char* b31 = uni(b21 + kstep);
            const int slc = ui & 1, sln = last ? (slc ^ 1) : slc;
#define G8_STAGE_A(bufoff, gbase, sl, half) do { if constexpr (Sched::GATHER) { G8_AOFF(_ao, sl, half); G8_STAGE(bufoff, gbase, _ao); } else { G8_STAGE(bufoff, gbase, va0); } } while (0)
            G8_LDB(B0, 0, 0); G8_LDB(B1, 0, 1); G8_SCHED; G8_LDA(At, 0, 0); G8_STAGE_A(G8_SA(1, 1), a11, slc, 1);
            G8_WAIT_V(8); G8_WAIT_L(0); G8_BAR; G8_MMA(0, 0, At, B0); G8_MMA(0, 1, At, B1); G8_BAR; G8_SCHED;
            G8_LDA(At, 0, 1); G8_STAGE(G8_SB(0, 0), b20, voffB); G8_STAGE(G8_SB(0, 1), b21, voffB); G8_STAGE_A(G8_SA(0, 0), a20, sln, 0);
            G8_WAIT_V(8); G8_WAIT_L(0); G8_BAR; G8_MMA(1, 0, At, B0); G8_MMA(1, 1, At, B1); G8_BAR; G8_SCHED;
            G8_LDB(B0, 1, 0); G8_LDB(B1, 1, 1); G8_SCHED; G8_LDA(At, 1, 0); G8_STAGE_A(G8_SA(0, 1), a21, sln, 1);
            G8_WAIT_V(8); G8_WAIT_L(0); G8_BAR; G8_MMA(0, 0, At, B0); G8_MMA(0, 1, At, B1); G8_BAR; G8_SCHED;
            G8_LDA(At, 1, 1); G8_STAGE(G8_SB(1, 0), b30, voffB); G8_STAGE(G8_SB(1, 1), b31, voffB); G8_STAGE_A(G8_SA(1, 0), a30, sln, 0);
            G8_WAIT_V(8); G8_WAIT_L(0); G8_BAR; G8_MMA(1, 0, At, B0); G8_MMA(1, 1, At, B1); G8_BAR; G8_SCHED;
#undef G8_STAGE_A
        }
        if (wr == 0) G8_BAR;
        { const int l2 = hw_lane(); E(acc, cur, wr, wc, l2 & 15, l2 >> 4); }
        if (!has_next) break;
#pragma unroll
        for (int a = 0; a < 2; ++a)
#pragma unroll
            for (int b = 0; b < 2; ++b)
#pragma unroll
                for (int m = 0; m < 4; ++m)
#pragma unroll
                    for (int n = 0; n < 2; ++n) acc[a][b][m][n] = (f32x4){0.f, 0.f, 0.f, 0.f};
        cur = nxt; cA0 = nA0; cA1 = nA1; cB0 = nB0; cB1 = nB1; ++ui;
        if (wr == 1) G8_BAR;
    }
    G8_WAIT_V(0);
    G8_BAR;
#undef G8_PSLOT
#undef G8_AOFF
#undef G8_SA
#undef G8_SB
#undef G8_STAGE
#undef G8_LDA
#undef G8_LDB
#undef G8_MMA
#undef G8_WAIT_V
#undef G8_WAIT_L
#undef G8_BAR
#undef G8_SCHED
}
DEV int deal(int i, int G, int c, int nwg) {
    const long L = (long)i * G + c; if (L >= nwg) return -1;
    const int w = (int)L, q = nwg / 8, r = nwg % 8, xcd = w % 8, off = w / 8;
    return (xcd < r ? xcd * (q + 1) : r * (q + 1) + (xcd - r) * q) + off;
}
struct EpiStore {
    static constexpr int MID_T = 0;
    bf16_t* O; int ld;
    DEV void operator()(const f32x4 (&acc)[2][2][4][2], const Unit& u, int wr, int wc, int fr, int fq) const {
#pragma unroll
        for (int ai = 0; ai < 2; ++ai)
#pragma unroll
            for (int m = 0; m < 4; ++m) {
                const int r = ai * HALF + wr * 64 + m * 16 + fr;
                if (r < u.nvalid) {
                    bf16_t* rowp = O + (size_t)(u.row0 + r) * ld + u.col0 + wc * 32 + 8 * fq;
#pragma unroll
                    for (int bj = 0; bj < 2; ++bj) {
                        const f32x4 v0 = acc[ai][bj][m][0], v1 = acc[ai][bj][m][1];
                        *(u32x4*)(rowp + bj * HALF) = (u32x4){pk2(v0[0], v0[1]), pk2(v0[2], v0[3]), pk2(v1[0], v1[1]), pk2(v1[2], v1[3])};
                    }
                }
            }
    }
};
struct EpiStore8 {
    static constexpr int MID_T = 0;
    unsigned char* O; int ld; float sc;
    DEV void operator()(const f32x4 (&acc)[2][2][4][2], const Unit& u, int wr, int wc, int fr, int fq) const {
#pragma unroll
        for (int ai = 0; ai < 2; ++ai)
#pragma unroll
            for (int m = 0; m < 4; ++m) {
                const int r = ai * HALF + wr * 64 + m * 16 + fr;
                if (r < u.nvalid) {
                    unsigned char* rowp = O + (size_t)(u.row0 + r) * ld + u.col0 + wc * 32 + 8 * fq;
#pragma unroll
                    for (int bj = 0; bj < 2; ++bj) {
                        const f32x4 v0 = acc[ai][bj][m][0] * sc, v1 = acc[ai][bj][m][1] * sc;
                        int w0 = 0, w1 = 0;
                        w0 = __builtin_amdgcn_cvt_pk_fp8_f32(v0[0], v0[1], w0, false); w0 = __builtin_amdgcn_cvt_pk_fp8_f32(v0[2], v0[3], w0, true);
                        w1 = __builtin_amdgcn_cvt_pk_fp8_f32(v1[0], v1[1], w1, false); w1 = __builtin_amdgcn_cvt_pk_fp8_f32(v1[2], v1[3], w1, true);
                        *(uint2*)(rowp + bj * HALF) = make_uint2((unsigned)w0, (unsigned)w1);
                    }
                }
            }
    }
};
struct SchedDense {
    static constexpr bool GATHER = false, F8 = false;
    const bf16_t* A; const bf16_t* Bt; int lda, ldb, nM, nN, G, c;
    DEV bool next(int i, Unit& u) const {
        const int w = deal(i, G, c, nM * nN); if (w < 0) return false;
        const int nig = 8 * nN, gid = w / nig, fm = gid * 8, gsz = (nM - fm) < 8 ? (nM - fm) : 8;
        const int pm = fm + ((w % nig) % gsz), pn = (w % nig) / gsz;
        u.a = (const char*)(A + (size_t)pm * BM * lda); u.b0 = (const char*)(Bt + (size_t)pn * BM * ldb); u.b1 = u.b0 + (size_t)HALF * ldb * 2;
        u.aux = nullptr; u.row0 = pm * BM; u.col0 = pn * BM; u.nvalid = BM; u.sub = 0; return true;
    }
    DEV size_t a_half() const { return (size_t)HALF * lda * 2; }
    DEV void a_off(const Unit&, unsigned (&v0)[2], unsigned (&v1)[2]) const {
        const int tz = tid512();
#pragma unroll
        for (int i = 0; i < 2; ++i) { int R, C; stage_rc(tz * 16 + i * 8192, R, C); v0[i] = (unsigned)(R * lda + C) * 2u; v1[i] = v0[i]; }
    }
};
}

DEV uint4 as_uint4(const u32x4 q) { return make_uint4(q[0], q[1], q[2], q[3]); }
struct LdRows {
    const bf16_t* base; size_t ld; int cs;
    DEV RawV raw(int, int r, int kcg) const { RawV x; x.q0 = *(const u32x4*)(base + (size_t)r * ld + kcg * cs); return x; }
    DEV uint4 fin(const RawV& x, int, int, int) const { return as_uint4(x.q0); }
};
struct EpStoreBf16 {
    bf16_t* O;
    DEV void pre(int) {}
    DEV void operator()(const float* ct, int tid) const {
#pragma unroll
        for (int i = 0; i < 8; ++i) {
            const int id = tid + 256 * i, c8 = id >> 7, r = id & 127;
            float v[8]; ld8f(ct, r * 132 + c8 * 8, v);
            *(uint4*)(O + (size_t)(r >> 6) * 8192 + c8 * 512 + (r & 63) * 8) = pack8(v);
        }
    }
};

struct Strip { const float* src; unsigned char* dst; const float* rscale; int ld_src, ld_dst; float f8; };
DEV void strip_of(const P& p, int layer, int it, Strip& st) {
    bf16_t* WIN = (bf16_t*)(wsp(p) + WS_WIN); bf16_t* WOUT = (bf16_t*)(wsp(p) + WS_WOUT);
    bf16_t* WG = (bf16_t*)(wsp(p) + WS_WG); bf16_t* WU = (bf16_t*)(wsp(p) + WS_WU); bf16_t* WD = (bf16_t*)(wsp(p) + WS_WD);
    constexpr int T0 = 144, T1 = T0 + 64, T2 = T1 + 1024, T3 = T2 + 1024, T4 = T3 + 1024, T5 = T4 + 16, T6 = T5 + 16;
    const float* src; bf16_t* dst; int ls, ld, r0, c0, rd0 = -1; st.rscale = nullptr;
    const bool f8 = it >= T1;
    unsigned char* WG8 = (unsigned char*)WG; unsigned char* WU8 = (unsigned char*)WU; unsigned char* WD8 = (unsigned char*)WD; unsigned char* dst8 = nullptr;
    if (it < T0) { r0 = (it / 9) * 64; c0 = (it % 9) * 256; src = p.w_in + (size_t)layer * DM * NINF; ls = NINF; dst = WIN; ld = DM; }
    else if (it < T1) { const int ti = it - T0, rt = ti >> 2; r0 = rt * 64; c0 = (ti & 3) * 256; src = p.w_out + (size_t)layer * DM * DM; ls = DM; dst = WOUT; ld = DM;
        rd0 = (r0 + 512) & 1023; if (rt >= 8) st.rscale = p.ssd_norm + layer * 512 + (rt - 8) * 64; }
    else if (it < T2) { const int ti = it - T1, e = ti >> 4; r0 = (ti & 15) * 64; c0 = 0; src = p.w_gate + ((size_t)layer * 64 + e) * DM * FE; ls = FE; dst = nullptr; dst8 = WG8 + (size_t)e * FE * DM; ld = DM; }
    else if (it < T3) { const int ti = it - T2, e = ti >> 4; r0 = (ti & 15) * 64; c0 = 0; src = p.w_up + ((size_t)layer * 64 + e) * DM * FE; ls = FE; dst = nullptr; dst8 = WU8 + (size_t)e * FE * DM; ld = DM; }
    else if (it < T4) { const int ti = it - T3, e = ti >> 4; r0 = ((ti >> 2) & 3) * 64; c0 = (ti & 3) * 256; src = p.w_down + ((size_t)layer * 64 + e) * FE * DM; ls = DM; dst = nullptr; dst8 = WD8 + (size_t)e * DM * FE; ld = FE; }
    else if (it < T5) { r0 = (it - T4) * 64; c0 = 0; src = p.ws_gate + (size_t)layer * DM * FE; ls = FE; dst = nullptr; dst8 = WG8 + (size_t)64 * FE * DM; ld = DM; }
    else if (it < T6) { r0 = (it - T5) * 64; c0 = 0; src = p.ws_up + (size_t)layer * DM * FE; ls = FE; dst = nullptr; dst8 = WU8 + (size_t)64 * FE * DM; ld = DM; }
    else { const int ti = it - T6; r0 = (ti >> 2) * 64; c0 = (ti & 3) * 256; src = p.ws_down + (size_t)layer * FE * DM; ls = DM; dst = nullptr; dst8 = WD8 + (size_t)64 * DM * FE; ld = FE; }
    if (rd0 < 0) rd0 = r0;
    st.src = src + (size_t)r0 * ls + c0; st.dst = f8 ? dst8 + (size_t)c0 * ld + rd0 : (unsigned char*)(dst + (size_t)c0 * ld + rd0); st.ld_src = ls; st.ld_dst = ld; st.f8 = !f8 ? 0.f : (ld == FE ? WD8_SCALE : W8_SCALE);
}
DEV const char* uni_ptr(const void* p) { const unsigned long long v = (unsigned long long)p; const unsigned lo = __builtin_amdgcn_readfirstlane((unsigned)v), hi = __builtin_amdgcn_readfirstlane((unsigned)(v >> 32)); return (const char*)(GAS const char*)(((unsigned long long)hi << 32) | lo); }
DEV void strip_load(const Strip& st, int tid, float4 (&v)[16]) {
    const char* sb = uni_ptr(st.src);
    unsigned off = (unsigned)((tid >> 6) * st.ld_src + (tid & 63) * 4) * 4u; const unsigned step = (unsigned)st.ld_src * 16u;
#pragma unroll
    for (int i = 0; i < 16; ++i) { const f32x4v q = __builtin_nontemporal_load((const f32x4v*)(sb + off)); v[i] = make_float4(q[0], q[1], q[2], q[3]); off += step; }
}
DEV void strip_park(float* t, int tid, const float4 (&v)[16]) {
    const int lane = tid & 63, rot = (lane >> 3) & 3;
    float* base = t + (tid >> 6) * 257 + 4 * lane;
    const int o0 = rot, o1 = (rot + 1) & 3, o2 = (rot + 2) & 3, o3 = (rot + 3) & 3;
#pragma unroll
    for (int i = 0; i < 16; ++i) {
        float a = v[i].x, b = v[i].y, c = v[i].z, d = v[i].w;
        if (rot & 1) { const float t0 = a; a = b; b = c; c = d; d = t0; }
        if (rot & 2) { const float t0 = a, t1 = b; a = c; b = d; c = t0; d = t1; }
        float* q = base + i * 4 * 257;
        q[o0] = a; q[o1] = b; q[o2] = c; q[o3] = d;
    }
}
DEV void strip_emit(const float* t, int tid, const Strip& cur) {
#pragma unroll
    for (int i = 0; i < 8; ++i) {
        const int idx = tid + 256 * i, c = idx >> 3, r8 = (idx & 7) * 8;
        float o[8];
#pragma unroll
        for (int e = 0; e < 8; ++e) o[e] = t[(r8 + e) * 257 + c] * (cur.rscale ? cur.rscale[r8 + e] : 1.f);
        if (cur.f8 != 0.f) { const float sc = cur.f8; *(uint2*)(cur.dst + (size_t)c * cur.ld_dst + r8) = make_uint2(pk4_f8(o[0] * sc, o[1] * sc, o[2] * sc, o[3] * sc), pk4_f8(o[4] * sc, o[5] * sc, o[6] * sc, o[7] * sc)); }
        else *(uint4*)((bf16_t*)cur.dst + (size_t)c * cur.ld_dst + r8) = pack8(o);
    }
}
DEV int strip_index(int part, int i) {
    if (part == 0) return i < 208 ? i : (i < 208 + 1024 ? 2256 + (i - 208) : 3312 + (i - 1232));
    return i < 2048 ? 208 + i : 3280 + (i - 2048);
}
DEV void strips_loop(const P& p, int layer, unsigned char* lds, int id0, int n, int stride, int part) {
    float* t = (float*)lds;
    const int tid = tidx();
    Strip cur, nxt; float4 v[16];
    if (n > 0) { strip_of(p, layer, part < 0 ? id0 : strip_index(part, id0), cur); strip_load(cur, tid, v); }
    for (int k = 0; k < n; ++k) {
        __syncthreads();
        strip_park(t, tid, v);
        const bool more = k + 1 < n;
        if (more) { const int id = id0 + (k + 1) * stride; strip_of(p, layer, part < 0 ? id : strip_index(part, id), nxt); strip_load(nxt, tid, v); }
        __syncthreads();
        strip_emit(t, tid, cur);
        if (more) cur = nxt;
    }
}
constexpr int CW_QH = 8192, NQ_PAIRS = (3328 - 208) / 2;
DEV void fill_strips(const P& p, unsigned char* lds, int budget) {
    volatile LAS int* bc = (volatile LAS int*)(smem_all + LDS_QB);
    unsigned* qh = (unsigned*)(wsp(p) + WS_CTL) + CW_QH;
    const int want = budget < 0 ? 2 : budget;
    for (;;) {
        __syncthreads();
        if (tid512() == 0) *bc = (int)__hip_atomic_fetch_add(qh, (unsigned)want, __ATOMIC_RELAXED, __HIP_MEMORY_SCOPE_AGENT);
        __syncthreads();
        const int q0 = __builtin_amdgcn_readfirstlane(*bc);
        if (q0 >= NQ_PAIRS) break;
        const int n = min(want, NQ_PAIRS - q0);
        strips_loop(p, 0, lds, 208 + 2 * q0 + vhalf(), n, 2, -1);
        if (budget >= 0) break;
    }
}
DEV void phase_p0(const P& p, int layer, unsigned char* lds, int part, bool extras) {
    constexpr int T7 = 3328;
    const int nstrip = part == 0 ? 1248 : (part == 1 ? 2080 : 208);
    const int nextra = extras ? (192 + 256 + 128 + 32) : 0;
    { const int v0 = vbid(); const int n = v0 < nstrip ? (nstrip - v0 + vgrid() - 1) / vgrid() : 0; strips_loop(p, layer, lds, v0, n, vgrid(), part == 2 ? 0 : part); }
    for (int it = T7 + (vbid() + vgrid() - (nstrip % vgrid())) % vgrid(); it < T7 + nextra; it += vgrid()) {
        if (false) {}
        else if (it < T7 + 192) {
            const int mi = it - T7, l = mi / 96, cg = mi % 96, tid = tidx(), lane = tid & 63, wid = tid >> 6;
            float* sc = (float*)lds;
            float* part = sc + 9 * 1024;
            __syncthreads();
            for (int i = tid; i < 9 * 1024; i += 256) { const float v = (i < 8192) ? p.c[i] : p.c_ctx[i - 8192]; sc[i] = silu_f(v); }
            __syncthreads();
            float a9[9];
#pragma unroll
            for (int r = 0; r < 9; ++r) a9[r] = 0.f;
            const float* wm = p.w_mod + (size_t)l * DM * 6144 + cg * 64 + lane;
#pragma unroll 1
            for (int k0 = wid * 256; k0 < wid * 256 + 256; k0 += 16) {
                float w[16];
#pragma unroll
                for (int j = 0; j < 16; ++j) w[j] = wm[(size_t)(k0 + j) * 6144];
#pragma unroll
                for (int j = 0; j < 16; ++j)
#pragma unroll
                    for (int r = 0; r < 9; ++r) a9[r] += sc[r * 1024 + k0 + j] * w[j];
            }
#pragma unroll
            for (int r = 0; r < 9; ++r) part[(wid * 9 + r) * 64 + lane] = a9[r];
            __syncthreads();
            float* MOD = (float*)(wsp(p) + WS_MOD);
            for (int i = tid; i < 9 * 64; i += 256) {
                const int r = i >> 6, j = i & 63;
                const float s = ((part[(0 * 9 + r) * 64 + j] + part[(1 * 9 + r) * 64 + j]) + part[(2 * 9 + r) * 64 + j]) + part[(3 * 9 + r) * 64 + j];
                const float v = s + p.b_mod[l * 6144 + cg * 64 + j];
                const int T = cg >> 4, c = (cg & 15) * 64 + j;
                float o = v;
                if (T == 1) o = p.g_pre_mix[l * DM + c] * (1.f + v);
                if (T == 2) o = v * p.g_post_mix[l * DM + c];
                if (T == 4) o = p.g_pre_ffn[l * DM + c] * (1.f + v);
                if (T == 5) o = v * p.g_post_ffn[l * DM + c];
                MOD[((size_t)l * 9 + r) * 6144 + cg * 64 + j] = o;
            }
        } else if (it >= T7 + 192 + 256) {
            const int idx = (it - T7 - 192 - 256) * 256 + tidx();
            if (idx < 32768) {
                const int l = idx >> 14, wid = (idx >> 12) & 3, q = (idx >> 6) & 63, lane = idx & 63;
                const float* src = p.router_w + (size_t)l * DM * NEXP + (size_t)(16 * q + 4 * (lane >> 4)) * NEXP + 16 * wid + (lane & 15);
                ((float4*)(wsp(p) + WS_RW2))[idx] = make_float4(src[0], src[NEXP], src[2 * NEXP], src[3 * NEXP]);
            } else {
                const int id2 = idx - 32768, l = id2 >> 12, wid = (id2 >> 10) & 3, q = (id2 >> 6) & 15, lane = id2 & 63;
                const float* src = p.w_in + (size_t)l * DM * NINF + (size_t)(256 * wid + 16 * q + 4 * (lane >> 4)) * NINF + NIN + (lane & 15);
                ((float4*)(wsp(p) + WS_WD2))[id2] = make_float4(src[0], src[NINF], src[2 * NINF], src[3 * NINF]);
            }
        } else {
            const int idx = (it - T7 - 192) * 256 + tidx(), pos = idx >> 5, i = idx & 31, f = i & 15;
            const float inv = powf(10000.f, -(float)f / 16.f);
            const float ang = (float)((i < 16) ? (pos >> 6) : (pos & 63)) * inv;
            float2* ROPE = (float2*)(wsp(p) + WS_ROPE);
            ROPE[idx] = make_float2(cosf(ang), sinf(ang));
        }
    }
}

DEV void ld_row16(const float* row, int lane, float* v) {
#pragma unroll
    for (int i = 0; i < 4; ++i) { const float4 q = *(const float4*)(row + 4 * lane + 256 * i); v[4 * i] = q.x; v[4 * i + 1] = q.y; v[4 * i + 2] = q.z; v[4 * i + 3] = q.w; }
}
DEV void st_row16(float* row, int lane, const float* v) {
#pragma unroll
    for (int i = 0; i < 4; ++i) *(float4*)(row + 4 * lane + 256 * i) = make_float4(v[4 * i], v[4 * i + 1], v[4 * i + 2], v[4 * i + 3]);
}
DEV void ld_row16_bf(const bf16_t* row, int lane, float* v) {
#pragma unroll
    for (int i = 0; i < 4; ++i) { const uint2 q = *(const uint2*)(row + 4 * lane + 256 * i); v[4 * i] = bflo(q.x); v[4 * i + 1] = bfhi(q.x); v[4 * i + 2] = bflo(q.y); v[4 * i + 3] = bfhi(q.y); }
}
DEV void st_row16_bf(bf16_t* row, int lane, const float* v) {
#pragma unroll
    for (int i = 0; i < 4; ++i) *(uint2*)(row + 4 * lane + 256 * i) = make_uint2(pk2(v[4 * i], v[4 * i + 1]), pk2(v[4 * i + 2], v[4 * i + 3]));
}
DEV float rstd16(const float* v) {
    float s = 0.f;
#pragma unroll
    for (int e = 0; e < 16; ++e) s += v[e] * v[e];
    s = wave_sum(s);
    return rsqrtf(s * (1.f / 1024.f) + EPS);
}
constexpr int HLS = 1028;
constexpr int HL_BYTES = 16 * HLS * 4;
DEV f32x4v mfma4(const float4 a, const float4 b, f32x4v acc) {
    acc = __builtin_amdgcn_mfma_f32_16x16x4f32(a.x, b.x, acc, 0, 0, 0); acc = __builtin_amdgcn_mfma_f32_16x16x4f32(a.y, b.y, acc, 0, 0, 0);
    acc = __builtin_amdgcn_mfma_f32_16x16x4f32(a.z, b.z, acc, 0, 0, 0); acc = __builtin_amdgcn_mfma_f32_16x16x4f32(a.w, b.w, acc, 0, 0, 0);
    return acc;
}
template <int RPW> DEV void dt_tail16(const float* hl, const float4* wd2  , const float* bias, float* part, float* DT, int tok0, int tid) {
    const int lane = tid & 63, wid = tid >> 6, ar = lane & 15, kq = lane >> 4;
    f32x4v acc = {0.f, 0.f, 0.f, 0.f};
    const float* ap = hl + ar * HLS + wid * 256 + 4 * kq;
    const float4* bp = wd2 + (size_t)wid * 16 * 64 + lane;
#pragma unroll 8
    for (int q = 0; q < 16; ++q) acc = mfma4(*(const float4*)(ap + 16 * q), bp[q * 64], acc);
#pragma unroll
    for (int e = 0; e < 4; ++e) part[(wid * 16 + kq * 4 + e) * 16 + ar] = acc[e];
    __syncthreads();
    const int r = tid >> 4, j = tid & 15;
    const float v = ((part[(0 * 16 + r) * 16 + j] + part[(1 * 16 + r) * 16 + j]) + part[(2 * 16 + r) * 16 + j]) + part[(3 * 16 + r) * 16 + j];
    if (r < 4 * RPW) DT[(size_t)(tok0 + r) * 16 + j] = softplus_f(v + bias[j]);
}
template <int RPW> DEV void phase_pa0(const P& p, unsigned char* lds, int row0, int nrows) {
    const int tid = tidx(), lane = tid & 63, wid = tid >> 6;
    const float* MOD = (const float*)(wsp(p) + WS_MOD);
    bf16_t* H = (bf16_t*)(wsp(p) + WS_H); float* DT = (float*)(wsp(p) + WS_DT);
    float* hl = (float*)lds; float* part = (float*)(lds + HL_BYTES);
    for (int task = vbid(); task < nrows / (4 * RPW); task += vgrid()) {
        const int tok0 = row0 + task * (4 * RPW) + wid * RPW;
        const float* xb = tok0 < TL ? p.x + (size_t)tok0 * DM : p.ctx + (size_t)(tok0 - TL) * DM;
        const float* md = MOD + (size_t)(tok0 < TL ? tok0 / SEQ : 8) * 6144;
        float x[RPW][16], pb[16], pc[16];
#pragma unroll
        for (int rr = 0; rr < RPW; ++rr) ld_row16(xb + (size_t)rr * DM, lane, x[rr]);
        ld_row16(md + 1024, lane, pb); ld_row16(md + 0, lane, pc);
        __syncthreads();
#pragma unroll
        for (int rr = 0; rr < RPW; ++rr) {
            const float rs = rstd16(x[rr]);
            float h[16];
#pragma unroll
            for (int e = 0; e < 16; ++e) h[e] = x[rr][e] * rs * pb[e] + pc[e];
            st_row16_bf(H + (size_t)(tok0 + rr) * DM, lane, h);
            st_row16(hl + (wid * RPW + rr) * HLS, lane, h);
        }
        __syncthreads();
        dt_tail16<RPW>(hl, (const float4*)(wsp(p) + WS_WD2), p.dt_bias, part, DT, row0 + task * (4 * RPW), tid);
    }
}
template <int RPW> DEV void phase_pi(const P& p, int layer, unsigned char* lds, int row0, int nrows) {
    const int tid = tidx(), lane = tid & 63, wid = tid >> 6;
    const float* MOD = (const float*)(wsp(p) + WS_MOD);
    const bf16_t* ML = (const bf16_t*)(wsp(p) + WS_ML);
    bf16_t* XB = (bf16_t*)(wsp(p) + WS_XB);
    bf16_t* H = (bf16_t*)(wsp(p) + WS_H);
    unsigned* TOPK = (unsigned*)(wsp(p) + WS_TOPK);
    uint2* LIST = (uint2*)(wsp(p) + WS_LIST);
    unsigned* cnt = (unsigned*)(wsp(p) + WS_CTL) + CW_CNT + layer * CNT_LAYER;
    float* hl = (float*)lds; float* lgl = (float*)(lds + HL_BYTES);
    unsigned* lcnt = (unsigned*)(lds + HL_BYTES + 4096); unsigned* lbase = lcnt + 64;
    if (tid < 64) lcnt[tid] = 0u;
    const float4* rw2 = (const float4*)(wsp(p) + WS_RW2) + (size_t)layer * 16384 + (size_t)wid * 4096 + lane;
    const float rbias = p.router_bias[layer * NEXP + lane];
    for (int task = vbid(); task < nrows / (4 * RPW); task += vgrid()) {
        const int tok0 = row0 + task * (4 * RPW) + wid * RPW;
        const float* xin = tok0 < TL ? p.x + (size_t)tok0 * DM : p.ctx + (size_t)(tok0 - TL) * DM;
        bf16_t* xout = XB + (size_t)tok0 * DM;
        const float* md = MOD + ((size_t)layer * 9 + (tok0 < TL ? tok0 / SEQ : 8)) * 6144;
        float pa[16], pb[16], pc[16];
        ld_row16(md + 2048, lane, pa); ld_row16(md + 4096, lane, pb); ld_row16(md + 3072, lane, pc);
        __syncthreads();
#pragma unroll 1
        for (int hp = 0; hp < 2; ++hp) {
            float x[2][16]; uint2 yp[2][4];
#pragma unroll
            for (int r2 = 0; r2 < 2; ++r2) {
                const int rr = hp * 2 + r2;
                if (rr < RPW) {
                    if (layer == 0) ld_row16(xin + (size_t)rr * DM, lane, x[r2]); else ld_row16_bf(xout + (size_t)rr * DM, lane, x[r2]);
#pragma unroll
                    for (int i = 0; i < 4; ++i) yp[r2][i] = *(const uint2*)(ML + (size_t)(tok0 + rr) * DM + 4 * lane + 256 * i);
                }
            }
#pragma unroll
            for (int r2 = 0; r2 < 2; ++r2) {
                const int rr = hp * 2 + r2;
                if (rr >= RPW) continue;
                float y[16];
#pragma unroll
                for (int i = 0; i < 4; ++i) { y[4 * i] = bflo(yp[r2][i].x); y[4 * i + 1] = bfhi(yp[r2][i].x); y[4 * i + 2] = bflo(yp[r2][i].y); y[4 * i + 3] = bfhi(yp[r2][i].y); }
                const float rsy = rstd16(y);
#pragma unroll
                for (int e = 0; e < 16; ++e) x[r2][e] += pa[e] * (y[e] * rsy);
                st_row16_bf(xout + (size_t)rr * DM, lane, x[r2]);
                const float rs = rstd16(x[r2]);
                float h[16];
#pragma unroll
                for (int e = 0; e < 16; ++e) h[e] = x[r2][e] * rs * pb[e] + pc[e];
                {
                    unsigned char* h8 = (unsigned char*)H + (size_t)(tok0 + rr) * DM + 4 * lane;
#pragma unroll
                    for (int i = 0; i < 4; ++i) *(unsigned*)(h8 + 256 * i) = pk4_f8(h[4 * i] * H8_SCALE, h[4 * i + 1] * H8_SCALE, h[4 * i + 2] * H8_SCALE, h[4 * i + 3] * H8_SCALE);
                }
                st_row16(hl + (wid * RPW + rr) * HLS, lane, h);
            }
        }
        __syncthreads();
        {
            const int ar = lane & 15, kq = lane >> 4;
            f32x4v acc = {0.f, 0.f, 0.f, 0.f};
            const float* ap = hl + ar * HLS + 4 * kq;
#pragma unroll 8
            for (int q = 0; q < 64; ++q) acc = mfma4(*(const float4*)(ap + 16 * q), rw2[q * 64], acc);
#pragma unroll
            for (int e = 0; e < 4; ++e) lgl[(kq * 4 + e) * 64 + wid * 16 + ar] = acc[e];
        }
        __syncthreads();
        unsigned selm = 0; float gatev[RPW]; int posv[RPW]; unsigned lrk[RPW];
#pragma unroll
        for (int rr = 0; rr < RPW; ++rr) {
            const float score = sigmoid_f(lgl[(wid * RPW + rr) * 64 + lane]), choice = score + rbias;
            int grank = 0;
#pragma unroll
            for (int t = 0; t < 8; ++t) { const int j = (lane & ~7) + t; const float v = __shfl(choice, j); grank += (v > choice || (v == choice && j < lane)) ? 1 : 0; }
            float gs = grank < 2 ? choice : 0.f;
            gs += __shfl_xor(gs, 1); gs += __shfl_xor(gs, 2); gs += __shfl_xor(gs, 4);
            int gr = 0;
#pragma unroll
            for (int t = 0; t < 8; ++t) { const float v = __shfl(gs, t * 8); gr += (v > gs || (v == gs && t < (lane >> 3))) ? 1 : 0; }
            const bool ok = gr < 4;
            const float m = ok ? choice : -INFINITY;
            int rank = 0;
            for (int j = 0; j < 64; ++j) { const float v = __shfl(m, j); rank += (v > m || (v == m && j < lane)) ? 1 : 0; }
            const bool sel = ok && rank < 8;
            const float wsum = wave_sum(sel ? score : 0.f);
            const unsigned long long bal = __ballot(sel);
            gatev[rr] = score / wsum * 2.5f;
            posv[rr] = __popcll(bal & ((1ull << lane) - 1ull));
            lrk[rr] = 0;
            if (sel) { selm |= 1u << rr; lrk[rr] = atomicAdd(&lcnt[lane], 1u); }
        }
        __syncthreads();
        if (tid < 64) { const unsigned c = lcnt[tid]; lbase[tid] = c ? atomicAdd(&cnt[tid * CNT_STRIDE], c) : 0u; lcnt[tid] = 0u; }
        __syncthreads();
        const unsigned base = lbase[lane];
#pragma unroll
        for (int rr = 0; rr < RPW; ++rr)
            if (selm & (1u << rr)) {
                const unsigned rk = base + lrk[rr];
                LIST[(size_t)lane * CAP + rk] = make_uint2((unsigned)(tok0 + rr), __builtin_bit_cast(unsigned, gatev[rr]));
                TOPK[(size_t)(tok0 + rr) * 8 + posv[rr]] = (unsigned)lane | (rk << 8);
            }
    }
}

DEV void phase_pb(const P& p, int layer, LAS unsigned char* lds) {
    const bf16_t* H = (const bf16_t*)(wsp(p) + (layer == 0 ? WS_H : WS_HIN1)); const bf16_t* WIN = (const bf16_t*)(wsp(p) + WS_WIN); bf16_t* O = (bf16_t*)(wsp(p) + WS_QKVZX);
    g8::SchedDense S{H, WIN, DM, DM, TT / 256, NIN / 256, (int)gridDim.x, (int)blockIdx.x};
    g8::EpiStore E{O, NIN};
    g8::gemm(lds, S, E, DM / 64, DM);
}

template <bool FRAG = false> DEV void store_transposed(unsigned char* lds, const float (*v)[8], bf16_t* dst, size_t stride) {
    bf16_t* t = (bf16_t*)lds;
    const int tid = tidx();
    __syncthreads();
#pragma unroll
    for (int i = 0; i < 4; ++i) *(uint4*)(t + ((tid >> 3) + 32 * i) * 72 + (tid & 7) * 8) = pack8(v[i]);
    __syncthreads();
    const int c = tid >> 2, sp = (tid & 3) * 32;
#pragma unroll
    for (int jj = 0; jj < 4; ++jj) {
        unsigned w[4];
#pragma unroll
        for (int e = 0; e < 4; ++e) w[e] = (unsigned)t[(sp + jj * 8 + 2 * e) * 72 + c] | ((unsigned)t[(sp + jj * 8 + 2 * e + 1) * 72 + c] << 16);
        if (FRAG) *(uint4*)(dst + (size_t)((sp >> 3) + jj) * 512 + c * 8) = make_uint4(w[0], w[1], w[2], w[3]);
        else *(uint4*)(dst + (size_t)c * stride + sp + jj * 8) = make_uint4(w[0], w[1], w[2], w[3]);
    }
}
struct PcRegs { u32x4 ra[4], rb[4], rc[4]; f32x4v w[8]; };
DEV void pc_issue(const P& p, int layer, int u, PcRegs& R) {
    const bf16_t* QK = (const bf16_t*)(wsp(p) + WS_QKVZX);
    const int tid = tidx(), c8 = (tid & 7) * 8, s0 = tid >> 3;
    const int ch = u / 29, sub = u % 29;
    const bool lat = ch < NCHL;
    const int tok0 = ch * 128;
    const int pos0 = lat ? (ch & 15) * 128 : ((ch - NCHL) & 1) * 128;
    const int slen = lat ? SEQ : LC;
    if (sub < 16) {
        const int cc = sub * 64 + c8;
        const float* cw = p.conv_w + (size_t)layer * 3 * 1024 + cc; const float* cbp = p.conv_b + layer * 1024 + cc;
        R.w[0] = *(const f32x4v*)cw; R.w[1] = *(const f32x4v*)(cw + 4); R.w[2] = *(const f32x4v*)(cw + 1024); R.w[3] = *(const f32x4v*)(cw + 1028);
        R.w[4] = *(const f32x4v*)(cw + 2048); R.w[5] = *(const f32x4v*)(cw + 2052); R.w[6] = *(const f32x4v*)cbp; R.w[7] = *(const f32x4v*)(cbp + 4);
#pragma unroll
        for (int i = 0; i < 4; ++i) {
            const int s = s0 + 32 * i, pos = pos0 + s;
            const bf16_t* src = QK + (size_t)(tok0 + s) * NIN + C_X + cc;
            R.rb[i] = *(const u32x4*)src; R.ra[i] = *(const u32x4*)(pos > 0 ? src - NIN : src); R.rc[i] = *(const u32x4*)(pos < slen - 1 ? src + NIN : src);
        }
    } else if (sub < 28) {
        const int hs = sub - 16;
        const int col = hs < 8 ? C_Q + hs * 64 : (hs < 10 ? C_K + (hs - 8) * 64 : C_V + (hs - 10) * 64);
#pragma unroll
        for (int i = 0; i < 4; ++i) R.rb[i] = *(const u32x4*)(QK + (size_t)(tok0 + s0 + 32 * i) * NIN + col + c8);
        const float* g = (hs < 8 ? p.q_norm : p.k_norm) + layer * 64 + c8;
        R.w[0] = *(const f32x4v*)g; R.w[1] = *(const f32x4v*)(g + 4);
    }
}
DEV void pc_consume(const P& p, int layer, unsigned char* lds, int u, const PcRegs& R) {
    bf16_t* QP = (bf16_t*)(wsp(p) + WS_QP); bf16_t* KP = (bf16_t*)(wsp(p) + WS_KP); bf16_t* VT = (bf16_t*)(wsp(p) + WS_VT);
    bf16_t* XT = (bf16_t*)(wsp(p) + WS_XT); bf16_t* BT = (bf16_t*)(wsp(p) + WS_BT); bf16_t* BC = (bf16_t*)(wsp(p) + WS_BC); bf16_t* CF = (bf16_t*)(wsp(p) + WS_CF);
    const float2* ROPE = (const float2*)(wsp(p) + WS_ROPE);
    const float* DT = (const float*)(wsp(p) + WS_DT);
    float* CUM = (float*)(wsp(p) + WS_CUM); float* WST = (float*)(wsp(p) + WS_WST); float* DTT = (float*)(wsp(p) + WS_DTT); float* TOT = (float*)(wsp(p) + WS_TOT);
    const int tid = tidx(), c8 = (tid & 7) * 8, s0 = tid >> 3;
    {
        const int ch = u / 29, sub = u % 29;
        const bool lat = ch < NCHL;
        const int tok0 = ch * 128;
        const int pos0 = lat ? (ch & 15) * 128 : ((ch - NCHL) & 1) * 128;
        const int slen = lat ? SEQ : LC;
        if (sub < 16) {
            const int cg = sub, cc = cg * 64 + c8;
            float w0[8], w1[8], w2[8], bb[8];
#pragma unroll
            for (int e = 0; e < 4; ++e) { w0[e] = R.w[0][e]; w0[4 + e] = R.w[1][e]; w1[e] = R.w[2][e]; w1[4 + e] = R.w[3][e]; w2[e] = R.w[4][e]; w2[4 + e] = R.w[5][e]; bb[e] = R.w[6][e]; bb[4 + e] = R.w[7][e]; }
            float o[4][8];
#pragma unroll
            for (int i = 0; i < 4; ++i) {
                const int s = s0 + 32 * i, pos = pos0 + s;
                float a[8], b[8], c[8];
                unpack8(as_uint4(R.ra[i]), a); unpack8(as_uint4(R.rb[i]), b); unpack8(as_uint4(R.rc[i]), c);
                const float ma = pos > 0 ? 1.f : 0.f, mc = pos < slen - 1 ? 1.f : 0.f;
#pragma unroll
                for (int e = 0; e < 8; ++e) { a[e] *= ma; c[e] *= mc; }
#pragma unroll
                for (int e = 0; e < 8; ++e) o[i][e] = silu_f(bb[e] + w0[e] * a[e] + w1[e] * b[e] + w2[e] * c[e]);
                if (cg >= 12) *(uint4*)(CF + (((size_t)ch * 2 + ((cg - 12) >> 1)) * 16 + (((cc - 768) & 127) >> 3)) * 1024 + s * 8) = pack8(o[i]);
                else if (cg >= 8) *(uint4*)(BC + (size_t)(tok0 + s) * 512 + (cc - 512)) = pack8(o[i]);
            }
            if (cg < 8) store_transposed<true>(lds, o, XT + ((size_t)ch * 8 + cg) * 64 * 128, 128);
            else if (cg < 12) store_transposed(lds, o, BT + (((size_t)ch * 2 + ((cg - 8) >> 1)) * 128 + ((cg - 8) & 1) * 64) * 128, 128);
            else { __syncthreads(); __syncthreads(); }
            __syncthreads();
        } else if (sub < 28) {
            const int hs = sub - 16;
            float o[4][8];
#pragma unroll
            for (int i = 0; i < 4; ++i) {
                const int s = s0 + 32 * i;
                unpack8(as_uint4(R.rb[i]), o[i]);
                if (hs < 10) {
                    float ss = 0.f;
#pragma unroll
                    for (int e = 0; e < 8; ++e) ss += o[i][e] * o[i][e];
                    ss += __shfl_xor(ss, 1); ss += __shfl_xor(ss, 2); ss += __shfl_xor(ss, 4);
                    const float rs = rsqrtf(ss * (1.f / 64.f) + EPS);
#pragma unroll
                    for (int e = 0; e < 8; ++e) o[i][e] = o[i][e] * rs * (e < 4 ? R.w[0][e & 3] : R.w[1][e & 3]);
                    if (lat) {
                        const int pos = pos0 + s, half = (tid & 7) >> 2;
                        const float2* rp = ROPE + (size_t)pos * 32 + (c8 & 31);
#pragma unroll
                        for (int e = 0; e < 8; ++e) {
                            const float other = __shfl_xor(o[i][e], 4);
                            const float2 cs = rp[e];
                            o[i][e] = half ? (other * cs.y + o[i][e] * cs.x) : (o[i][e] * cs.x - other * cs.y);
                        }
                    }
                    if (hs < 8) {
#pragma unroll
                        for (int e = 0; e < 8; ++e) o[i][e] *= QSCALE;
                        *(uint4*)(QP + (size_t)(tok0 + s) * 512 + hs * 64 + c8) = pack8(o[i]);
                    } else *(uint4*)(KP + (size_t)(tok0 + s) * 128 + (hs - 8) * 64 + c8) = pack8(o[i]);
                }
            }
            if (hs >= 10) {
                const int b = lat ? ch >> 4 : (ch - NCHL) >> 1;
                const int kp0 = lat ? LC + pos0 : pos0;
                store_transposed(lds, o, VT + ((size_t)(b * 2 + (hs - 10)) * 64) * NKEY + kp0, NKEY);
            } else { __syncthreads(); __syncthreads(); }
            __syncthreads();
        } else {
            __syncthreads(); __syncthreads(); __syncthreads();
            const int lane = tid & 63, wv = tid >> 6;
#pragma unroll
            for (int jj = 0; jj < 4; ++jj) {
                const int j = wv * 4 + jj;
                const float nega = -__expf(p.a_log[layer * 16 + j]);
                const float d0 = DT[(size_t)(tok0 + 2 * lane) * 16 + j], d1 = DT[(size_t)(tok0 + 2 * lane + 1) * 16 + j];
                const float l0 = d0 * nega, l1 = d1 * nega;
                float incl = l0 + l1;
#pragma unroll
                for (int o = 1; o < 64; o <<= 1) { const float v = __shfl_up(incl, o); if (lane >= o) incl += v; }
                const float tot = __shfl(incl, 63), excl = incl - (l0 + l1);
                const float cu0 = j < 8 ? excl + l0 : excl, cu1 = j < 8 ? incl : excl + l0;
                float* dd = DTT + ((size_t)ch * 16 + j) * 128 + 2 * lane; float* cc = CUM + ((size_t)ch * 16 + j) * 128 + 2 * lane; float* ww = WST + ((size_t)ch * 16 + j) * 128 + 2 * lane;
                *(float2*)dd = make_float2(d0, d1);
                *(float2*)cc = make_float2(cu0, cu1);
                *(float2*)ww = make_float2(d0 * (j < 8 ? __expf(tot - cu0) : __expf(cu0)), d1 * (j < 8 ? __expf(tot - cu1) : __expf(cu1)));
                if (lane == 0) TOT[ch * 16 + j] = tot;
            }
        }
    }
}
DEV void phase_pc(const P& p, int layer, unsigned char* lds) {
    const int N = NCH * 29, G = vgrid();
    PcRegs A, B;
    int u = vbid();
    if (u < N) pc_issue(p, layer, u, A);
    for (; u < N; u += 2 * G) {
        const int u1 = u + G, u2 = u + 2 * G;
        if (u1 < N) pc_issue(p, layer, u1, B);
        pc_consume(p, layer, lds, u, A);
        if (u1 >= N) break;
        if (u2 < N) pc_issue(p, layer, u2, A);
        pc_consume(p, layer, lds, u1, B);
    }
}

struct LdXTw {
    const bf16_t* xt; const float* w;
    DEV RawV raw(int, int r, int kcg) const {
        RawV x; x.q0 = *(const u32x4*)(xt + (size_t)(r >> 6) * 8192 + kcg * 512 + (r & 63) * 8);
        const float* wp = w + (r >> 6) * 128 + kcg * 8;
        x.q1 = *(const u32x4*)wp; x.q2 = *(const u32x4*)(wp + 4); return x;
    }
    DEV uint4 fin(const RawV& x, int, int, int) const {
        float f[8]; unpack8(as_uint4(x.q0), f);
#pragma unroll
        for (int e = 0; e < 4; ++e) { f[e] *= __uint_as_float(x.q1[e]); f[4 + e] *= __uint_as_float(x.q2[e]); }
        return pack8(f);
    }
};
struct EpStoreF32 {
    float* O;
    DEV void pre(int) {}
    DEV void operator()(const float* ct, int tid) const {
#pragma unroll
        for (int i = 0; i < 8; ++i) {
            const int id = tid + 256 * i, c8 = id >> 7, r = id & 127;
            *(float4*)(O + (size_t)c8 * 1024 + r * 8) = *(const float4*)(ct + r * 132 + c8 * 8);
            *(float4*)(O + (size_t)c8 * 1024 + r * 8 + 4) = *(const float4*)(ct + r * 132 + c8 * 8 + 4);
        }
    }
};
DEV void phase_pd(const P& p, unsigned char* lds) {
    const bf16_t* XT = (const bf16_t*)(wsp(p) + WS_XT); const bf16_t* BT = (const bf16_t*)(wsp(p) + WS_BT); const bf16_t* BC = (const bf16_t*)(wsp(p) + WS_BC); const bf16_t* CF = (const bf16_t*)(wsp(p) + WS_CF);
    const float* WST = (const float*)(wsp(p) + WS_WST);
    bf16_t* SST = (bf16_t*)(wsp(p) + WS_SST); float* CB = (float*)(wsp(p) + WS_CB);
    for (int u = vbid(); u < NCH * 10; u += vgrid()) {
        const int ch = u / 10, sub = u % 10;
        if (sub < 8) {
            const int dir = sub >> 2, hp = sub & 3, h0 = hp * 2, g = hp >> 1;
            LdXTw al{XT + ((size_t)ch * 8 + h0) * 64 * 128, WST + ((size_t)ch * 16 + dir * 8 + h0) * 128};
            LdRows bl{BT + ((size_t)ch * 2 + g) * 128 * 128, 128, 8};
            EpStoreBf16 ep{SST + (((size_t)ch * 2 + dir) * 8 + h0) * 64 * 128};
            gemm_tile<128, 2>(lds, al, bl, ep);
        } else {
            const int g = sub - 8;
            LdRows al{CF + ((size_t)ch * 2 + g) * 128 * 128, 8, 1024}, bl{BC + (size_t)ch * 128 * 512 + g * 128, 512, 8};
            EpStoreF32 ep{CB + ((size_t)ch * 2 + g) * 128 * 128};
            gemm_tile<128, 2>(lds, al, bl, ep);
        }
    }
}
DEV void phase_pe(const P& p) {
    bf16_t* SST = (bf16_t*)(wsp(p) + WS_SST); const float* TOT = (const float*)(wsp(p) + WS_TOT);
    for (int gid = vbid() * 256 + tidx(); gid < NB * 2 * 8 * 64 * 16; gid += vgrid() * 256) {
        const int n8 = gid & 15, pp = (gid >> 4) & 63, h = (gid >> 10) & 7, dir = (gid >> 13) & 1, b = gid >> 14;
        u32x4 loc[18]; float dec[18];
#pragma unroll
        for (int st = 0; st < 18; ++st) {
            const int ch = dir == 0 ? (st < 2 ? NCHL + b * 2 + st : b * 16 + (st - 2)) : (st < 2 ? NCHL + b * 2 + (1 - st) : b * 16 + (17 - st));
            loc[st] = *(const u32x4*)(SST + ((((size_t)ch * 2 + dir) * 8 + h) * 64 + pp) * 128 + n8 * 8);
            dec[st] = TOT[ch * 16 + dir * 8 + h];
        }
        float run[8];
#pragma unroll
        for (int e = 0; e < 8; ++e) run[e] = 0.f;
#pragma unroll
        for (int st = 0; st < 18; ++st) {
            const int ch = dir == 0 ? (st < 2 ? NCHL + b * 2 + st : b * 16 + (st - 2)) : (st < 2 ? NCHL + b * 2 + (1 - st) : b * 16 + (17 - st));
            *(uint4*)(SST + ((((size_t)ch * 2 + dir) * 8 + h) * 64 + pp) * 128 + n8 * 8) = pack8(run);
            const float d = __expf(dec[st]);
            const u32x4 q = loc[st];
            run[0] = d * run[0] + bflo(q.x); run[1] = d * run[1] + bfhi(q.x); run[2] = d * run[2] + bflo(q.y); run[3] = d * run[3] + bfhi(q.y);
            run[4] = d * run[4] + bflo(q.z); run[5] = d * run[5] + bfhi(q.z); run[6] = d * run[6] + bflo(q.w); run[7] = d * run[7] + bfhi(q.w);
        }
    }
}
struct LdG {
    const float* cb; const bf16_t* cm; const float* sv; float totb, dsk;
    DEV RawV raw(int, int r, int kcg) const {
        const int seg = kcg >> 4, kk = (kcg & 15) * 8;
        RawV x;
        if (seg == 0 || seg == 2) { x.q0 = *(const u32x4*)(cb + (size_t)r * 128 + kk); x.q1 = *(const u32x4*)(cb + (size_t)r * 128 + kk + 4); }
        else x.q0 = *(const u32x4*)(cm + (size_t)r * 512 + kk);
        return x;
    }
    DEV uint4 fin(const RawV& x, int, int r, int kcg) const {
        const int seg = kcg >> 4, kk = (kcg & 15) * 8;
        float f[8];
        if (seg == 0 || seg == 2) {
            const bool fwd = seg == 0;
            if (fwd ? (kk > r) : (kk + 7 < r)) return make_uint4(0u, 0u, 0u, 0u);
            float cbv[8];
#pragma unroll
            for (int e = 0; e < 4; ++e) { cbv[e] = __uint_as_float(x.q0[e]); cbv[4 + e] = __uint_as_float(x.q1[e]); }
            const float* cu = sv + (fwd ? 0 : 128); const float* dt = sv + (fwd ? 256 : 384);
            const float4 c0 = *(const float4*)(cu + kk), c1 = *(const float4*)(cu + kk + 4), d0 = *(const float4*)(dt + kk), d1 = *(const float4*)(dt + kk + 4);
            const float cus[8] = {c0.x, c0.y, c0.z, c0.w, c1.x, c1.y, c1.z, c1.w}, dts[8] = {d0.x, d0.y, d0.z, d0.w, d1.x, d1.y, d1.z, d1.w};
            const float cl = cu[r];
#pragma unroll
            for (int e = 0; e < 8; ++e) {
                const int s = kk + e;
                const bool on = fwd ? (s <= r) : (s >= r);
                const float ex = fwd ? __expf(cl - cus[e]) : __expf(cus[e] - cl);
                float v = on ? cbv[e] * ex * dts[e] : 0.f;
                if (fwd && s == r) v += dsk;
                f[e] = v;
            }
        } else {
            unpack8(as_uint4(x.q0), f);
            const float sc = seg == 1 ? __expf(sv[r]) : __expf(totb - sv[128 + r]);
#pragma unroll
            for (int e = 0; e < 8; ++e) f[e] *= sc;
        }
        return pack8(f);
    }
};
struct LdXS {
    const bf16_t* xt; const bf16_t* sf; const bf16_t* sb;
    DEV RawV raw(int, int r, int kcg) const {
        const int seg = kcg >> 4, kk = (kcg & 15) * 8;
        const bf16_t* base = (seg == 1) ? sf : (seg == 3 ? sb : xt);
        RawV x; x.q0 = *(const u32x4*)(base + (size_t)r * 128 + kk); return x;
    }
    DEV uint4 fin(const RawV& x, int, int, int) const { return as_uint4(x.q0); }
};
struct EpSsd {
    const bf16_t* z; bf16_t* o; float* ssq;
    u32x4 zr[4];
    DEV void pre(int tid) {
#pragma unroll
        for (int i = 0; i < 4; ++i) { const int id = tid + 256 * i, r = id >> 3, c8 = id & 7; zr[i] = *(const u32x4*)(z + (size_t)r * NIN + c8 * 8); }
    }
    DEV void operator()(const float* ct, int tid) const {
#pragma unroll
        for (int i = 0; i < 4; ++i) {
            const int id = tid + 256 * i, r = id >> 3, c8 = id & 7;
            float v[8], zz[8]; ld8f(ct, r * 64 + c8 * 8, v);
            unpack8(as_uint4(zr[i]), zz);
            float ss = 0.f;
#pragma unroll
            for (int e = 0; e < 8; ++e) { v[e] *= silu_f(zz[e]); ss += v[e] * v[e]; }
            *(uint4*)(o + (size_t)r * DM + c8 * 8) = pack8(v);
            ss += __shfl_xor(ss, 1); ss += __shfl_xor(ss, 2); ss += __shfl_xor(ss, 4);
            if (c8 == 0) ssq[(size_t)r * 8] = ss;
        }
    }
};
DEV void phase_pf(const P& p, int layer, unsigned char* lds) {
    const bf16_t* XT = (const bf16_t*)(wsp(p) + WS_XT); const bf16_t* CF = (const bf16_t*)(wsp(p) + WS_CF); const bf16_t* SST = (const bf16_t*)(wsp(p) + WS_SST);
    const float* CB = (const float*)(wsp(p) + WS_CB); const float* CUM = (const float*)(wsp(p) + WS_CUM); const float* DTT = (const float*)(wsp(p) + WS_DTT); const float* TOT = (const float*)(wsp(p) + WS_TOT);
    const bf16_t* QK = (const bf16_t*)(wsp(p) + WS_QKVZX); bf16_t* AS = (bf16_t*)(wsp(p) + WS_AS); float* SSQ = (float*)(wsp(p) + WS_SSQ);
    const int nch = (layer == 0) ? NCH : NCHL;
    const int tid = tidx(), lane = tid & 63, wid = tid >> 6, lr = lane & 31, lh = lane >> 5;
    float* sv = (float*)(lds + wid * 2048);
    for (int u = vbid(); u < nch * 8; u += vgrid()) {
        const int ch = u >> 3, h = u & 7, g = h >> 2, tok0 = ch * 128, l = wid * 32 + lr;
        {
            const float* c0 = CUM + ((size_t)ch * 16 + h) * 128 + lane; const float* d0 = DTT + ((size_t)ch * 16 + h) * 128 + lane;
            const float a0 = c0[0], a1 = c0[64], b0 = c0[1024], b1 = c0[1088], e0 = d0[0], e1 = d0[64], f0 = d0[1024], f1 = d0[1088];
            sv[lane] = a0; sv[64 + lane] = a1; sv[128 + lane] = b0; sv[192 + lane] = b1; sv[256 + lane] = e0; sv[320 + lane] = e1; sv[384 + lane] = f0; sv[448 + lane] = f1;
        }
        const float totb = TOT[ch * 16 + 8 + h], dsk = p.d_skip[layer * 8 + h];
        const char* cbU = uni_ptr(CB + ((size_t)ch * 2 + g) * 128 * 128); const char* xtU = uni_ptr(XT + ((size_t)ch * 8 + h) * 64 * 128);
        const char* cmU = uni_ptr(CF + ((size_t)ch * 2 + g) * 128 * 128);
        const char* sfU = uni_ptr(SST + (((size_t)ch * 2 + 0) * 8 + h) * 64 * 128); const char* sbU = uni_ptr(SST + (((size_t)ch * 2 + 1) * 8 + h) * 64 * 128);
        unsigned ocb = (unsigned)(lh * 128 + l) * 32u, oxt = (unsigned)(lh * 64 + lr) * 16u, ocm = (unsigned)(lh * 128 + l) * 16u;
        asm volatile("" : "+v"(ocb), "+v"(oxt), "+v"(ocm));
#define PF_LD16(base, voff, imm) (*(const u32x4*)((base) + (voff) + (imm)))
        u32x4 rc0[8], rc1[8], rx0[8], rx1[8];
#pragma unroll
        for (int i = 0; i < 8; ++i) { rc0[i] = PF_LD16(cbU, ocb, 8192 * i); rc1[i] = PF_LD16(cbU, ocb, 8192 * i + 16); rx0[i] = PF_LD16(xtU, oxt, 2048 * i); rx1[i] = PF_LD16(xtU, oxt, 2048 * i + 512); }
        f32x16 acc[2];
#pragma unroll
        for (int e = 0; e < 16; ++e) { acc[0][e] = 0.f; acc[1][e] = 0.f; }
        const float cfl = sv[l], cbl = sv[128 + l];
        u32x4 rcm[8], rf0[8], rf1[8], rb0[8], rb1[8];
#pragma unroll
        for (int i = 0; i < 8; ++i) {
            const int sb = 16 * i + 8 * lh;
            const float4 q0 = *(const float4*)(sv + sb), q1 = *(const float4*)(sv + sb + 4), q2 = *(const float4*)(sv + 128 + sb), q3 = *(const float4*)(sv + 128 + sb + 4);
            const float4 q4 = *(const float4*)(sv + 256 + sb), q5 = *(const float4*)(sv + 256 + sb + 4), q6 = *(const float4*)(sv + 384 + sb), q7 = *(const float4*)(sv + 384 + sb + 4);
            const float cfs[8] = {q0.x, q0.y, q0.z, q0.w, q1.x, q1.y, q1.z, q1.w}, cbs[8] = {q2.x, q2.y, q2.z, q2.w, q3.x, q3.y, q3.z, q3.w};
            const float dfs[8] = {q4.x, q4.y, q4.z, q4.w, q5.x, q5.y, q5.z, q5.w}, dbs[8] = {q6.x, q6.y, q6.z, q6.w, q7.x, q7.y, q7.z, q7.w};
            float gv[8];
#pragma unroll
            for (int j = 0; j < 8; ++j) {
                const int s = sb + j;
                const float cbv = __uint_as_float(j < 4 ? rc0[i][j & 3] : rc1[i][j & 3]);
                const float arg = s < l ? cfl - cfs[j] : cbs[j] - cbl;
                float dtv = s < l ? dfs[j] : dbs[j];
                if (s == l) dtv += dfs[j];
                float v = cbv * __expf(arg) * dtv;
                if (s == l) v += dsk;
                gv[j] = v;
            }
            const bf16x8 gf = __builtin_bit_cast(bf16x8, pack8(gv));
            acc[0] = __builtin_amdgcn_mfma_f32_32x32x16_bf16(__builtin_bit_cast(bf16x8, rx0[i]), gf, acc[0], 0, 0, 0);
            acc[1] = __builtin_amdgcn_mfma_f32_32x32x16_bf16(__builtin_bit_cast(bf16x8, rx1[i]), gf, acc[1], 0, 0, 0);
            rcm[i] = PF_LD16(cmU, ocm, 4096 * i); rf0[i] = PF_LD16(sfU, oxt, 2048 * i); rf1[i] = PF_LD16(sfU, oxt, 2048 * i + 512);
            rb0[i] = PF_LD16(sbU, oxt, 2048 * i); rb1[i] = PF_LD16(sbU, oxt, 2048 * i + 512);
            __builtin_amdgcn_sched_barrier(0);
        }
        const char* zU = uni_ptr(QK + (size_t)tok0 * NIN + C_Z + h * 64);
        unsigned oz = (unsigned)(l * NIN + 4 * lh) * 2u; asm volatile("" : "+v"(oz));
        uint2 zr[8];
#pragma unroll
        for (int q = 0; q < 8; ++q) zr[q] = *(const uint2*)(zU + oz + 16 * q);
        const float af = __expf(cfl), ab = __expf(totb - cbl);
#pragma unroll
        for (int i = 0; i < 8; ++i) {
            float c[8], cf8[8], cb8[8];
            unpack8(as_uint4(rcm[i]), c);
#pragma unroll
            for (int j = 0; j < 8; ++j) { cf8[j] = c[j] * af; cb8[j] = c[j] * ab; }
            const bf16x8 ff = __builtin_bit_cast(bf16x8, pack8(cf8)), fb = __builtin_bit_cast(bf16x8, pack8(cb8));
            acc[0] = __builtin_amdgcn_mfma_f32_32x32x16_bf16(__builtin_bit_cast(bf16x8, rf0[i]), ff, acc[0], 0, 0, 0);
            acc[1] = __builtin_amdgcn_mfma_f32_32x32x16_bf16(__builtin_bit_cast(bf16x8, rf1[i]), ff, acc[1], 0, 0, 0);
            acc[0] = __builtin_amdgcn_mfma_f32_32x32x16_bf16(__builtin_bit_cast(bf16x8, rb0[i]), fb, acc[0], 0, 0, 0);
            acc[1] = __builtin_amdgcn_mfma_f32_32x32x16_bf16(__builtin_bit_cast(bf16x8, rb1[i]), fb, acc[1], 0, 0, 0);
        }
        bf16_t* op = AS + (size_t)(tok0 + l) * DM + h * 64 + 4 * lh;
#undef PF_LD16
        float ss = 0.f;
#pragma unroll
        for (int pt = 0; pt < 2; ++pt)
#pragma unroll
            for (int q = 0; q < 4; ++q) {
                const uint2 zz = zr[pt * 4 + q];
                const float z0 = bflo(zz.x), z1 = bfhi(zz.x), z2 = bflo(zz.y), z3 = bfhi(zz.y);
                const float y0 = acc[pt][4 * q] * silu_f(z0), y1 = acc[pt][4 * q + 1] * silu_f(z1), y2 = acc[pt][4 * q + 2] * silu_f(z2), y3 = acc[pt][4 * q + 3] * silu_f(z3);
                ss += (y0 * y0 + y1 * y1) + (y2 * y2 + y3 * y3);
                *(uint2*)(op + 32 * pt + 8 * q) = make_uint2(pk2(y0, y1), pk2(y2, y3));
            }
        ss += __shfl_xor(ss, 32);
        if (lh == 0) SSQ[(size_t)(tok0 + l) * 8 + h] = ss;
    }
}

DEV float fexp2(float x) { return __builtin_amdgcn_exp2f(x); }
#define ATT_SCORE(S_, qf_, m_, kb_) do { \
        _Pragma("unroll") for (int mt = 0; mt < 2; ++mt) _Pragma("unroll") for (int e = 0; e < 16; ++e) S_[mt][e] = -(m_); \
        __builtin_amdgcn_s_setprio(1); \
        _Pragma("unroll") for (int kk = 0; kk < 4; ++kk) _Pragma("unroll") for (int mt = 0; mt < 2; ++mt) \
            S_[mt] = __builtin_amdgcn_mfma_f32_32x32x16_bf16(kf[kk][mt], qf_[kk], S_[mt], 0, 0, 0); \
        __builtin_amdgcn_s_setprio(0); } while (0)
#define ATT_SOFTMAX(S_, m_, l_, ot_, pb_) do { \
        float mx = S_[0][0]; \
        _Pragma("unroll") for (int e = 1; e < 16; ++e) mx = fmaxf(mx, S_[0][e]); \
        _Pragma("unroll") for (int e = 0; e < 16; ++e) mx = fmaxf(mx, S_[1][e]); \
        mx = fmaxf(mx, __shfl_xor(mx, 32)); \
        if (!__all(mx <= 8.f)) { \
            const float dm = fmaxf(mx, 0.f), alpha = fexp2(-dm); \
            m_ += dm; l_ *= alpha; \
            _Pragma("unroll") for (int dt = 0; dt < 2; ++dt) _Pragma("unroll") for (int e = 0; e < 16; ++e) ot_[dt][e] *= alpha; \
            _Pragma("unroll") for (int mt = 0; mt < 2; ++mt) _Pragma("unroll") for (int e = 0; e < 16; ++e) S_[mt][e] -= dm; \
        } \
        float ps = 0.f; \
        _Pragma("unroll") for (int mt = 0; mt < 2; ++mt) _Pragma("unroll") for (int e = 0; e < 16; ++e) { S_[mt][e] = fexp2(S_[mt][e]); ps += S_[mt][e]; } \
        l_ += ps; \
        _Pragma("unroll") for (int mt = 0; mt < 2; ++mt) _Pragma("unroll") for (int sx = 0; sx < 2; ++sx) { \
            const u32x4 pbu = {pk2(S_[mt][8 * sx], S_[mt][8 * sx + 1]), pk2(S_[mt][8 * sx + 2], S_[mt][8 * sx + 3]), pk2(S_[mt][8 * sx + 4], S_[mt][8 * sx + 5]), pk2(S_[mt][8 * sx + 6], S_[mt][8 * sx + 7])}; \
            pb_[mt][sx] = __builtin_bit_cast(bf16x8, pbu); } } while (0)
DEV void attn_unit(unsigned char* lds, const bf16_t* QP, const bf16_t* KP, const bf16_t* VT, bf16_t* AS, int b, int kvh, int hqa, int hqb, int tokA0, int tokB0, bool lat) {
    const int tid = tid512(), lane = tid & 63, wid = tid >> 6, lr = lane & 31, lh = lane >> 5;
    const int ntl = lat ? NKEY / 64 : LC / 64;
    const int tokA = tokA0 + wid * 32 + lr, tokB = tokB0 + wid * 32 + lr;
    bf16x8 qa[4], qb[4];
#pragma unroll
    for (int kk = 0; kk < 4; ++kk) { qa[kk] = *(const bf16x8*)(QP + (size_t)tokA * 512 + hqa * 64 + (2 * kk + lh) * 8); qb[kk] = *(const bf16x8*)(QP + (size_t)tokB * 512 + hqb * 64 + (2 * kk + lh) * 8); }
    f32x16 oa[2], ob[2];
#pragma unroll
    for (int dt = 0; dt < 2; ++dt)
#pragma unroll
        for (int e = 0; e < 16; ++e) { oa[dt][e] = 0.f; ob[dt][e] = 0.f; }
    float ma = 0.f, la = 0.f, mb = 0.f, lb = 0.f;
    const int sr = tid >> 3, sc = tid & 7;
    const bf16_t* vbase = VT + ((size_t)(b * 2 + kvh) * 64) * NKEY;
    const int fsw = (sc ^ ((sr >> 1) & 7)) << 4;
    u32x4 rk, rv;
#define ATT_LD(t_) do { const int tq = (t_); const int ktok0 = tq < 4 ? TL + b * LC + tq * 64 : b * SEQ + (tq - 4) * 64; \
        rk = *(const u32x4*)(KP + (size_t)(ktok0 + sr) * 128 + kvh * 64 + sc * 8); \
        rv = *(const u32x4*)(vbase + (size_t)sr * NKEY + tq * 64 + sc * 8); } while (0)
#define ATT_ST(buf_) do { unsigned char* kb_ = lds + (buf_) * 16384; unsigned char* vb_ = kb_ + 8192; \
        *(u32x4*)(kb_ + sr * 128 + fsw) = rk; \
        *(u32x4*)(vb_ + sr * 128 + fsw) = ((sr >> 4) & 1) ? __builtin_shufflevector(rv, rv, 2, 3, 0, 1) : rv; } while (0)
    const int rsw = (lr >> 1) & 7, hsw = (lr >> 4) & 1;
    ATT_LD(0);
    __syncthreads();
    ATT_ST(0);
    ATT_LD(1);
    ATT_ST(1);
    __syncthreads();
    for (int t = 0; t < ntl; ++t) {
        if (t + 2 < ntl) ATT_LD(t + 2);
        const unsigned char* kb = lds + (t % 3) * 16384; const unsigned char* vb = kb + 8192;
        bf16x8 kf[4][2];
#pragma unroll
        for (int kk = 0; kk < 4; ++kk)
#pragma unroll
            for (int mt = 0; mt < 2; ++mt) kf[kk][mt] = *(const bf16x8*)(kb + (mt * 32 + lr) * 128 + (((2 * kk + lh) ^ rsw) << 4));
        f32x16 st[2]; bf16x8 pa[2][2], pbb[2][2];
        ATT_SCORE(st, qa, ma, kb);
        ATT_SOFTMAX(st, ma, la, oa, pa);
        ATT_SCORE(st, qb, mb, kb);
        ATT_SOFTMAX(st, mb, lb, ob, pbb);
#pragma unroll
        for (int mt = 0; mt < 2; ++mt)
#pragma unroll
            for (int sx = 0; sx < 2; ++sx) {
                bf16x8 va[2];
#pragma unroll
                for (int dt = 0; dt < 2; ++dt) {
                    const unsigned char* vr = vb + (dt * 32 + lr) * 128 + ((lh ^ hsw) << 3);
                    const int c0 = 4 * mt + 2 * sx;
                    const uint2 h0 = *(const uint2*)(vr + ((c0 ^ rsw) << 4)), h1 = *(const uint2*)(vr + (((c0 + 1) ^ rsw) << 4));
                    va[dt] = __builtin_bit_cast(bf16x8, (u32x4){h0.x, h0.y, h1.x, h1.y});
                }
#pragma unroll
                for (int dt = 0; dt < 2; ++dt) {
                    oa[dt] = __builtin_amdgcn_mfma_f32_32x32x16_bf16(va[dt], pa[mt][sx], oa[dt], 0, 0, 0);
                    ob[dt] = __builtin_amdgcn_mfma_f32_32x32x16_bf16(va[dt], pbb[mt][sx], ob[dt], 0, 0, 0);
                }
            }
        if (t + 2 < ntl) ATT_ST((t + 2) % 3);
        __syncthreads();
    }
#undef ATT_LD
#undef ATT_ST
    la += __shfl_xor(la, 32); lb += __shfl_xor(lb, 32);
    const float ila = 1.f / la, ilb = 1.f / lb;
    bf16_t* rowA = AS + (size_t)tokA * DM + 512 + hqa * 64; bf16_t* rowB = AS + (size_t)tokB * DM + 512 + hqb * 64;
#pragma unroll
    for (int dt = 0; dt < 2; ++dt)
#pragma unroll
        for (int g = 0; g < 4; ++g) {
            const int d0 = 32 * dt + 8 * g + 4 * lh;
            *(uint2*)(rowA + d0) = make_uint2(pk2(oa[dt][4 * g] * ila, oa[dt][4 * g + 1] * ila), pk2(oa[dt][4 * g + 2] * ila, oa[dt][4 * g + 3] * ila));
            *(uint2*)(rowB + d0) = make_uint2(pk2(ob[dt][4 * g] * ilb, ob[dt][4 * g + 1] * ilb), pk2(ob[dt][4 * g + 2] * ilb, ob[dt][4 * g + 3] * ilb));
        }
}
DEV void phase_pg(const P& p, int layer, unsigned char* lds) {
    const bf16_t* QP = (const bf16_t*)(wsp(p) + WS_QP); const bf16_t* KP = (const bf16_t*)(wsp(p) + WS_KP); const bf16_t* VT = (const bf16_t*)(wsp(p) + WS_VT);
    bf16_t* AS = (bf16_t*)(wsp(p) + WS_AS);
    const int nctx = (layer == 0) ? 32 : 0;
    for (int u0 = blockIdx.x; u0 < 256 + nctx; u0 += gridDim.x) {
        const int u = (u0 < 256 && gridDim.x == 256) ? (u0 & 7) * 32 + (u0 >> 3) : u0;
        if (u < 256) { const int b = u >> 5, hq = (u >> 2) & 7, qb = u & 3; attn_unit(lds, QP, KP, VT, AS, b, hq >> 2, hq, hq, b * SEQ + qb * 512, b * SEQ + qb * 512 + 256, true); }
        else { const int uu = u - 256, b = uu >> 2, hp = uu & 3; attn_unit(lds, QP, KP, VT, AS, b, hp >> 1, 2 * hp, 2 * hp + 1, TL + b * LC, TL + b * LC, false); }
    }
}

struct EpiOut {
    static constexpr int MID_T = 8;
    bf16_t* O; const float* ssq;
    DEV void mid(g8::f32x4 (&acc)[2][2][4][2], const g8::Unit& u, int wr, int fr) const {
#pragma unroll
        for (int ai = 0; ai < 2; ++ai)
#pragma unroll
            for (int m = 0; m < 4; ++m) {
                const float* q = ssq + (size_t)(u.row0 + ai * 128 + wr * 64 + m * 16 + fr) * 8;
                const float4 a = *(const float4*)q, b = *(const float4*)(q + 4);
                const float rs = rsqrtf((((a.x + a.y) + (a.z + a.w)) + ((b.x + b.y) + (b.z + b.w))) * (1.f / 512.f) + EPS);
#pragma unroll
                for (int bj = 0; bj < 2; ++bj)
#pragma unroll
                    for (int n = 0; n < 2; ++n) acc[ai][bj][m][n] = acc[ai][bj][m][n] * rs;
            }
    }
    DEV void operator()(const g8::f32x4 (&acc)[2][2][4][2], const g8::Unit& u, int wr, int wc, int fr, int fq) const { g8::EpiStore{O, DM}(acc, u, wr, wc, fr, fq); }
};
DEV void phase_ph(const P& p, int layer, LAS unsigned char* lds) {
    const int nt = (layer == 0) ? TT : TL;
    g8::SchedDense S{(const bf16_t*)(wsp(p) + WS_AS), (const bf16_t*)(wsp(p) + WS_WOUT), DM, DM, nt / 256, DM / 256, (int)gridDim.x, (int)blockIdx.x};
    EpiOut E{(bf16_t*)(wsp(p) + WS_ML), (const float*)(wsp(p) + WS_SSQ)};
    g8::gemm(lds, S, E, DM / 64, DM);
}

struct MoeMap { int offs[66]; int tp[66]; };
DEV void build_map(const P& p, int layer, MoeMap* mm) {
    const unsigned* cnt = (const unsigned*)(wsp(p) + WS_CTL) + CW_CNT + layer * CNT_LAYER;
    const int nt = (layer == 0) ? TT : TL;
    __syncthreads();
    if (tidx() == 0) {
        int o = 0, t = 0;
        for (int e = 0; e < 65; ++e) {
            const int c = e < 64 ? (int)__hip_atomic_load(&cnt[e * CNT_STRIDE], __ATOMIC_RELAXED, __HIP_MEMORY_SCOPE_AGENT) : nt;
            mm->offs[e] = o; mm->tp[e] = t; o += c; t += (c + 255) >> 8;
        }
        mm->offs[65] = o; mm->tp[65] = t;
    }
    __syncthreads();
}
template <class MP> DEV int find_expert(MP mm, int ti) {
    const int l = hw_lane(); const bool le = mm->tp[l + 1] <= ti;
    return (int)__popcll(__ballot(le));
}

template <int mode> struct SchedMoe {
    static constexpr bool GATHER = (mode == 0), F8 = true;
    const MoeMap* mm; int nsub, G, c;
    const bf16_t* A; const bf16_t* W0; const bf16_t* W1; const uint2* LIST;
    DEV bool next(int i, g8::Unit& u) const {
        const LAS MoeMap* mm; { unsigned o = (unsigned)(size_t)(const LAS MoeMap*)this->mm; asm volatile("" : "+s"(o)); mm = (const LAS MoeMap*)(size_t)o; }
        const int ntile = __builtin_amdgcn_readfirstlane(mm->tp[65]), w = g8::deal(i, G, c, ntile * nsub); if (w < 0) return false;
        const int ti = w / nsub, sub = w % nsub, e = __builtin_amdgcn_readfirstlane(find_expert(mm, ti)), tt = __builtin_amdgcn_readfirstlane(ti - mm->tp[e]);
        const int cnt_e = __builtin_amdgcn_readfirstlane(mm->offs[e + 1] - mm->offs[e]), nvalid = min(256, cnt_e - tt * 256), slot0 = __builtin_amdgcn_readfirstlane(mm->offs[e]) + tt * 256;
        u.row0 = slot0; u.nvalid = nvalid; u.sub = sub;
        if (mode == 0) {
            u.a = (const char*)A; u.b0 = (const char*)W0 + ((size_t)e * FE + sub * 128) * DM; u.b1 = (const char*)W1 + ((size_t)e * FE + sub * 128) * DM;
            u.aux = e < 64 ? (const void*)(LIST + (size_t)e * CAP + tt * 256) : nullptr; u.col0 = tt * 256;
        } else {
            u.a = (const char*)A + (size_t)slot0 * FE; u.b0 = (const char*)W0 + ((size_t)e * DM + sub * 256) * FE; u.b1 = u.b0 + (size_t)128 * FE;
            u.aux = nullptr; u.col0 = sub * 256;
        }
        return true;
    }
    DEV size_t a_half() const { return mode == 0 ? (size_t)0 : (size_t)128 * FE; }
    DEV void a_off(const g8::Unit& u, unsigned (&v0)[2], unsigned (&v1)[2]) const {
        const int tz = tid512();
        if (mode == 0) {
            const uint2* lst = (const uint2*)u.aux;
#pragma unroll
            for (int i = 0; i < 2; ++i) {
                int R, C; g8::stage_rc(tz * 16 + i * 8192, R, C);
                const int ra = R < u.nvalid ? R : 0, rb = (128 + R) < u.nvalid ? 128 + R : 0;
                const unsigned ta = lst ? lst[ra].x : (unsigned)(u.col0 + ra), tb = lst ? lst[rb].x : (unsigned)(u.col0 + rb);
                v0[i] = ta * (unsigned)DM + (unsigned)C * 2u; v1[i] = tb * (unsigned)DM + (unsigned)C * 2u;
            }
        } else {
#pragma unroll
            for (int i = 0; i < 2; ++i) { int R, C; g8::stage_rc(tz * 16 + i * 8192, R, C); v0[i] = (unsigned)(R * FE + C * 2); v1[i] = v0[i]; }
        }
    }
};
struct EpiAct {
    static constexpr int MID_T = 0;
    unsigned char* act;
    DEV void operator()(const g8::f32x4 (&acc)[2][2][4][2], const g8::Unit& u, int wr, int wc, int fr, int fq) const {
        const uint2* lst = (const uint2*)u.aux;
#pragma unroll
        for (int ai = 0; ai < 2; ++ai)
#pragma unroll
            for (int m = 0; m < 4; ++m) {
                const int r = ai * 128 + wr * 64 + m * 16 + fr;
                if (r < u.nvalid) {
                    const float gate = (lst ? __builtin_bit_cast(float, lst[r].y) : 1.f) * (GU_DESCALE * A8_SCALE);
                    float o[8];
#pragma unroll
                    for (int n = 0; n < 2; ++n)
#pragma unroll
                        for (int j = 0; j < 4; ++j) o[4 * n + j] = silu_f(acc[ai][0][m][n][j] * GU_DESCALE) * acc[ai][1][m][n][j] * gate;
                    *(uint2*)(act + (size_t)(u.row0 + r) * FE + u.sub * 128 + wc * 32 + 8 * fq) = make_uint2(pk4_f8(o[0], o[1], o[2], o[3]), pk4_f8(o[4], o[5], o[6], o[7]));
                }
            }
    }
};
DEV void phase_pj(const P& p, int layer, LAS unsigned char* lds, MoeMap* mm) {
    build_map(p, layer, mm);
    SchedMoe<0> S{mm, 2, (int)gridDim.x, (int)blockIdx.x, (const bf16_t*)(wsp(p) + WS_H), (const bf16_t*)(wsp(p) + WS_WG), (const bf16_t*)(wsp(p) + WS_WU), (const uint2*)(wsp(p) + WS_LIST)};
    EpiAct E{(unsigned char*)(wsp(p) + WS_ACT)};
    g8::gemm(lds, S, E, DM / 128, DM / 2);
}
template <bool FP8> DEV void phase_pk(const P& p, int layer, LAS unsigned char* lds, MoeMap* mm) {
    build_map(p, layer, mm);
    SchedMoe<1> S{mm, 4, (int)gridDim.x, (int)blockIdx.x, (const bf16_t*)(wsp(p) + WS_ACT), (const bf16_t*)(wsp(p) + WS_WD), nullptr, nullptr};
    static_assert(FP8, "the down projection runs on e4m3 operands and parks e4m3 outputs");
    g8::EpiStore8 E{(unsigned char*)(wsp(p) + WS_YH), DM, DN_RESCALE}; g8::gemm(lds, S, E, FE / 128, FE / 2);
}
template <int RPW> DEV void phase_pm(const P& p, int layer, unsigned char* lds, MoeMap* mm, int row0, int nrows) {
    const bool last = (layer == 1);
    const int tid = tidx(), lane = tid & 63, wid = tid >> 6;
    const float* MOD = (const float*)(wsp(p) + WS_MOD);
    const bf16_t* YH = (const bf16_t*)(wsp(p) + WS_YH); const unsigned* TOPK = (const unsigned*)(wsp(p) + WS_TOPK);
    bf16_t* XB = (bf16_t*)(wsp(p) + WS_XB);
    bf16_t* H = (bf16_t*)(wsp(p) + WS_HIN1); float* DT = (float*)(wsp(p) + WS_DT);
    float* hl = (float*)lds; float* part = (float*)(lds + HL_BYTES);
    build_map(p, layer, mm);
    for (int task = vbid(); task < nrows / (4 * RPW); task += vgrid()) {
        const int tok0 = row0 + task * (4 * RPW) + wid * RPW;
        bf16_t* xb = XB + (size_t)tok0 * DM;
        const int mr = tok0 < TL ? tok0 / SEQ : 8;
        const float* md = MOD + ((size_t)layer * 9 + mr) * 6144;
        const float* md1 = MOD + ((size_t)(last ? layer : layer + 1) * 9 + mr) * 6144;
        float pa[16], pb[16], pc[16];
        ld_row16(md + 5120, lane, pa); ld_row16(md1 + 1024, lane, pb); ld_row16(md1 + 0, lane, pc);
        __syncthreads();
#pragma unroll 1
        for (int rr = 0; rr < RPW; ++rr) {
            const int tok = tok0 + rr;
            float x[16], y[16];
            ld_row16_bf(xb + (size_t)rr * DM, lane, x);
#pragma unroll
            for (int e = 0; e < 16; ++e) y[e] = 0.f;
#pragma unroll
            for (int k = 0; k < 9; ++k) {
                int slot;
                if (k < 8) { const unsigned tk = TOPK[(size_t)tok * 8 + k]; slot = mm->offs[tk & 255u] + (int)(tk >> 8); } else slot = mm->offs[64] + tok;
#pragma unroll
                for (int i = 0; i < 4; ++i) {
                    if (true) {
                        typedef float f32x2v __attribute__((ext_vector_type(2)));
                        const int q = *(const int*)((const unsigned char*)YH + (size_t)slot * DM + 4 * lane + 256 * i);
                        const f32x2v lo = __builtin_amdgcn_cvt_pk_f32_fp8(q, false), hi = __builtin_amdgcn_cvt_pk_f32_fp8(q, true);
                        y[4 * i] += lo[0]; y[4 * i + 1] += lo[1]; y[4 * i + 2] += hi[0]; y[4 * i + 3] += hi[1];
                    } else {
                        const uint2 q = *(const uint2*)(YH + (size_t)slot * DM + 4 * lane + 256 * i);
                        y[4 * i] += bflo(q.x); y[4 * i + 1] += bfhi(q.x); y[4 * i + 2] += bflo(q.y); y[4 * i + 3] += bfhi(q.y); }
                }
            }
            {
#pragma unroll
                for (int e = 0; e < 16; ++e) y[e] *= 0.0625f; }
            const float rsy = rstd16(y);
#pragma unroll
            for (int e = 0; e < 16; ++e) x[e] += pa[e] * (y[e] * rsy);
            if (last) st_row16(p.out + (size_t)tok * DM, lane, x); else st_row16_bf(xb + (size_t)rr * DM, lane, x);
            if (!last) {
                const float rs = rstd16(x);
                float h[16];
#pragma unroll
                for (int e = 0; e < 16; ++e) h[e] = x[e] * rs * pb[e] + pc[e];
                st_row16_bf(H + (size_t)tok * DM, lane, h);
                st_row16(hl + (wid * RPW + rr) * HLS, lane, h);
            }
        }
        if (!last) {
            __syncthreads();
            dt_tail16<RPW>(hl, (const float4*)(wsp(p) + WS_WD2) + 4096 * (layer + 1), p.dt_bias + (layer + 1) * 16, part, DT, row0 + task * (4 * RPW), tid);
        }
    }
}

#define XB_TMO      128
#define XB_XCNT(j)  (256  + 64 * (j))
#define XB_XSUB(j)  (1280 + 64 * (j))
#define XB_XGEN(j)  (2304 + 64 * (j))
#define XB_TOP      3328
#define XB_TOPGEN   3392
#define XCD_BAR_WORDS 3456
#define XB_SPIN_CAP (1u << 18)
static_assert((CW_QH + 64) * 4 <= (int)CTL_BYTES && CW_CNT + 2 * CNT_LAYER <= CW_QH, "control words");
static_assert(XCD_BAR_WORDS <= CW_CNT, "barrier words below the expert counters");

__device__ __forceinline__ unsigned xb_ld(unsigned* p)              { return __hip_atomic_load(p, __ATOMIC_RELAXED, __HIP_MEMORY_SCOPE_AGENT); }
__device__ __forceinline__ unsigned xb_add(unsigned* p, unsigned v) { return __hip_atomic_fetch_add(p, v, __ATOMIC_RELAXED, __HIP_MEMORY_SCOPE_AGENT); }
__device__ __forceinline__ unsigned xb_xcc_id() { return (unsigned)__builtin_amdgcn_s_getreg((3 << 11) | 20) & 0xFu; }
#define XB_SPIN(cond, bar) do { unsigned _sp = 0; while (cond) { __builtin_amdgcn_s_sleep(1); \
    if ((++_sp & 255u) == 0u) { if (xb_ld(&(bar)[XB_TMO])) break; if (_sp > XB_SPIN_CAP) { atomicAdd(&(bar)[XB_TMO], 1u); break; } } } } while (0)

struct XcdBarrier {
    unsigned* bar; unsigned x;
    volatile LAS unsigned* st;
};
__device__ __forceinline__ XcdBarrier xcd_barrier_post(unsigned* bar, volatile LAS unsigned* st) {
    XcdBarrier b; b.bar = bar; b.x = xb_xcc_id(); b.st = st;
    if (tid512() == 0) (void)xb_add(&bar[XB_XCNT(b.x)], 1u);
    return b;
}
__device__ __forceinline__ void xcd_barrier_complete(unsigned* bar, unsigned x, unsigned& nloc, unsigned& nx) {
    const unsigned G = gridDim.x * gridDim.y * gridDim.z;
    unsigned sum, cnt, mine, sp = 0u;
    for (;;) {
        sum = 0u; cnt = 0u; mine = 0u;
#pragma unroll
        for (unsigned j = 0; j < 16; ++j) { const unsigned c = xb_ld(&bar[XB_XCNT(j)]); sum += c; cnt += (c > 0u) ? 1u : 0u; mine = (j == x) ? c : mine; }
        if (sum == G) break;
        __builtin_amdgcn_s_sleep(1);
        if ((++sp & 255u) == 0u) { if (xb_ld(&bar[XB_TMO])) break; if (sp > XB_SPIN_CAP) { atomicAdd(&bar[XB_TMO], 1u); break; } }
    }
    nloc = mine > 0u ? mine : 1u; nx = cnt > 0u ? cnt : 1u;
}
__device__ __forceinline__ void xcd_barrier(const XcdBarrier& b) {
    asm volatile("s_waitcnt vmcnt(0)" ::: "memory");
    __syncthreads();
    if (tid512() == 0) {
        unsigned* bar = b.bar;
        __builtin_amdgcn_s_waitcnt(0);
        unsigned nloc = b.st[0], nx = b.st[1];
        if (nloc == 0u) { xcd_barrier_complete(bar, b.x, nloc, nx); b.st[0] = nloc; b.st[1] = nx; }
        const unsigned old = xb_add(&bar[XB_XSUB(b.x)], 1u);
        const unsigned gen = old / nloc;
        if (old + 1u == (gen + 1u) * nloc) {
            __builtin_amdgcn_fence(__ATOMIC_RELEASE, "agent");
            asm volatile("s_waitcnt vmcnt(0)" ::: "memory");
            const unsigned og = xb_add(&bar[XB_TOP], 1u);
            const unsigned tg = og / nx;
            if (og + 1u == (tg + 1u) * nx) xb_add(&bar[XB_TOPGEN], 1u);
            else XB_SPIN(xb_ld(&bar[XB_TOPGEN]) == tg, bar);
            __builtin_amdgcn_fence(__ATOMIC_ACQUIRE, "agent");
            xb_add(&bar[XB_XGEN(b.x)], 1u);
            asm volatile("s_waitcnt vmcnt(0)" ::: "memory");
        } else {
            XB_SPIN(xb_ld(&bar[XB_XGEN(b.x)]) == gen, bar);
            __builtin_amdgcn_fence(__ATOMIC_ACQUIRE, "agent");
            asm volatile("s_waitcnt vmcnt(0)" ::: "memory");
        }
    }
    __syncthreads();
}

DEV unsigned long long rfl64(unsigned long long v) { const unsigned lo = __builtin_amdgcn_readfirstlane((unsigned)v), hi = __builtin_amdgcn_readfirstlane((unsigned)(v >> 32)); return ((unsigned long long)hi << 32) | lo; }
DEV void park_params(const P& p, LAS unsigned long long* tab) { tab[0] = (unsigned long long)p.x; tab[1] = (unsigned long long)p.c; tab[2] = (unsigned long long)p.ctx; tab[3] = (unsigned long long)p.c_ctx; tab[4] = (unsigned long long)p.w_mod; tab[5] = (unsigned long long)p.b_mod; tab[6] = (unsigned long long)p.g_pre_mix; tab[7] = (unsigned long long)p.g_post_mix; tab[8] = (unsigned long long)p.g_pre_ffn; tab[9] = (unsigned long long)p.g_post_ffn; tab[10] = (unsigned long long)p.w_in; tab[11] = (unsigned long long)p.q_norm; tab[12] = (unsigned long long)p.k_norm; tab[13] = (unsigned long long)p.conv_w; tab[14] = (unsigned long long)p.conv_b; tab[15] = (unsigned long long)p.dt_bias; tab[16] = (unsigned long long)p.a_log; tab[17] = (unsigned long long)p.d_skip; tab[18] = (unsigned long long)p.ssd_norm; tab[19] = (unsigned long long)p.w_out; tab[20] = (unsigned long long)p.router_w; tab[21] = (unsigned long long)p.router_bias; tab[22] = (unsigned long long)p.w_gate; tab[23] = (unsigned long long)p.w_up; tab[24] = (unsigned long long)p.w_down; tab[25] = (unsigned long long)p.ws_gate; tab[26] = (unsigned long long)p.ws_up; tab[27] = (unsigned long long)p.ws_down; tab[28] = (unsigned long long)p.out; tab[29] = (unsigned long long)p.ws; }
DEV P load_params(const LAS unsigned long long* tab) { P q; q.x = (const float*)(GAS const float*)rfl64(tab[0]); q.c = (const float*)(GAS const float*)rfl64(tab[1]); q.ctx = (const float*)(GAS const float*)rfl64(tab[2]); q.c_ctx = (const float*)(GAS const float*)rfl64(tab[3]); q.w_mod = (const float*)(GAS const float*)rfl64(tab[4]); q.b_mod = (const float*)(GAS const float*)rfl64(tab[5]); q.g_pre_mix = (const float*)(GAS const float*)rfl64(tab[6]); q.g_post_mix = (const float*)(GAS const float*)rfl64(tab[7]); q.g_pre_ffn = (const float*)(GAS const float*)rfl64(tab[8]); q.g_post_ffn = (const float*)(GAS const float*)rfl64(tab[9]); q.w_in = (const float*)(GAS const float*)rfl64(tab[10]); q.q_norm = (const float*)(GAS const float*)rfl64(tab[11]); q.k_norm = (const float*)(GAS const float*)rfl64(tab[12]); q.conv_w = (const float*)(GAS const float*)rfl64(tab[13]); q.conv_b = (const float*)(GAS const float*)rfl64(tab[14]); q.dt_bias = (const float*)(GAS const float*)rfl64(tab[15]); q.a_log = (const float*)(GAS const float*)rfl64(tab[16]); q.d_skip = (const float*)(GAS const float*)rfl64(tab[17]); q.ssd_norm = (const float*)(GAS const float*)rfl64(tab[18]); q.w_out = (const float*)(GAS const float*)rfl64(tab[19]); q.router_w = (const float*)(GAS const float*)rfl64(tab[20]); q.router_bias = (const float*)(GAS const float*)rfl64(tab[21]); q.w_gate = (const float*)(GAS const float*)rfl64(tab[22]); q.w_up = (const float*)(GAS const float*)rfl64(tab[23]); q.w_down = (const float*)(GAS const float*)rfl64(tab[24]); q.ws_gate = (const float*)(GAS const float*)rfl64(tab[25]); q.ws_up = (const float*)(GAS const float*)rfl64(tab[26]); q.ws_down = (const float*)(GAS const float*)rfl64(tab[27]); q.out = (float*)(GAS float*)rfl64(tab[28]); q.ws = (unsigned char*)(GAS unsigned char*)rfl64(tab[29]); return q; }
static_assert(g8::STAGE_BYTES + 512 * 16 <= LDS_HALF + LDS_MAIN, "the 8-wave GEMM's stage buffers + parking slots must stay below the second half's MoE map");
static_assert(HL_BYTES + 16 * 64 * 4 + 512 <= LDS_MAIN, "row-phase LDS");
__device__ __noinline__ void grid_bar() {
    const LAS unsigned long long* ptab = (const LAS unsigned long long*)(smem_all + LDS_PT);
    XcdBarrier bar_; bar_.bar = (unsigned*)(GAS unsigned*)rfl64(ptab[29]); bar_.x = xb_xcc_id(); bar_.st = (volatile LAS unsigned*)(smem_all + LDS_XB);
    xcd_barrier(bar_);
}
__global__ void __launch_bounds__(NTHR, 2) k_mega(P p0) {
    if ((threadIdx.x & 63) == 0) ((LAS int*)(smem_all + LDS_WT))[hw_slot()] = (int)(threadIdx.x >> 6);
    __syncthreads();
    unsigned char* smem = smem_all + vhalf() * LDS_HALF;
    MoeMap* mm = (MoeMap*)(smem + LDS_MAIN);
    LAS unsigned long long* ptab = (LAS unsigned long long*)(smem_all + LDS_PT);
    if (tid512() == 0) { *(uint4*)(smem_all + LDS_XB) = make_uint4(0u, 0u, 0u, 0u); park_params(p0, ptab); }
    __syncthreads();
    (void)xcd_barrier_post((unsigned*)(p0.ws + WS_CTL), (volatile LAS unsigned*)(smem_all + LDS_XB));
#define GRID_BAR() grid_bar()
    phase_p0(load_params(ptab), 0, smem, 2, true);
    GRID_BAR();
    phase_pa0<4>(load_params(ptab), smem, 0, TL); phase_pa0<1>(load_params(ptab), smem, TL, TC);
    GRID_BAR();
#define LAYER_BODY(layer) do { \
        phase_pb(load_params(ptab), layer, (LAS unsigned char*)smem_all); \
        if (layer == 0 && blockIdx.x >= 136) fill_strips(load_params(ptab), smem, 3); \
        if (layer == 1) phase_p0(load_params(ptab), 1, smem, 1, false);        \
        GRID_BAR(); \
        phase_pc(load_params(ptab), layer, smem); \
        GRID_BAR(); \
        phase_pd(load_params(ptab), smem); phase_pg(load_params(ptab), layer, smem_all); \
        GRID_BAR(); \
        phase_pe(load_params(ptab)); \
        GRID_BAR(); \
        phase_pf(load_params(ptab), layer, smem); \
        if (layer == 0 && blockIdx.x >= 64) fill_strips(load_params(ptab), smem, 2); \
        GRID_BAR(); \
        phase_ph(load_params(ptab), layer, (LAS unsigned char*)smem_all); \
        if (layer == 0 && blockIdx.x >= 32) fill_strips(load_params(ptab), smem, 3); \
        GRID_BAR(); \
        phase_pi<4>(load_params(ptab), layer, smem, 0, TL); if (layer == 0) phase_pi<1>(load_params(ptab), layer, smem, TL, TC); \
        if (layer == 0) fill_strips(load_params(ptab), smem, -1); \
        GRID_BAR(); \
        phase_pj(load_params(ptab), layer, (LAS unsigned char*)smem_all, (MoeMap*)(smem_all + LDS_HALF + LDS_MAIN)); \
        GRID_BAR(); \
        phase_pk<true>(load_params(ptab), layer, (LAS unsigned char*)smem_all, (MoeMap*)(smem_all + LDS_HALF + LDS_MAIN)); \
        GRID_BAR(); \
        phase_pm<4>(load_params(ptab), layer, smem, mm, 0, TL); if (layer == 0) phase_pm<1>(load_params(ptab), layer, smem, mm, TL, TC); \
        if (layer == 0) { phase_p0(load_params(ptab), 1, smem, 0, false); GRID_BAR(); } \
    } while (0)
    LAYER_BODY(0);
    LAYER_BODY(1);
#undef LAYER_BODY
}

extern "C" void kernel_launch(void* const* d_in, const int* in_sizes, int n_in, void* d_out, int out_size, void* d_ws, size_t ws_size, hipStream_t stream) {
    if (ws_size < WS_END) { fprintf(stderr, "workspace too small: %zu < %zu\n", ws_size, (size_t)WS_END); return; }
    static int grid = 0;
    if (!grid) {
        int dev = 0, cus = 0, per_cu = 0;
        (void)hipGetDevice(&dev);
        (void)hipDeviceGetAttribute(&cus, hipDeviceAttributeMultiprocessorCount, dev);
        (void)hipFuncSetAttribute((const void*)k_mega, hipFuncAttributeMaxDynamicSharedMemorySize, LDS_BYTES);
        (void)hipOccupancyMaxActiveBlocksPerMultiprocessor(&per_cu, (const void*)k_mega, NTHR, LDS_BYTES);
        if (per_cu < 1) per_cu = 1;
        grid = cus;
    }
    P p{};
    const float** pp = (const float**)&p;
    for (int i = 0; i < 28; ++i) pp[i] = (const float*)d_in[i];
    p.out = (float*)d_out; p.ws = (unsigned char*)d_ws;
    (void)hipMemsetAsync(d_ws, 0, CTL_BYTES, stream);
    hipLaunchKernelGGL(k_mega, dim3(grid), dim3(NTHR), LDS_BYTES, stream, p);
}
```

```cpp
#include <hip/hip_runtime.h>
#include <stdint.h>
#include <stdio.h>

#define DEV __device__ __forceinline__
typedef unsigned short bf16_t;
typedef short bf16x8 __attribute__((ext_vector_type(8)));
typedef float f32x16 __attribute__((ext_vector_type(16)));
typedef __bf16 bf16x2_t __attribute__((ext_vector_type(2)));
typedef float f32x2_t __attribute__((ext_vector_type(2)));
typedef unsigned u32x4 __attribute__((ext_vector_type(4)));
typedef unsigned u32x2 __attribute__((ext_vector_type(2)));
typedef float f32x4v __attribute__((ext_vector_type(4)));

constexpr int NB = 8, SEQ = 2048, LC = 256, DM = 1024;
constexpr int TL = NB * SEQ, TC = NB * LC, TT = TL + TC;
constexpr int NCH = TT / 128, NCHL = TL / 128;
constexpr int NIN = 2304, NINF = 2320;
constexpr int C_Q = 0, C_K = 512, C_V = 640, C_Z = 768, C_X = 1280;
constexpr int NKEY = LC + SEQ;
constexpr int NEXP = 64, FE = 256, CAP = TT;
constexpr float EPS = 1e-6f;
constexpr float QSCALE = 0.125f * 1.4426950408889634f;
constexpr int NTHR = 512;
#define NWAVE_TOT (vgrid() * 4)

constexpr size_t al256(size_t x) { return (x + 255) & ~(size_t)255; }
constexpr size_t WS_CTL = 0, CTL_BYTES = 65536;
constexpr size_t WS_MOD = WS_CTL + CTL_BYTES;
constexpr size_t WS_ROPE = WS_MOD + al256((size_t)2 * 9 * 6144 * 4);
constexpr size_t WS_RW2 = WS_ROPE + (size_t)2048 * 32 * 8;
constexpr size_t WS_WD2 = WS_RW2 + (size_t)2 * 65536 * 4;
constexpr size_t WS_WIN = WS_WD2 + (size_t)2 * 16384 * 4;
constexpr size_t WS_WOUT = WS_WIN + (size_t)NIN * DM * 2;
constexpr size_t WS_WD = WS_WOUT + (size_t)DM * DM * 2;
constexpr size_t WS_XB = WS_WD + (size_t)65 * FE * DM * 2;
constexpr size_t WS_DT = WS_XB + (size_t)TT * DM * 2;
constexpr size_t WS_TOPK = WS_DT + (size_t)TT * 16 * 4;
constexpr size_t WS_LIST = WS_TOPK + (size_t)TT * 8 * 4;
constexpr size_t WS_CUM = WS_LIST + (size_t)NEXP * CAP * 8;
constexpr size_t WS_WST = WS_CUM + (size_t)NCH * 16 * 128 * 4;
constexpr size_t WS_DTT = WS_WST + (size_t)NCH * 16 * 128 * 4;
constexpr size_t WS_TOT = WS_DTT + (size_t)NCH * 16 * 128 * 4;
constexpr size_t WS_SSQ = WS_TOT + al256((size_t)NCH * 16 * 4);
constexpr size_t WS_ACT = WS_SSQ + (size_t)TT * 8 * 4;
constexpr size_t WS_HIN1 = WS_ACT;
constexpr size_t WS_WG = WS_ACT + (size_t)TT * 9 * FE * 2;
constexpr size_t WS_YH = WS_WG;
constexpr size_t WS_WU = WS_WG + (size_t)65 * FE * DM * 2;
constexpr size_t WS_H = WS_WU + (size_t)65 * FE * DM * 2;
constexpr size_t WS_R1 = WS_H + (size_t)TT * DM * 2;
constexpr size_t WS_QKVZX = WS_R1;
constexpr size_t WS_ML = WS_R1;
constexpr size_t WS_QP = WS_QKVZX + (size_t)TT * NIN * 2;
constexpr size_t WS_KP = WS_QP + (size_t)TT * 512 * 2;
constexpr size_t WS_VT = WS_KP + (size_t)TT * 128 * 2;
constexpr size_t WS_XT = WS_VT + (size_t)NB * 2 * 64 * NKEY * 2;
constexpr size_t WS_BT = WS_XT + (size_t)NCH * 8 * 64 * 128 * 2;
constexpr size_t WS_BC = WS_BT + (size_t)NCH * 2 * 128 * 128 * 2;
constexpr size_t WS_SST = WS_BC + (size_t)TT * 512 * 2;
constexpr size_t WS_CB = WS_SST + (size_t)NCH * 2 * 8 * 64 * 128 * 2;
constexpr size_t WS_AS = WS_CB + (size_t)NCH * 2 * 128 * 128 * 4;
constexpr size_t WS_CF = WS_AS + (size_t)TT * DM * 2;
constexpr size_t WS_R1A_END = WS_CF + (size_t)NCH * 2 * 128 * 128 * 2;
constexpr size_t WS_YH_END = WS_YH + (size_t)TT * 9 * DM * 2;
constexpr size_t WS_END = WS_R1A_END > WS_YH_END ? WS_R1A_END : WS_YH_END;
static_assert(WS_END <= (size_t)536 * 1024 * 1024, "workspace map too large");
constexpr float H8_SCALE = 4.f, W8_SCALE = 256.f, GU_DESCALE = 1.f / (H8_SCALE * W8_SCALE);
constexpr float A8_SCALE = 16.f, WD8_SCALE = 128.f, YH8_SCALE = 16.f, DN_RESCALE = YH8_SCALE / (A8_SCALE * WD8_SCALE);
constexpr int CW_CNT = 4096, CNT_STRIDE = 32, CNT_LAYER = 64 * CNT_STRIDE;

struct P {
    const float *x, *c, *ctx, *c_ctx, *w_mod, *b_mod, *g_pre_mix, *g_post_mix, *g_pre_ffn, *g_post_ffn, *w_in, *q_norm, *k_norm, *conv_w, *conv_b,
        *dt_bias, *a_log, *d_skip, *ssd_norm, *w_out, *router_w, *router_bias, *w_gate, *w_up, *w_down, *ws_gate, *ws_up, *ws_down;
    float* out;
    unsigned char* ws;
};

#define LAS __attribute__((address_space(3)))
extern __shared__ __attribute__((aligned(16))) unsigned char smem_all[];
constexpr int LDS_MAIN = 73728, LDS_HALF = LDS_MAIN + 1024, LDS_XB = 2 * LDS_HALF, LDS_PT = LDS_XB + 64, LDS_WT = LDS_PT + 256, LDS_QB = LDS_WT + 256, LDS_BYTES = LDS_QB + 64;
DEV int hw_slot() { return (int)__builtin_amdgcn_s_getreg((5 << 11) | 4) & 63; }
DEV int hw_wave() { return __builtin_amdgcn_readfirstlane(((const LAS int*)(smem_all + LDS_WT))[hw_slot()]); }
DEV int hw_lane() { unsigned z = 0u; asm volatile("" : "+v"(z)); return (int)__builtin_amdgcn_mbcnt_hi(~0u, __builtin_amdgcn_mbcnt_lo(~0u, z)); }
DEV int tid512() { int t = hw_wave() * 64 + hw_lane(); asm volatile("" : "+v"(t)); return t; }
DEV int tidx() { int t = (hw_wave() & 3) * 64 + hw_lane(); asm volatile("" : "+v"(t)); return t; }
DEV int vhalf() { int h = hw_wave() >> 2; asm volatile("" : "+s"(h)); return h; }
DEV int vbid() { return (int)blockIdx.x * 2 + vhalf(); }
DEV int vgrid() { return (int)gridDim.x * 2; }
#define GAS __attribute__((address_space(1)))
DEV unsigned char* wsp(const P& p) { GAS unsigned char* w = (GAS unsigned char*)p.ws; asm volatile("" : "+s"(w)); return (unsigned char*)w; }
DEV unsigned pk2(float lo, float hi) { f32x2_t v = {lo, hi}; bf16x2_t b = __builtin_convertvector(v, bf16x2_t); return __builtin_bit_cast(unsigned, b); }
DEV float bflo(unsigned u) { return __builtin_bit_cast(float, u << 16); }
DEV float bfhi(unsigned u) { return __builtin_bit_cast(float, u & 0xffff0000u); }
DEV void unpack8(uint4 q, float* f) { f[0] = bflo(q.x); f[1] = bfhi(q.x); f[2] = bflo(q.y); f[3] = bfhi(q.y); f[4] = bflo(q.z); f[5] = bfhi(q.z); f[6] = bflo(q.w); f[7] = bfhi(q.w); }
DEV unsigned pk4_f8(float a, float b, float c, float d) {
    a = fminf(fmaxf(a, -448.f), 448.f); b = fminf(fmaxf(b, -448.f), 448.f); c = fminf(fmaxf(c, -448.f), 448.f); d = fminf(fmaxf(d, -448.f), 448.f);
    int w = 0; w = __builtin_amdgcn_cvt_pk_fp8_f32(a, b, w, false); w = __builtin_amdgcn_cvt_pk_fp8_f32(c, d, w, true); return (unsigned)w;
}
DEV uint4 pack8(const float* f) { uint4 q; q.x = pk2(f[0], f[1]); q.y = pk2(f[2], f[3]); q.z = pk2(f[4], f[5]); q.w = pk2(f[6], f[7]); return q; }
DEV float wave_sum(float v) {
#pragma unroll
    for (int o = 32; o > 0; o >>= 1) v += __shfl_xor(v, o);
    return v;
}
DEV float silu_f(float v) { return v / (1.f + __expf(-v)); }
DEV float sigmoid_f(float v) { return 1.f / (1.f + __expf(-v)); }
DEV float softplus_f(float v) { return v > 20.f ? v : log1pf(__expf(v)); }

struct RawV { u32x4 q0, q1, q2; };
template <int BN, int NK, class AL, class BL, class EP>
DEV void gemm_tile(unsigned char* lds, AL& al, BL& bl, EP& ep) {
    constexpr int NT = BN / 64;
    constexpr int NBCH = BN / 32;
    constexpr int A_BYTES = 128 * 128, B_BYTES = BN * 128, STAGE = A_BYTES + B_BYTES;
    const int tid = tidx(), lane = tid & 63, wid = tid >> 6, wr = wid >> 1, wc = wid & 1;
    const int kc = tid & 7, r0 = tid >> 3;
    const int wsw = (kc ^ ((r0 >> 1) & 7)) << 4;
    const int rsw = (lane >> 1) & 7, lr = lane & 31, lh = lane >> 5;
    f32x16 acc[2][NT];
#pragma unroll
    for (int mi = 0; mi < 2; ++mi)
#pragma unroll
        for (int ni = 0; ni < NT; ++ni)
#pragma unroll
            for (int e = 0; e < 16; ++e) acc[mi][ni][e] = 0.f;
    RawV xa[2][4], xb[2][NBCH];
#define GT_RAW(set, ks_) do { _Pragma("unroll") for (int i = 0; i < 4; ++i) xa[set][i] = al.raw(i, r0 + 32 * i, (ks_) * 8 + kc); \
                              _Pragma("unroll") for (int i = 0; i < NBCH; ++i) xb[set][i] = bl.raw(i, r0 + 32 * i, (ks_) * 8 + kc); } while (0)
#define GT_PUT(set, ks_, stg) do { unsigned char* da_ = lds + (stg) * STAGE; \
        _Pragma("unroll") for (int i = 0; i < 4; ++i) *(uint4*)(da_ + (r0 + 32 * i) * 128 + wsw) = al.fin(xa[set][i], i, r0 + 32 * i, (ks_) * 8 + kc); \
        _Pragma("unroll") for (int i = 0; i < NBCH; ++i) *(uint4*)(da_ + A_BYTES + (r0 + 32 * i) * 128 + wsw) = bl.fin(xb[set][i], i, r0 + 32 * i, (ks_) * 8 + kc); } while (0)
    GT_RAW(0, 0);
    if (NK > 1) GT_RAW(1, 1);
    ep.pre(tid);
    __syncthreads();
    GT_PUT(0, 0, 0);
    __syncthreads();
#pragma unroll
    for (int ks = 0; ks < NK; ++ks) {
        const int cur = ks & 1;
        if (ks + 2 < NK) GT_RAW(cur, ks + 2);
        const unsigned char* sa = lds + cur * STAGE;
        const unsigned char* sb = sa + A_BYTES;
#pragma unroll
        for (int kk = 0; kk < 4; ++kk) {
            const int co = ((2 * kk + lh) ^ rsw) << 4;
            bf16x8 fa[2], fb[NT];
#pragma unroll
            for (int mi = 0; mi < 2; ++mi) fa[mi] = *(const bf16x8*)(sa + (wr * 64 + mi * 32 + lr) * 128 + co);
#pragma unroll
            for (int ni = 0; ni < NT; ++ni) fb[ni] = *(const bf16x8*)(sb + (wc * (BN / 2) + ni * 32 + lr) * 128 + co);
#pragma unroll
            for (int mi = 0; mi < 2; ++mi)
#pragma unroll
                for (int ni = 0; ni < NT; ++ni) acc[mi][ni] = __builtin_amdgcn_mfma_f32_32x32x16_bf16(fa[mi], fb[ni], acc[mi][ni], 0, 0, 0);
        }
        if (ks + 1 < NK) GT_PUT(cur ^ 1, ks + 1, cur ^ 1);
        __syncthreads();
    }
#undef GT_RAW
#undef GT_PUT
    float* ct = (float*)lds;
#pragma unroll
    for (int mi = 0; mi < 2; ++mi)
#pragma unroll
        for (int ni = 0; ni < NT; ++ni)
#pragma unroll
            for (int e = 0; e < 16; ++e) {
                const int row = wr * 64 + mi * 32 + (e & 3) + 8 * (e >> 2) + 4 * lh;
                const int col = wc * (BN / 2) + ni * 32 + lr;
                ct[row * (BN + 4) + col] = acc[mi][ni][e];
            }
    __syncthreads();
    ep(ct, tid);
}
DEV void ld8f(const float* ct, int off, float* v) {
    const float4 a = *(const float4*)(ct + off), b = *(const float4*)(ct + off + 4);
    v[0] = a.x; v[1] = a.y; v[2] = a.z; v[3] = a.w; v[4] = b.x; v[5] = b.y; v[6] = b.z; v[7] = b.w;
}

namespace g8 {
typedef float f32x4 __attribute__((ext_vector_type(4)));
constexpr int BM = 256, BK = 64, HALF = 128, HTB = HALF * BK * 2, STAGE_BYTES = 8 * HTB;
DEV int lds_byte(int r, int c) { const int st = (r >> 4) * 2 + (c >> 5), rr = r & 15, cc = c & 31, ob = rr * 64 + cc * 2; return st * 1024 + (ob ^ (((ob >> 9) & 1) << 5)); }
DEV void stage_rc(int b, int& R, int& C) { const int st = b / 1024, sb = b % 1024, swz = sb ^ (((sb >> 9) & 1) << 5); R = (st >> 1) * 16 + swz / 64; C = (st & 1) * 32 + (swz % 64) / 2; }
DEV int perm32(int rho) { const int n = rho >> 4, i = rho & 15; return 8 * (i >> 2) + 4 * n + (i & 3); }
struct Unit { const char* a; const char* b0; const char* b1; const void* aux; int row0, col0, nvalid, sub; };
typedef int i32x8 __attribute__((ext_vector_type(8)));
typedef int i32x4 __attribute__((ext_vector_type(4)));
DEV i32x8 cat8(const bf16x8 a, const bf16x8 b) { return __builtin_shufflevector(__builtin_bit_cast(i32x4, a), __builtin_bit_cast(i32x4, b), 0, 1, 2, 3, 4, 5, 6, 7); }
DEV const char* uni(const char* p) { const unsigned long long v = (unsigned long long)p; const unsigned lo = __builtin_amdgcn_readfirstlane((unsigned)v), hi = __builtin_amdgcn_readfirstlane((unsigned)(v >> 32)); return (const char*)(GAS const char*)(((unsigned long long)hi << 32) | lo); }
template <class Epi, class Sched>
DEV void gemm(LAS unsigned char* lds, const Sched& S, const Epi& E, const int nt  , const int ldb  ) {
    const int tid = tid512(), wid = __builtin_amdgcn_readfirstlane(tid >> 6), lane = tid & 63, wr = wid >> 2, wc = wid & 3, fr = lane & 15, fq = lane >> 4;
    unsigned voffB[2];
#pragma unroll
    for (int i = 0; i < 2; ++i) { int R, C; stage_rc(tid * 16 + i * 8192, R, C); const int Rb = (R & ~31) + perm32(R & 31); voffB[i] = (unsigned)(Rb * ldb + C) * 2u; }
    const size_t kstep = (size_t)(BK * 2);
    const unsigned ldsw = (unsigned)wid * 1024u;
    const int swz = lds_byte(fr, fq * 8); const int aS = wr * 8192, bS = wc * 4096;
    const unsigned pko = (unsigned)tid * 32u;
#define G8_PSLOT(sl) ((LAS u32x4*)(lds + STAGE_BYTES + pko) + (sl))
#define G8_AOFF(dst, sl, half) unsigned dst[2]; { const u32x2 _q = *((const LAS u32x2*)G8_PSLOT(sl) + (half)); dst[0] = _q[0]; dst[1] = _q[1]; }
#define G8_SA(b, h) (((b) * 2 + (h)) * HTB)
#define G8_SB(b, h) ((4 + (b) * 2 + (h)) * HTB)
#define G8_STAGE(bufoff, gbase, voff) do { _Pragma("unroll") for (int _i = 0; _i < 2; ++_i) { unsigned _o = (voff)[_i]; asm volatile("" : "+v"(_o));   \
        __builtin_amdgcn_global_load_lds((const unsigned*)((const char*)(gbase) + _o), (LAS unsigned*)(lds + (bufoff) + ldsw + _i * 8192), 16, 0, 0); } } while (0)
#define G8_LDA(dst, b, h) do { _Pragma("unroll") for (int m = 0; m < 4; ++m) _Pragma("unroll") for (int k = 0; k < 2; ++k) dst[m][k] = *(const LAS bf16x8*)(lds + (G8_SA(b, h) + aS) + swz + m * 2048 + k * 1024); } while (0)
#define G8_LDB(dst, b, h) do { _Pragma("unroll") for (int n = 0; n < 2; ++n) _Pragma("unroll") for (int k = 0; k < 2; ++k) dst[n][k] = *(const LAS bf16x8*)(lds + (G8_SB(b, h) + bS) + swz + n * 2048 + k * 1024); } while (0)
#define G8_MMA(ai, bj, At, Bt) do { __builtin_amdgcn_s_setprio(1); _Pragma("unroll") for (int m = 0; m < 4; ++m) _Pragma("unroll") for (int n = 0; n < 2; ++n) { \
        if constexpr (Sched::F8) acc[ai][bj][m][n] = __builtin_amdgcn_mfma_scale_f32_16x16x128_f8f6f4(cat8(Bt[n][0], Bt[n][1]), cat8(At[m][0], At[m][1]), acc[ai][bj][m][n], 0, 0, 0, 0, 0, 0); \
        else { _Pragma("unroll") for (int k = 0; k < 2; ++k) acc[ai][bj][m][n] = __builtin_amdgcn_mfma_f32_16x16x32_bf16(Bt[n][k], At[m][k], acc[ai][bj][m][n], 0, 0, 0); } } __builtin_amdgcn_s_setprio(0); } while (0)
#define G8_WAIT_V(n) asm volatile("s_waitcnt vmcnt(" #n ")" ::: "memory")
#define G8_WAIT_L(n) asm volatile("s_waitcnt lgkmcnt(" #n ")" ::: "memory")
#define G8_BAR __builtin_amdgcn_s_barrier()
#define G8_SCHED __builtin_amdgcn_sched_barrier(0)
    Unit cur, nxt; int ui = 0;
    if (!S.next(0, cur)) return;
    f32x4 acc[2][2][4][2];
#pragma unroll
    for (int a = 0; a < 2; ++a)
#pragma unroll
        for (int b = 0; b < 2; ++b)
#pragma unroll
            for (int m = 0; m < 4; ++m)
#pragma unroll
                for (int n = 0; n < 2; ++n) acc[a][b][m][n] = (f32x4){0.f, 0.f, 0.f, 0.f};
    bf16x8 At[4][2], B0[2][2], B1[2][2];
    unsigned va0[2], va1x[2];
    S.a_off(cur, va0, va1x);
    unsigned (&va1)[2] = Sched::GATHER ? va1x : va0;
    if constexpr (Sched::GATHER) *G8_PSLOT(0) = (u32x4){va0[0], va0[1], va1x[0], va1x[1]};
    const char* cA0 = uni(cur.a); const char* cA1 = uni(cur.a + S.a_half());
    const char* cB0 = uni(cur.b0); const char* cB1 = uni(cur.b1);
    G8_STAGE(G8_SB(0, 0), cB0, voffB); G8_STAGE(G8_SB(0, 1), cB1, voffB); G8_STAGE(G8_SA(0, 0), cA0, va0); G8_STAGE(G8_SA(0, 1), cA1, va1);
    if (wr == 1) G8_BAR;
    G8_WAIT_V(2); G8_BAR;
    G8_STAGE(G8_SB(1, 0), uni(cB0 + kstep), voffB); G8_STAGE(G8_SA(1, 0), uni(cA0 + kstep), va0); G8_STAGE(G8_SB(1, 1), uni(cB1 + kstep), voffB);
    G8_WAIT_V(6); G8_BAR;
    for (;;) {
        const bool has_next = S.next(ui + 1, nxt);
        if constexpr (Sched::GATHER) {
            if (!has_next) nxt = cur;
            unsigned n0[2], n1[2];
            S.a_off(nxt, n0, n1);
            *G8_PSLOT((ui + 1) & 1) = (u32x4){n0[0], n0[1], n1[0], n1[1]};
        }
        const char* nA0 = has_next ? nxt.a : cA0 - 0; const char* nB0 = has_next ? nxt.b0 : cB0; const char* nB1 = has_next ? nxt.b1 : cB1;
        if (!has_next) nA0 = cur.a;
        const char* nA1 = nA0 + S.a_half();
        for (int t = 0; t < nt; t += 2) {
            const bool last = (t == nt - 2);
            if constexpr (Epi::MID_T > 0) { if (t == Epi::MID_T) E.mid(acc, cur, wr, fr); }
            const char* a11 = uni(cA1 + (size_t)(t + 1) * kstep);
            const char* a20 = uni(last ? nA0 : cA0 + (size_t)(t + 2) * kstep); const char* a21 = uni(last ? nA1 : cA1 + (size_t)(t + 2) * kstep);
            const char* b20 = uni(last ? nB0 : cB0 + (size_t)(t + 2) * kstep); const char* b21 = uni(last ? nB1 : cB1 + (size_t)(t + 2) * kstep);
            const char* a30 = uni(a20 + kstep); const char* b30 = uni(b20 + kstep); const char* b31 = uni(b21 + kstep);
            const int slc = ui & 1, sln = last ? (slc ^ 1) : slc;
#define G8_STAGE_A(bufoff, gbase, sl, half) do { if constexpr (Sched::GATHER) { G8_AOFF(_ao, sl, half); G8_STAGE(bufoff, gbase, _ao); } else { G8_STAGE(bufoff, gbase, va0); } } while (0)
            G8_LDB(B0, 0, 0); G8_LDB(B1, 0, 1); G8_SCHED; G8_LDA(At, 0, 0); G8_STAGE_A(G8_SA(1, 1), a11, slc, 1);
            G8_WAIT_V(8); G8_WAIT_L(0); G8_BAR; G8_MMA(0, 0, At, B0); G8_MMA(0, 1, At, B1); G8_BAR; G8_SCHED;
            G8_LDA(At, 0, 1); G8_STAGE(G8_SB(0, 0), b20, voffB); G8_STAGE(G8_SB(0, 1), b21, voffB); G8_STAGE_A(G8_SA(0, 0), a20, sln, 0);
            G8_WAIT_V(8); G8_WAIT_L(0); G8_BAR; G8_MMA(1, 0, At, B0); G8_MMA(1, 1, At, B1); G8_BAR; G8_SCHED;
            G8_LDB(B0, 1, 0); G8_LDB(B1, 1, 1); G8_SCHED; G8_LDA(At, 1, 0); G8_STAGE_A(G8_SA(0, 1), a21, sln, 1);
            G8_WAIT_V(8); G8_WAIT_L(0); G8_BAR; G8_MMA(0, 0, At, B0); G8_MMA(0, 1, At, B1); G8_BAR; G8_SCHED;
            G8_LDA(At, 1, 1); G8_STAGE(G8_SB(1, 0), b30, voffB); G8_STAGE(G8_SB(1, 1), b31, voffB); G8_STAGE_A(G8_SA(1, 0), a30, sln, 0);
            G8_WAIT_V(8); G8_WAIT_L(0); G8_BAR; G8_MMA(1, 0, At, B0); G8_MMA(1, 1, At, B1); G8_BAR; G8_SCHED;
#undef G8_STAGE_A
        }
        if (wr == 0) G8_BAR;
        { const int l2 = hw_lane(); E(acc, cur, wr, wc, l2 & 15, l2 >> 4); }
        if (!has_next) break;
#pragma unroll
        for (int a = 0; a < 2; ++a)
#pragma unroll
            for (int b = 0; b < 2; ++b)
#pragma unroll
                for (int m = 0; m < 4; ++m)
#pragma unroll
                    for (int n = 0; n < 2; ++n) acc[a][b][m][n] = (f32x4){0.f, 0.f, 0.f, 0.f};
        cur = nxt; cA0 = nA0; cA1 = nA1; cB0 = nB0; cB1 = nB1; ++ui;
        if (wr == 1) G8_BAR;
    }
    G8_WAIT_V(0);
    G8_BAR;
#undef G8_PSLOT
#undef G8_AOFF
#undef G8_SA
#undef G8_SB
#undef G8_STAGE
#undef G8_LDA
#undef G8_LDB
#undef G8_MMA
#undef G8_WAIT_V
#undef G8_WAIT_L
#undef G8_BAR
#undef G8_SCHED
}
DEV int deal(int i, int G, int c, int nwg) {
    const long L = (long)i * G + c; if (L >= nwg) return -1;
    const int w = (int)L, q = nwg / 8, r = nwg % 8, xcd = w % 8, off = w / 8;
    return (xcd < r ? xcd * (q + 1) : r * (q + 1) + (xcd - r) * q) + off;
}
struct EpiStore {
    static constexpr int MID_T = 0;
    bf16_t* O; int ld;
    DEV void operator()(const f32x4 (&acc)[2][2][4][2], const Unit& u, int wr, int wc, int fr, int fq) const {
#pragma unroll
        for (int ai = 0; ai < 2; ++ai)
#pragma unroll
            for (int m = 0; m < 4; ++m) {
                const int r = ai * HALF + wr * 64 + m * 16 + fr;
                if (r < u.nvalid) {
                    bf16_t* rowp = O + (size_t)(u.row0 + r) * ld + u.col0 + wc * 32 + 8 * fq;
#pragma unroll
                    for (int bj = 0; bj < 2; ++bj) {
                        const f32x4 v0 = acc[ai][bj][m][0], v1 = acc[ai][bj][m][1];
                        *(u32x4*)(rowp + bj * HALF) = (u32x4){pk2(v0[0], v0[1]), pk2(v0[2], v0[3]), pk2(v1[0], v1[1]), pk2(v1[2], v1[3])};
                    }
                }
            }
    }
};
struct EpiStore8 {
    static constexpr int MID_T = 0;
    unsigned char* O; int ld; float sc;
    DEV void operator()(const f32x4 (&acc)[2][2][4][2], const Unit& u, int wr, int wc, int fr, int fq) const {
#pragma unroll
        for (int ai = 0; ai < 2; ++ai)
#pragma unroll
            for (int m = 0; m < 4; ++m) {
                const int r = ai * HALF + wr * 64 + m * 16 + fr;
                if (r < u.nvalid) {
                    unsigned char* rowp = O + (size_t)(u.row0 + r) * ld + u.col0 + wc * 32 + 8 * fq;
#pragma unroll
                    for (int bj = 0; bj < 2; ++bj) {
                        const f32x4 v0 = acc[ai][bj][m][0] * sc, v1 = acc[ai][bj][m][1] * sc;
                        int w0 = 0, w1 = 0;
                        w0 = __builtin_amdgcn_cvt_pk_fp8_f32(v0[0], v0[1], w0, false); w0 = __builtin_amdgcn_cvt_pk_fp8_f32(v0[2], v0[3], w0, true);
                        w1 = __builtin_amdgcn_cvt_pk_fp8_f32(v1[0], v1[1], w1, false); w1 = __builtin_amdgcn_cvt_pk_fp8_f32(v1[2], v1[3], w1, true);
                        *(uint2*)(rowp + bj * HALF) = make_uint2((unsigned)w0, (unsigned)w1);
                    }
                }
            }
    }
};
struct SchedDense {
    static constexpr bool GATHER = false, F8 = false;
    const bf16_t* A; const bf16_t* Bt; int lda, ldb, nM, nN, G, c;
    DEV bool next(int i, Unit& u) const {
        const int w = deal(i, G, c, nM * nN); if (w < 0) return false;
        const int nig = 8 * nN, gid = w / nig, fm = gid * 8, gsz = (nM - fm) < 8 ? (nM - fm) : 8;
        const int pm = fm + ((w % nig) % gsz), pn = (w % nig) / gsz;
        u.a = (const char*)(A + (size_t)pm * BM * lda); u.b0 = (const char*)(Bt + (size_t)pn * BM * ldb); u.b1 = u.b0 + (size_t)HALF * ldb * 2;
        u.aux = nullptr; u.row0 = pm * BM; u.col0 = pn * BM; u.nvalid = BM; u.sub = 0; return true;
    }
    DEV size_t a_half() const { return (size_t)HALF * lda * 2; }
    DEV void a_off(const Unit&, unsigned (&v0)[2], unsigned (&v1)[2]) const {
        const int tz = tid512();
#pragma unroll
        for (int i = 0; i < 2; ++i) { int R, C; stage_rc(tz * 16 + i * 8192, R, C); v0[i] = (unsigned)(R * lda + C) * 2u; v1[i] = v0[i]; }
    }
};
}

DEV uint4 as_uint4(const u32x4 q) { return make_uint4(q[0], q[1], q[2], q[3]); }
struct LdRows {
    const bf16_t* base; size_t ld; int cs;
    DEV RawV raw(int, int r, int kcg) const { RawV x; x.q0 = *(const u32x4*)(base + (size_t)r * ld + kcg * cs); return x; }
    DEV uint4 fin(const RawV& x, int, int, int) const { return as_uint4(x.q0); }
};
struct EpStoreBf16 {
    bf16_t* O;
    DEV void pre(int) {}
    DEV void operator()(const float* ct, int tid) const {
#pragma unroll
        for (int i = 0; i < 8; ++i) {
            const int id = tid + 256 * i, c8 = id >> 7, r = id & 127;
            float v[8]; ld8f(ct, r * 132 + c8 * 8, v);
            *(uint4*)(O + (size_t)(r >> 6) * 8192 + c8 * 512 + (r & 63) * 8) = pack8(v);
        }
    }
};

struct Strip { const float* src; unsigned char* dst; const float* rscale; int ld_src, ld_dst; float f8; };
DEV void strip_of(const P& p, int layer, int it, Strip& st) {
    bf16_t* WIN = (bf16_t*)(wsp(p) + WS_WIN); bf16_t* WOUT = (bf16_t*)(wsp(p) + WS_WOUT);
    bf16_t* WG = (bf16_t*)(wsp(p) + WS_WG); bf16_t* WU = (bf16_t*)(wsp(p) + WS_WU); bf16_t* WD = (bf16_t*)(wsp(p) + WS_WD);
    constexpr int T0 = 144, T1 = T0 + 64, T2 = T1 + 1024, T3 = T2 + 1024, T4 = T3 + 1024, T5 = T4 + 16, T6 = T5 + 16;
    const float* src; bf16_t* dst; int ls, ld, r0, c0, rd0 = -1; st.rscale = nullptr;
    const bool f8 = it >= T1;
    unsigned char* WG8 = (unsigned char*)WG; unsigned char* WU8 = (unsigned char*)WU; unsigned char* WD8 = (unsigned char*)WD; unsigned char* dst8 = nullptr;
    if (it < T0) { r0 = (it / 9) * 64; c0 = (it % 9) * 256; src = p.w_in + (size_t)layer * DM * NINF; ls = NINF; dst = WIN; ld = DM; }
    else if (it < T1) { const int ti = it - T0, rt = ti >> 2; r0 = rt * 64; c0 = (ti & 3) * 256; src = p.w_out + (size_t)layer * DM * DM; ls = DM; dst = WOUT; ld = DM;
        rd0 = (r0 + 512) & 1023; if (rt >= 8) st.rscale = p.ssd_norm + layer * 512 + (rt - 8) * 64; }
    else if (it < T2) { const int ti = it - T1, e = ti >> 4; r0 = (ti & 15) * 64; c0 = 0; src = p.w_gate + ((size_t)layer * 64 + e) * DM * FE; ls = FE; dst = nullptr; dst8 = WG8 + (size_t)e * FE * DM; ld = DM; }
    else if (it < T3) { const int ti = it - T2, e = ti >> 4; r0 = (ti & 15) * 64; c0 = 0; src = p.w_up + ((size_t)layer * 64 + e) * DM * FE; ls = FE; dst = nullptr; dst8 = WU8 + (size_t)e * FE * DM; ld = DM; }
    else if (it < T4) { const int ti = it - T3, e = ti >> 4; r0 = ((ti >> 2) & 3) * 64; c0 = (ti & 3) * 256; src = p.w_down + ((size_t)layer * 64 + e) * FE * DM; ls = DM; dst = nullptr; dst8 = WD8 + (size_t)e * DM * FE; ld = FE; }
    else if (it < T5) { r0 = (it - T4) * 64; c0 = 0; src = p.ws_gate + (size_t)layer * DM * FE; ls = FE; dst = nullptr; dst8 = WG8 + (size_t)64 * FE * DM; ld = DM; }
    else if (it < T6) { r0 = (it - T5) * 64; c0 = 0; src = p.ws_up + (size_t)layer * DM * FE; ls = FE; dst = nullptr; dst8 = WU8 + (size_t)64 * FE * DM; ld = DM; }
    else { const int ti = it - T6; r0 = (ti >> 2) * 64; c0 = (ti & 3) * 256; src = p.ws_down + (size_t)layer * FE * DM; ls = DM; dst = nullptr; dst8 = WD8 + (size_t)64 * DM * FE; ld = FE; }
    if (rd0 < 0) rd0 = r0;
    st.src = src + (size_t)r0 * ls + c0; st.dst = f8 ? dst8 + (size_t)c0 * ld + rd0 : (unsigned char*)(dst + (size_t)c0 * ld + rd0); st.ld_src = ls; st.ld_dst = ld; st.f8 = !f8 ? 0.f : (ld == FE ? WD8_SCALE : W8_SCALE);
}
DEV const char* uni_ptr(const void* p) { const unsigned long long v = (unsigned long long)p; const unsigned lo = __builtin_amdgcn_readfirstlane((unsigned)v), hi = __builtin_amdgcn_readfirstlane((unsigned)(v >> 32)); return (const char*)(GAS const char*)(((unsigned long long)hi << 32) | lo); }
DEV void strip_load(const Strip& st, int tid, float4 (&v)[16]) {
    const char* sb = uni_ptr(st.src);
    unsigned off = (unsigned)((tid >> 6) * st.ld_src + (tid & 63) * 4) * 4u; const unsigned step = (unsigned)st.ld_src * 16u;
#pragma unroll
    for (int i = 0; i < 16; ++i) { const f32x4v q = __builtin_nontemporal_load((const f32x4v*)(sb + off)); v[i] = make_float4(q[0], q[1], q[2], q[3]); off += step; }
}
DEV void strip_park(float* t, int tid, const float4 (&v)[16]) {
    const int lane = tid & 63, rot = (lane >> 3) & 3;
    float* base = t + (tid >> 6) * 257 + 4 * lane;
    const int o0 = rot, o1 = (rot + 1) & 3, o2 = (rot + 2) & 3, o3 = (rot + 3) & 3;
#pragma unroll
    for (int i = 0; i < 16; ++i) {
        float a = v[i].x, b = v[i].y, c = v[i].z, d = v[i].w;
        if (rot & 1) { const float t0 = a; a = b; b = c; c = d; d = t0; }
        if (rot & 2) { const float t0 = a, t1 = b; a = c; b = d; c = t0; d = t1; }
        float* q = base + i * 4 * 257;
        q[o0] = a; q[o1] = b; q[o2] = c; q[o3] = d;
    }
}
DEV void strip_emit(const float* t, int tid, const Strip& cur) {
#pragma unroll
    for (int i = 0; i < 8; ++i) {
        const int idx = tid + 256 * i, c = idx >> 3, r8 = (idx & 7) * 8;
        float o[8];
#pragma unroll
        for (int e = 0; e < 8; ++e) o[e] = t[(r8 + e) * 257 + c] * (cur.rscale ? cur.rscale[r8 + e] : 1.f);
        if (cur.f8 != 0.f) { const float sc = cur.f8; *(uint2*)(cur.dst + (size_t)c * cur.ld_dst + r8) = make_uint2(pk4_f8(o[0] * sc, o[1] * sc, o[2] * sc, o[3] * sc), pk4_f8(o[4] * sc, o[5] * sc, o[6] * sc, o[7] * sc)); }
        else *(uint4*)((bf16_t*)cur.dst + (size_t)c * cur.ld_dst + r8) = pack8(o);
    }
}
DEV int strip_index(int part, int i) {
    if (part == 0) return i < 208 ? i : (i < 208 + 1024 ? 2256 + (i - 208) : 3312 + (i - 1232));
    return i < 2048 ? 208 + i : 3280 + (i - 2048);
}
DEV void strips_loop(const P& p, int layer, unsigned char* lds, int id0, int n, int stride, int part) {
    float* t = (float*)lds;
    const int tid = tidx();
    Strip cur, nxt; float4 v[16];
    if (n > 0) { strip_of(p, layer, part < 0 ? id0 : strip_index(part, id0), cur); strip_load(cur, tid, v); }
    for (int k = 0; k < n; ++k) {
        __syncthreads();
        strip_park(t, tid, v);
        const bool more = k + 1 < n;
        if (more) { const int id = id0 + (k + 1) * stride; strip_of(p, layer, part < 0 ? id : strip_index(part, id), nxt); strip_load(nxt, tid, v); }
        __syncthreads();
        strip_emit(t, tid, cur);
        if (more) cur = nxt;
    }
}
constexpr int CW_QH = 8192, NQ_PAIRS = (3328 - 208) / 2;
DEV void fill_strips(const P& p, unsigned char* lds, int budget) {
    volatile LAS int* bc = (volatile LAS int*)(smem_all + LDS_QB);
    unsigned* qh = (unsigned*)(wsp(p) + WS_CTL) + CW_QH;
    const int want = budget < 0 ? 2 : budget;
    for (;;) {
        __syncthreads();
        if (tid512() == 0) *bc = (int)__hip_atomic_fetch_add(qh, (unsigned)want, __ATOMIC_RELAXED, __HIP_MEMORY_SCOPE_AGENT);
        __syncthreads();
        const int q0 = __builtin_amdgcn_readfirstlane(*bc);
        if (q0 >= NQ_PAIRS) break;
        const int n = min(want, NQ_PAIRS - q0);
        strips_loop(p, 0, lds, 208 + 2 * q0 + vhalf(), n, 2, -1);
        if (budget >= 0) break;
    }
}
DEV void phase_p0(const P& p, int layer, unsigned char* lds, int part, bool extras) {
    constexpr int T7 = 3328;
    const int nstrip = part == 0 ? 1248 : (part == 1 ? 2080 : 208);
    const int nextra = extras ? (192 + 256 + 128 + 32) : 0;
    { const int v0 = vbid(); const int n = v0 < nstrip ? (nstrip - v0 + vgrid() - 1) / vgrid() : 0; strips_loop(p, layer, lds, v0, n, vgrid(), part == 2 ? 0 : part); }
    for (int it = T7 + (vbid() + vgrid() - (nstrip % vgrid())) % vgrid(); it < T7 + nextra; it += vgrid()) {
        if (false) {}
        else if (it < T7 + 192) {
            const int mi = it - T7, l = mi / 96, cg = mi % 96, tid = tidx(), lane = tid & 63, wid = tid >> 6;
            float* sc = (float*)lds;
            float* part = sc + 9 * 1024;
            __syncthreads();
            for (int i = tid; i < 9 * 1024; i += 256) { const float v = (i < 8192) ? p.c[i] : p.c_ctx[i - 8192]; sc[i] = silu_f(v); }
            __syncthreads();
            float a9[9];
#pragma unroll
            for (int r = 0; r < 9; ++r) a9[r] = 0.f;
            const float* wm = p.w_mod + (size_t)l * DM * 6144 + cg * 64 + lane;
#pragma unroll 1
            for (int k0 = wid * 256; k0 < wid * 256 + 256; k0 += 16) {
                float w[16];
#pragma unroll
                for (int j = 0; j < 16; ++j) w[j] = wm[(size_t)(k0 + j) * 6144];
#pragma unroll
                for (int j = 0; j < 16; ++j)
#pragma unroll
                    for (int r = 0; r < 9; ++r) a9[r] += sc[r * 1024 + k0 + j] * w[j];
            }
#pragma unroll
            for (int r = 0; r < 9; ++r) part[(wid * 9 + r) * 64 + lane] = a9[r];
            __syncthreads();
            float* MOD = (float*)(wsp(p) + WS_MOD);
            for (int i = tid; i < 9 * 64; i += 256) {
                const int r = i >> 6, j = i & 63;
                const float s = ((part[(0 * 9 + r) * 64 + j] + part[(1 * 9 + r) * 64 + j]) + part[(2 * 9 + r) * 64 + j]) + part[(3 * 9 + r) * 64 + j];
                const float v = s + p.b_mod[l * 6144 + cg * 64 + j];
                const int T = cg >> 4, c = (cg & 15) * 64 + j;
                float o = v;
                if (T == 1) o = p.g_pre_mix[l * DM + c] * (1.f + v);
                if (T == 2) o = v * p.g_post_mix[l * DM + c];
                if (T == 4) o = p.g_pre_ffn[l * DM + c] * (1.f + v);
                if (T == 5) o = v * p.g_post_ffn[l * DM + c];
                MOD[((size_t)l * 9 + r) * 6144 + cg * 64 + j] = o;
            }
        } else if (it >= T7 + 192 + 256) {
            const int idx = (it - T7 - 192 - 256) * 256 + tidx();
            if (idx < 32768) {
                const int l = idx >> 14, wid = (idx >> 12) & 3, q = (idx >> 6) & 63, lane = idx & 63;
                const float* src = p.router_w + (size_t)l * DM * NEXP + (size_t)(16 * q + 4 * (lane >> 4)) * NEXP + 16 * wid + (lane & 15);
                ((float4*)(wsp(p) + WS_RW2))[idx] = make_float4(src[0], src[NEXP], src[2 * NEXP], src[3 * NEXP]);
            } else {
                const int id2 = idx - 32768, l = id2 >> 12, wid = (id2 >> 10) & 3, q = (id2 >> 6) & 15, lane = id2 & 63;
                const float* src = p.w_in + (size_t)l * DM * NINF + (size_t)(256 * wid + 16 * q + 4 * (lane >> 4)) * NINF + NIN + (lane & 15);
                ((float4*)(wsp(p) + WS_WD2))[id2] = make_float4(src[0], src[NINF], src[2 * NINF], src[3 * NINF]);
            }
        } else {
            const int idx = (it - T7 - 192) * 256 + tidx(), pos = idx >> 5, i = idx & 31, f = i & 15;
            const float inv = powf(10000.f, -(float)f / 16.f);
            const float ang = (float)((i < 16) ? (pos >> 6) : (pos & 63)) * inv;
            float2* ROPE = (float2*)(wsp(p) + WS_ROPE);
            ROPE[idx] = make_float2(cosf(ang), sinf(ang));
        }
    }
}

DEV void ld_row16(const float* row, int lane, float* v) {
#pragma unroll
    for (int i = 0; i < 4; ++i) { const float4 q = *(const float4*)(row + 4 * lane + 256 * i); v[4 * i] = q.x; v[4 * i + 1] = q.y; v[4 * i + 2] = q.z; v[4 * i + 3] = q.w; }
}
DEV void st_row16(float* row, int lane, const float* v) {
#pragma unroll
    for (int i = 0; i < 4; ++i) *(float4*)(row + 4 * lane + 256 * i) = make_float4(v[4 * i], v[4 * i + 1], v[4 * i + 2], v[4 * i + 3]);
}
DEV void ld_row16_bf(const bf16_t* row, int lane, float* v) {
#pragma unroll
    for (int i = 0; i < 4; ++i) { const uint2 q = *(const uint2*)(row + 4 * lane + 256 * i); v[4 * i] = bflo(q.x); v[4 * i + 1] = bfhi(q.x); v[4 * i + 2] = bflo(q.y); v[4 * i + 3] = bfhi(q.y); }
}
DEV void st_row16_bf(bf16_t* row, int lane, const float* v) {
#pragma unroll
    for (int i = 0; i < 4; ++i) *(uint2*)(row + 4 * lane + 256 * i) = make_uint2(pk2(v[4 * i], v[4 * i + 1]), pk2(v[4 * i + 2], v[4 * i + 3]));
}
DEV float rstd16(const float* v) {
    float s = 0.f;
#pragma unroll
    for (int e = 0; e < 16; ++e) s += v[e] * v[e];
    s = wave_sum(s);
    return rsqrtf(s * (1.f / 1024.f) + EPS);
}
constexpr int HLS = 1028;
constexpr int HL_BYTES = 16 * HLS * 4;
DEV f32x4v mfma4(const float4 a, const float4 b, f32x4v acc) {
    acc = __builtin_amdgcn_mfma_f32_16x16x4f32(a.x, b.x, acc, 0, 0, 0); acc = __builtin_amdgcn_mfma_f32_16x16x4f32(a.y, b.y, acc, 0, 0, 0);
    acc = __builtin_amdgcn_mfma_f32_16x16x4f32(a.z, b.z, acc, 0, 0, 0); acc = __builtin_amdgcn_mfma_f32_16x16x4f32(a.w, b.w, acc, 0, 0, 0);
    return acc;
}
template <int RPW> DEV void dt_tail16(const float* hl, const float4* wd2  , const float* bias, float* part, float* DT, int tok0, int tid) {
    const int lane = tid & 63, wid = tid >> 6, ar = lane & 15, kq = lane >> 4;
    f32x4v acc = {0.f, 0.f, 0.f, 0.f};
    const float* ap = hl + ar * HLS + wid * 256 + 4 * kq;
    const float4* bp = wd2 + (size_t)wid * 16 * 64 + lane;
#pragma unroll 8
    for (int q = 0; q < 16; ++q) acc = mfma4(*(const float4*)(ap + 16 * q), bp[q * 64], acc);
#pragma unroll
    for (int e = 0; e < 4; ++e) part[(wid * 16 + kq * 4 + e) * 16 + ar] = acc[e];
    __syncthreads();
    const int r = tid >> 4, j = tid & 15;
    const float v = ((part[(0 * 16 + r) * 16 + j] + part[(1 * 16 + r) * 16 + j]) + part[(2 * 16 + r) * 16 + j]) + part[(3 * 16 + r) * 16 + j];
    if (r < 4 * RPW) DT[(size_t)(tok0 + r) * 16 + j] = softplus_f(v + bias[j]);
}
template <int RPW> DEV void phase_pa0(const P& p, unsigned char* lds, int row0, int nrows) {
    const int tid = tidx(), lane = tid & 63, wid = tid >> 6;
    const float* MOD = (const float*)(wsp(p) + WS_MOD);
    bf16_t* H = (bf16_t*)(wsp(p) + WS_H); float* DT = (float*)(wsp(p) + WS_DT);
    float* hl = (float*)lds; float* part = (float*)(lds + HL_BYTES);
    for (int task = vbid(); task < nrows / (4 * RPW); task += vgrid()) {
        const int tok0 = row0 + task * (4 * RPW) + wid * RPW;
        const float* xb = tok0 < TL ? p.x + (size_t)tok0 * DM : p.ctx + (size_t)(tok0 - TL) * DM;
        const float* md = MOD + (size_t)(tok0 < TL ? tok0 / SEQ : 8) * 6144;
        float x[RPW][16], pb[16], pc[16];
#pragma unroll
        for (int rr = 0; rr < RPW; ++rr) ld_row16(xb + (size_t)rr * DM, lane, x[rr]);
        ld_row16(md + 1024, lane, pb); ld_row16(md + 0, lane, pc);
        __syncthreads();
#pragma unroll
        for (int rr = 0; rr < RPW; ++rr) {
            const float rs = rstd16(x[rr]);
            float h[16];
#pragma unroll
            for (int e = 0; e < 16; ++e) h[e] = x[rr][e] * rs * pb[e] + pc[e];
            st_row16_bf(H + (size_t)(tok0 + rr) * DM, lane, h);
            st_row16(hl + (wid * RPW + rr) * HLS, lane, h);
        }
        __syncthreads();
        dt_tail16<RPW>(hl, (const float4*)(wsp(p) + WS_WD2), p.dt_bias, part, DT, row0 + task * (4 * RPW), tid);
    }
}
template <int RPW> DEV void phase_pi(const P& p, int layer, unsigned char* lds, int row0, int nrows) {
    const int tid = tidx(), lane = tid & 63, wid = tid >> 6;
    const float* MOD = (const float*)(wsp(p) + WS_MOD);
    const bf16_t* ML = (const bf16_t*)(wsp(p) + WS_ML);
    bf16_t* XB = (bf16_t*)(wsp(p) + WS_XB);
    bf16_t* H = (bf16_t*)(wsp(p) + WS_H);
    unsigned* TOPK = (unsigned*)(wsp(p) + WS_TOPK);
    uint2* LIST = (uint2*)(wsp(p) + WS_LIST);
    unsigned* cnt = (unsigned*)(wsp(p) + WS_CTL) + CW_CNT + layer * CNT_LAYER;
    float* hl = (float*)lds; float* lgl = (float*)(lds + HL_BYTES);
    unsigned* lcnt = (unsigned*)(lds + HL_BYTES + 4096); unsigned* lbase = lcnt + 64;
    if (tid < 64) lcnt[tid] = 0u;
    const float4* rw2 = (const float4*)(wsp(p) + WS_RW2) + (size_t)layer * 16384 + (size_t)wid * 4096 + lane;
    const float rbias = p.router_bias[layer * NEXP + lane];
    for (int task = vbid(); task < nrows / (4 * RPW); task += vgrid()) {
        const int tok0 = row0 + task * (4 * RPW) + wid * RPW;
        const float* xin = tok0 < TL ? p.x + (size_t)tok0 * DM : p.ctx + (size_t)(tok0 - TL) * DM;
        bf16_t* xout = XB + (size_t)tok0 * DM;
        const float* md = MOD + ((size_t)layer * 9 + (tok0 < TL ? tok0 / SEQ : 8)) * 6144;
        float pa[16], pb[16], pc[16];
        ld_row16(md + 2048, lane, pa); ld_row16(md + 4096, lane, pb); ld_row16(md + 3072, lane, pc);
        __syncthreads();
#pragma unroll 1
        for (int hp = 0; hp < 2; ++hp) {
            float x[2][16]; uint2 yp[2][4];
#pragma unroll
            for (int r2 = 0; r2 < 2; ++r2) {
                const int rr = hp * 2 + r2;
                if (rr < RPW) {
                    if (layer == 0) ld_row16(xin + (size_t)rr * DM, lane, x[r2]); else ld_row16_bf(xout + (size_t)rr * DM, lane, x[r2]);
#pragma unroll
                    for (int i = 0; i < 4; ++i) yp[r2][i] = *(const uint2*)(ML + (size_t)(tok0 + rr) * DM + 4 * lane + 256 * i);
                }
            }
#pragma unroll
            for (int r2 = 0; r2 < 2; ++r2) {
                const int rr = hp * 2 + r2;
                if (rr >= RPW) continue;
                float y[16];
#pragma unroll
                for (int i = 0; i < 4; ++i) { y[4 * i] = bflo(yp[r2][i].x); y[4 * i + 1] = bfhi(yp[r2][i].x); y[4 * i + 2] = bflo(yp[r2][i].y); y[4 * i + 3] = bfhi(yp[r2][i].y); }
                const float rsy = rstd16(y);
#pragma unroll
                for (int e = 0; e < 16; ++e) x[r2][e] += pa[e] * (y[e] * rsy);
                st_row16_bf(xout + (size_t)rr * DM, lane, x[r2]);
                const float rs = rstd16(x[r2]);
                float h[16];
#pragma unroll
                for (int e = 0; e < 16; ++e) h[e] = x[r2][e] * rs * pb[e] + pc[e];
                {
                    unsigned char* h8 = (unsigned char*)H + (size_t)(tok0 + rr) * DM + 4 * lane;
#pragma unroll
                    for (int i = 0; i < 4; ++i) *(unsigned*)(h8 + 256 * i) = pk4_f8(h[4 * i] * H8_SCALE, h[4 * i + 1] * H8_SCALE, h[4 * i + 2] * H8_SCALE, h[4 * i + 3] * H8_SCALE);
                }
                st_row16(hl + (wid * RPW + rr) * HLS, lane, h);
            }
        }
        __syncthreads();
        {
            const int ar = lane & 15, kq = lane >> 4;
            f32x4v acc = {0.f, 0.f, 0.f, 0.f};
            const float* ap = hl + ar * HLS + 4 * kq;
#pragma unroll 8
            for (int q = 0; q < 64; ++q) acc = mfma4(*(const float4*)(ap + 16 * q), rw2[q * 64], acc);
#pragma unroll
            for (int e = 0; e < 4; ++e) lgl[(kq * 4 + e) * 64 + wid * 16 + ar] = acc[e];
        }
        __syncthreads();
        unsigned selm = 0; float gatev[RPW]; int posv[RPW]; unsigned lrk[RPW];
#pragma unroll
        for (int rr = 0; rr < RPW; ++rr) {
            const float score = sigmoid_f(lgl[(wid * RPW + rr) * 64 + lane]), choice = score + rbias;
            int grank = 0;
#pragma unroll
            for (int t = 0; t < 8; ++t) { const int j = (lane & ~7) + t; const float v = __shfl(choice, j); grank += (v > choice || (v == choice && j < lane)) ? 1 : 0; }
            float gs = grank < 2 ? choice : 0.f;
            gs += __shfl_xor(gs, 1); gs += __shfl_xor(gs, 2); gs += __shfl_xor(gs, 4);
            int gr = 0;
#pragma unroll
            for (int t = 0; t < 8; ++t) { const float v = __shfl(gs, t * 8); gr += (v > gs || (v == gs && t < (lane >> 3))) ? 1 : 0; }
            const bool ok = gr < 4;
            const float m = ok ? choice : -INFINITY;
            int rank = 0;
            for (int j = 0; j < 64; ++j) { const float v = __shfl(m, j); rank += (v > m || (v == m && j < lane)) ? 1 : 0; }
            const bool sel = ok && rank < 8;
            const float wsum = wave_sum(sel ? score : 0.f);
            const unsigned long long bal = __ballot(sel);
            gatev[rr] = score / wsum * 2.5f;
            posv[rr] = __popcll(bal & ((1ull << lane) - 1ull));
            lrk[rr] = 0;
            if (sel) { selm |= 1u << rr; lrk[rr] = atomicAdd(&lcnt[lane], 1u); }
        }
        __syncthreads();
        if (tid < 64) { const unsigned c = lcnt[tid]; lbase[tid] = c ? atomicAdd(&cnt[tid * CNT_STRIDE], c) : 0u; lcnt[tid] = 0u; }
        __syncthreads();
        const unsigned base = lbase[lane];
#pragma unroll
        for (int rr = 0; rr < RPW; ++rr)
            if (selm & (1u << rr)) {
                const unsigned rk = base + lrk[rr];
                LIST[(size_t)lane * CAP + rk] = make_uint2((unsigned)(tok0 + rr), __builtin_bit_cast(unsigned, gatev[rr]));
                TOPK[(size_t)(tok0 + rr) * 8 + posv[rr]] = (unsigned)lane | (rk << 8);
            }
    }
}

DEV void phase_pb(const P& p, int layer, LAS unsigned char* lds) {
    const bf16_t* H = (const bf16_t*)(wsp(p) + (layer == 0 ? WS_H : WS_HIN1)); const bf16_t* WIN = (const bf16_t*)(wsp(p) + WS_WIN); bf16_t* O = (bf16_t*)(wsp(p) + WS_QKVZX);
    g8::SchedDense S{H, WIN, DM, DM, TT / 256, NIN / 256, (int)gridDim.x, (int)blockIdx.x};
    g8::EpiStore E{O, NIN};
    g8::gemm(lds, S, E, DM / 64, DM);
}

template <bool FRAG = false> DEV void store_transposed(unsigned char* lds, const float (*v)[8], bf16_t* dst, size_t stride) {
    bf16_t* t = (bf16_t*)lds;
    const int tid = tidx();
    __syncthreads();
#pragma unroll
    for (int i = 0; i < 4; ++i) *(uint4*)(t + ((tid >> 3) + 32 * i) * 72 + (tid & 7) * 8) = pack8(v[i]);
    __syncthreads();
    const int c = tid >> 2, sp = (tid & 3) * 32;
#pragma unroll
    for (int jj = 0; jj < 4; ++jj) {
        unsigned w[4];
#pragma unroll
        for (int e = 0; e < 4; ++e) w[e] = (unsigned)t[(sp + jj * 8 + 2 * e) * 72 + c] | ((unsigned)t[(sp + jj * 8 + 2 * e + 1) * 72 + c] << 16);
        if (FRAG) *(uint4*)(dst + (size_t)((sp >> 3) + jj) * 512 + c * 8) = make_uint4(w[0], w[1], w[2], w[3]);
        else *(uint4*)(dst + (size_t)c * stride + sp + jj * 8) = make_uint4(w[0], w[1], w[2], w[3]);
    }
}
struct PcRegs { u32x4 ra[4], rb[4], rc[4]; f32x4v w[8]; };
DEV void pc_issue(const P& p, int layer, int u, PcRegs& R) {
    const bf16_t* QK = (const bf16_t*)(wsp(p) + WS_QKVZX);
    const int tid = tidx(), c8 = (tid & 7) * 8, s0 = tid >> 3;
    const int ch = u / 29, sub = u % 29;
    const bool lat = ch < NCHL;
    const int tok0 = ch * 128;
    const int pos0 = lat ? (ch & 15) * 128 : ((ch - NCHL) & 1) * 128;
    const int slen = lat ? SEQ : LC;
    if (sub < 16) {
        const int cc = sub * 64 + c8;
        const float* cw = p.conv_w + (size_t)layer * 3 * 1024 + cc; const float* cbp = p.conv_b + layer * 1024 + cc;
        R.w[0] = *(const f32x4v*)cw; R.w[1] = *(const f32x4v*)(cw + 4); R.w[2] = *(const f32x4v*)(cw + 1024); R.w[3] = *(const f32x4v*)(cw + 1028);
        R.w[4] = *(const f32x4v*)(cw + 2048); R.w[5] = *(const f32x4v*)(cw + 2052); R.w[6] = *(const f32x4v*)cbp; R.w[7] = *(const f32x4v*)(cbp + 4);
#pragma unroll
        for (int i = 0; i < 4; ++i) {
            const int s = s0 + 32 * i, pos = pos0 + s;
            const bf16_t* src = QK + (size_t)(tok0 + s) * NIN + C_X + cc;
            R.rb[i] = *(const u32x4*)src; R.ra[i] = *(const u32x4*)(pos > 0 ? src - NIN : src); R.rc[i] = *(const u32x4*)(pos < slen - 1 ? src + NIN : src);
        }
    } else if (sub < 28) {
        const int hs = sub - 16;
        const int col = hs < 8 ? C_Q + hs * 64 : (hs < 10 ? C_K + (hs - 8) * 64 : C_V + (hs - 10) * 64);
#pragma unroll
        for (int i = 0; i < 4; ++i) R.rb[i] = *(const u32x4*)(QK + (size_t)(tok0 + s0 + 32 * i) * NIN + col + c8);
        const float* g = (hs < 8 ? p.q_norm : p.k_norm) + layer * 64 + c8;
        R.w[0] = *(const f32x4v*)g; R.w[1] = *(const f32x4v*)(g + 4);
    }
}
DEV void pc_consume(const P& p, int layer, unsigned char* lds, int u, const PcRegs& R) {
    bf16_t* QP = (bf16_t*)(wsp(p) + WS_QP); bf16_t* KP = (bf16_t*)(wsp(p) + WS_KP); bf16_t* VT = (bf16_t*)(wsp(p) + WS_VT);
    bf16_t* XT = (bf16_t*)(wsp(p) + WS_XT); bf16_t* BT = (bf16_t*)(wsp(p) + WS_BT); bf16_t* BC = (bf16_t*)(wsp(p) + WS_BC); bf16_t* CF = (bf16_t*)(wsp(p) + WS_CF);
    const float2* ROPE = (const float2*)(wsp(p) + WS_ROPE);
    const float* DT = (const float*)(wsp(p) + WS_DT);
    float* CUM = (float*)(wsp(p) + WS_CUM); float* WST = (float*)(wsp(p) + WS_WST); float* DTT = (float*)(wsp(p) + WS_DTT); float* TOT = (float*)(wsp(p) + WS_TOT);
    const int tid = tidx(), c8 = (tid & 7) * 8, s0 = tid >> 3;
    {
        const int ch = u / 29, sub = u % 29;
        const bool lat = ch < NCHL;
        const int tok0 = ch * 128;
        const int pos0 = lat ? (ch & 15) * 128 : ((ch - NCHL) & 1) * 128;
        const int slen = lat ? SEQ : LC;
        if (sub < 16) {
            const int cg = sub, cc = cg * 64 + c8;
            float w0[8], w1[8], w2[8], bb[8];
#pragma unroll
            for (int e = 0; e < 4; ++e) { w0[e] = R.w[0][e]; w0[4 + e] = R.w[1][e]; w1[e] = R.w[2][e]; w1[4 + e] = R.w[3][e]; w2[e] = R.w[4][e]; w2[4 + e] = R.w[5][e]; bb[e] = R.w[6][e]; bb[4 + e] = R.w[7][e]; }
            float o[4][8];
#pragma unroll
            for (int i = 0; i < 4; ++i) {
                const int s = s0 + 32 * i, pos = pos0 + s;
                float a[8], b[8], c[8];
                unpack8(as_uint4(R.ra[i]), a); unpack8(as_uint4(R.rb[i]), b); unpack8(as_uint4(R.rc[i]), c);
                const float ma = pos > 0 ? 1.f : 0.f, mc = pos < slen - 1 ? 1.f : 0.f;
#pragma unroll
                for (int e = 0; e < 8; ++e) { a[e] *= ma; c[e] *= mc; }
#pragma unroll
                for (int e = 0; e < 8; ++e) o[i][e] = silu_f(bb[e] + w0[e] * a[e] + w1[e] * b[e] + w2[e] * c[e]);
                if (cg >= 12) *(uint4*)(CF + (((size_t)ch * 2 + ((cg - 12) >> 1)) * 16 + (((cc - 768) & 127) >> 3)) * 1024 + s * 8) = pack8(o[i]);
                else if (cg >= 8) *(uint4*)(BC + (size_t)(tok0 + s) * 512 + (cc - 512)) = pack8(o[i]);
            }
            if (cg < 8) store_transposed<true>(lds, o, XT + ((size_t)ch * 8 + cg) * 64 * 128, 128);
            else if (cg < 12) store_transposed(lds, o, BT + (((size_t)ch * 2 + ((cg - 8) >> 1)) * 128 + ((cg - 8) & 1) * 64) * 128, 128);
            else { __syncthreads(); __syncthreads(); }
            __syncthreads();
        } else if (sub < 28) {
            const int hs = sub - 16;
            float o[4][8];
#pragma unroll
            for (int i = 0; i < 4; ++i) {
                const int s = s0 + 32 * i;
                unpack8(as_uint4(R.rb[i]), o[i]);
                if (hs < 10) {
                    float ss = 0.f;
#pragma unroll
                    for (int e = 0; e < 8; ++e) ss += o[i][e] * o[i][e];
                    ss += __shfl_xor(ss, 1); ss += __shfl_xor(ss, 2); ss += __shfl_xor(ss, 4);
                    const float rs = rsqrtf(ss * (1.f / 64.f) + EPS);
#pragma unroll
                    for (int e = 0; e < 8; ++e) o[i][e] = o[i][e] * rs * (e < 4 ? R.w[0][e & 3] : R.w[1][e & 3]);
                    if (lat) {
                        const int pos = pos0 + s, half = (tid & 7) >> 2;
                        const float2* rp = ROPE + (size_t)pos * 32 + (c8 & 31);
#pragma unroll
                        for (int e = 0; e < 8; ++e) {
                            const float other = __shfl_xor(o[i][e], 4);
                            const float2 cs = rp[e];
                            o[i][e] = half ? (other * cs.y + o[i][e] * cs.x) : (o[i][e] * cs.x - other * cs.y);
                        }
                    }
                    if (hs < 8) {
#pragma unroll
                        for (int e = 0; e < 8; ++e) o[i][e] *= QSCALE;
                        *(uint4*)(QP + (size_t)(tok0 + s) * 512 + hs * 64 + c8) = pack8(o[i]);
                    } else *(uint4*)(KP + (size_t)(tok0 + s) * 128 + (hs - 8) * 64 + c8) = pack8(o[i]);
                }
            }
            if (hs >= 10) {
                const int b = lat ? ch >> 4 : (ch - NCHL) >> 1;
                const int kp0 = lat ? LC + pos0 : pos0;
                store_transposed(lds, o, VT + ((size_t)(b * 2 + (hs - 10)) * 64) * NKEY + kp0, NKEY);
            } else { __syncthreads(); __syncthreads(); }
            __syncthreads();
        } else {
            __syncthreads(); __syncthreads(); __syncthreads();
            const int lane = tid & 63, wv = tid >> 6;
#pragma unroll
            for (int jj = 0; jj < 4; ++jj) {
                const int j = wv * 4 + jj;
                const float nega = -__expf(p.a_log[layer * 16 + j]);
                const float d0 = DT[(size_t)(tok0 + 2 * lane) * 16 + j], d1 = DT[(size_t)(tok0 + 2 * lane + 1) * 16 + j];
                const float l0 = d0 * nega, l1 = d1 * nega;
                float incl = l0 + l1;
#pragma unroll
                for (int o = 1; o < 64; o <<= 1) { const float v = __shfl_up(incl, o); if (lane >= o) incl += v; }
                const float tot = __shfl(incl, 63), excl = incl - (l0 + l1);
                const float cu0 = j < 8 ? excl + l0 : excl, cu1 = j < 8 ? incl : excl + l0;
                float* dd = DTT + ((size_t)ch * 16 + j) * 128 + 2 * lane; float* cc = CUM + ((size_t)ch * 16 + j) * 128 + 2 * lane; float* ww = WST + ((size_t)ch * 16 + j) * 128 + 2 * lane;
                *(float2*)dd = make_float2(d0, d1);
                *(float2*)cc = make_float2(cu0, cu1);
                *(float2*)ww = make_float2(d0 * (j < 8 ? __expf(tot - cu0) : __expf(cu0)), d1 * (j < 8 ? __expf(tot - cu1) : __expf(cu1)));
                if (lane == 0) TOT[ch * 16 + j] = tot;
            }
        }
    }
}
DEV void phase_pc(const P& p, int layer, unsigned char* lds) {
    const int N = NCH * 29, G = vgrid();
    PcRegs A, B;
    int u = vbid();
    if (u < N) pc_issue(p, layer, u, A);
    for (; u < N; u += 2 * G) {
        const int u1 = u + G, u2 = u + 2 * G;
        if (u1 < N) pc_issue(p, layer, u1, B);
        pc_consume(p, layer, lds, u, A);
        if (u1 >= N) break;
        if (u2 < N) pc_issue(p, layer, u2, A);
        pc_consume(p, layer, lds, u1, B);
    }
}

struct LdXTw {
    const bf16_t* xt; const float* w;
    DEV RawV raw(int, int r, int kcg) const {
        RawV x; x.q0 = *(const u32x4*)(xt + (size_t)(r >> 6) * 8192 + kcg * 512 + (r & 63) * 8);
        const float* wp = w + (r >> 6) * 128 + kcg * 8;
        x.q1 = *(const u32x4*)wp; x.q2 = *(const u32x4*)(wp + 4); return x;
    }
    DEV uint4 fin(const RawV& x, int, int, int) const {
        float f[8]; unpack8(as_uint4(x.q0), f);
#pragma unroll
        for (int e = 0; e < 4; ++e) { f[e] *= __uint_as_float(x.q1[e]); f[4 + e] *= __uint_as_float(x.q2[e]); }
        return pack8(f);
    }
};
struct EpStoreF32 {
    float* O;
    DEV void pre(int) {}
    DEV void operator()(const float* ct, int tid) const {
#pragma unroll
        for (int i = 0; i < 8; ++i) {
            const int id = tid + 256 * i, c8 = id >> 7, r = id & 127;
            *(float4*)(O + (size_t)c8 * 1024 + r * 8) = *(const float4*)(ct + r * 132 + c8 * 8);
            *(float4*)(O + (size_t)c8 * 1024 + r * 8 + 4) = *(const float4*)(ct + r * 132 + c8 * 8 + 4);
        }
    }
};
struct PdUnit { int kind; const bf16_t* a; const float* w; const bf16_t* b; int b_ld; bf16_t* os; float* oc; };
DEV void pd_unit_of(const P& p, int u, PdUnit& U) {
    const bf16_t* XT = (const bf16_t*)(wsp(p) + WS_XT); const bf16_t* BT = (const bf16_t*)(wsp(p) + WS_BT); const bf16_t* BC = (const bf16_t*)(wsp(p) + WS_BC); const bf16_t* CF = (const bf16_t*)(wsp(p) + WS_CF);
    const float* WST = (const float*)(wsp(p) + WS_WST);
    bf16_t* SST = (bf16_t*)(wsp(p) + WS_SST); float* CB = (float*)(wsp(p) + WS_CB);
    const int ch = u / 10, sub = u % 10;
    const int dir = (sub >> 2) & 1, hp = sub & 3, h0 = hp * 2, g0 = hp >> 1, g1 = sub & 1;
    U.kind = sub < 8 ? 0 : 1;
    U.a = sub < 8 ? XT + ((size_t)ch * 8 + h0) * 64 * 128 : CF + ((size_t)ch * 2 + g1) * 128 * 128;
    U.w = WST + ((size_t)ch * 16 + dir * 8 + h0) * 128;
    U.b = sub < 8 ? BT + ((size_t)ch * 2 + g0) * 128 * 128 : BC + (size_t)ch * 128 * 512 + g1 * 128;
    U.b_ld = sub < 8 ? 128 : 512;
    U.os = SST + (((size_t)ch * 2 + dir) * 8 + h0) * 64 * 128; U.oc = CB + ((size_t)ch * 2 + g1) * 128 * 128;
}
DEV void phase_pd(const P& p, unsigned char* lds) {
    constexpr int A_BYTES = 128 * 128, STAGE = 2 * A_BYTES;
    const int tid = tidx(), lane = tid & 63, wid = tid >> 6, wr = wid >> 1, wc = wid & 1;
    const int kc = tid & 7, r0 = tid >> 3;
    const int wsw = (kc ^ ((r0 >> 1) & 7)) << 4;
    const int rsw = (lane >> 1) & 7, lr = lane & 31, lh = lane >> 5;
    const int N = NCH * 10, G = vgrid();
    RawV xa[2][4], xb[2][4];
    unsigned voA0 = (unsigned)(kc * 512 + r0 * 8) * 2u, voW = (unsigned)kc * 32u, voA1 = (unsigned)(r0 * 8 + kc * 1024) * 2u;
    asm volatile("" : "+v"(voA0), "+v"(voW), "+v"(voA1));
#define PD_LD(base, sconst, voff) (*(const u32x4*)(uni_ptr((const char*)(base) + (sconst)) + (voff)))
#define PD_RAW(U_) do { unsigned vb_ = (unsigned)(r0 * (U_).b_ld + kc * 8) * 2u; asm volatile("" : "+v"(vb_)); \
        if ((U_).kind == 0) { _Pragma("unroll") for (int ks = 0; ks < 2; ++ks) _Pragma("unroll") for (int i = 0; i < 4; ++i) { \
            xa[ks][i].q0 = PD_LD((U_).a, (size_t)((i >> 1) * 8192 + ks * 4096 + (i & 1) * 256) * 2, voA0); \
            xa[ks][i].q1 = PD_LD((U_).w, (size_t)((i >> 1) * 128 + ks * 64) * 4, voW); xa[ks][i].q2 = PD_LD((U_).w, (size_t)((i >> 1) * 128 + ks * 64 + 4) * 4, voW); } } \
        else { _Pragma("unroll") for (int ks = 0; ks < 2; ++ks) _Pragma("unroll") for (int i = 0; i < 4; ++i) xa[ks][i].q0 = PD_LD((U_).a, (size_t)(i * 256 + ks * 8192) * 2, voA1); } \
        _Pragma("unroll") for (int ks = 0; ks < 2; ++ks) _Pragma("unroll") for (int i = 0; i < 4; ++i) xb[ks][i].q0 = PD_LD((U_).b, ((size_t)(32 * i) * (U_).b_ld + ks * 64) * 2, vb_); } while (0)
#define PD_PUT(U_, ks, stg) do { unsigned char* da_ = lds + (stg) * STAGE; _Pragma("unroll") for (int i = 0; i < 4; ++i) { \
        uint4 av_ = as_uint4(xa[ks][i].q0); \
        if ((U_).kind == 0) { float f_[8]; unpack8(av_, f_); _Pragma("unroll") for (int e = 0; e < 4; ++e) { f_[e] *= __uint_as_float(xa[ks][i].q1[e]); f_[4 + e] *= __uint_as_float(xa[ks][i].q2[e]); } av_ = pack8(f_); } \
        *(uint4*)(da_ + (r0 + 32 * i) * 128 + wsw) = av_; \
        *(uint4*)(da_ + A_BYTES + (r0 + 32 * i) * 128 + wsw) = as_uint4(xb[ks][i].q0); } } while (0)
#define PD_MMA(stg) do { const unsigned char* sa = lds + (stg) * STAGE; const unsigned char* sb = sa + A_BYTES; \
        _Pragma("unroll") for (int kk = 0; kk < 4; ++kk) { const int co = ((2 * kk + lh) ^ rsw) << 4; bf16x8 fa[2], fb[2]; \
            _Pragma("unroll") for (int mi = 0; mi < 2; ++mi) fa[mi] = *(const bf16x8*)(sa + (wr * 64 + mi * 32 + lr) * 128 + co); \
            _Pragma("unroll") for (int ni = 0; ni < 2; ++ni) fb[ni] = *(const bf16x8*)(sb + (wc * 64 + ni * 32 + lr) * 128 + co); \
            _Pragma("unroll") for (int mi = 0; mi < 2; ++mi) _Pragma("unroll") for (int ni = 0; ni < 2; ++ni) acc[mi][ni] = __builtin_amdgcn_mfma_f32_32x32x16_bf16(fa[mi], fb[ni], acc[mi][ni], 0, 0, 0); } } while (0)
    int u = vbid();
    if (u >= N) return;
    PdUnit cur, nxt;
    pd_unit_of(p, u, cur);
    PD_RAW(cur);
    for (;;) {
        const bool has = u + G < N;
        if (has) pd_unit_of(p, u + G, nxt);
        f32x16 acc[2][2];
#pragma unroll
        for (int mi = 0; mi < 2; ++mi)
#pragma unroll
            for (int ni = 0; ni < 2; ++ni)
#pragma unroll
                for (int e = 0; e < 16; ++e) acc[mi][ni][e] = 0.f;
        __syncthreads();
        PD_PUT(cur, 0, 0);
        __syncthreads();
        PD_MMA(0);
        PD_PUT(cur, 1, 1);
        __syncthreads();
        if (has) PD_RAW(nxt);
        PD_MMA(1);
        __syncthreads();
        float* ct = (float*)lds;
#pragma unroll
        for (int mi = 0; mi < 2; ++mi)
#pragma unroll
            for (int ni = 0; ni < 2; ++ni)
#pragma unroll
                for (int e = 0; e < 16; ++e) ct[(wr * 64 + mi * 32 + (e & 3) + 8 * (e >> 2) + 4 * lh) * 132 + wc * 64 + ni * 32 + lr] = acc[mi][ni][e];
        __syncthreads();
        { const int t2 = tidx(); if (cur.kind == 0) EpStoreBf16{cur.os}(ct, t2); else EpStoreF32{cur.oc}(ct, t2); }
        if (!has) break;
        cur = nxt; u += G;
    }
#undef PD_RAW
#undef PD_LD
#undef PD_PUT
#undef PD_MMA
}
DEV void phase_pe(const P& p) {
    bf16_t* SST = (bf16_t*)(wsp(p) + WS_SST); const float* TOT = (const float*)(wsp(p) + WS_TOT);
    for (int gid = vbid() * 256 + tidx(); gid < NB * 2 * 8 * 64 * 16; gid += vgrid() * 256) {
        const int n8 = gid & 15, pp = (gid >> 4) & 63, h = (gid >> 10) & 7, dir = (gid >> 13) & 1, b = gid >> 14;
        u32x4 loc[18]; float dec[18];
#pragma unroll
        for (int st = 0; st < 18; ++st) {
            const int ch = dir == 0 ? (st < 2 ? NCHL + b * 2 + st : b * 16 + (st - 2)) : (st < 2 ? NCHL + b * 2 + (1 - st) : b * 16 + (17 - st));
            loc[st] = *(const u32x4*)(SST + ((((size_t)ch * 2 + dir) * 8 + h) * 64 + pp) * 128 + n8 * 8);
            dec[st] = TOT[ch * 16 + dir * 8 + h];
        }
        float run[8];
#pragma unroll
        for (int e = 0; e < 8; ++e) run[e] = 0.f;
#pragma unroll
        for (int st = 0; st < 18; ++st) {
            const int ch = dir == 0 ? (st < 2 ? NCHL + b * 2 + st : b * 16 + (st - 2)) : (st < 2 ? NCHL + b * 2 + (1 - st) : b * 16 + (17 - st));
            *(uint4*)(SST + ((((size_t)ch * 2 + dir) * 8 + h) * 64 + pp) * 128 + n8 * 8) = pack8(run);
            const float d = __expf(dec[st]);
            const u32x4 q = loc[st];
            run[0] = d * run[0] + bflo(q.x); run[1] = d * run[1] + bfhi(q.x); run[2] = d * run[2] + bflo(q.y); run[3] = d * run[3] + bfhi(q.y);
            run[4] = d * run[4] + bflo(q.z); run[5] = d * run[5] + bfhi(q.z); run[6] = d * run[6] + bflo(q.w); run[7] = d * run[7] + bfhi(q.w);
        }
    }
}
struct LdG {
    const float* cb; const bf16_t* cm; const float* sv; float totb, dsk;
    DEV RawV raw(int, int r, int kcg) const {
        const int seg = kcg >> 4, kk = (kcg & 15) * 8;
        RawV x;
        if (seg == 0 || seg == 2) { x.q0 = *(const u32x4*)(cb + (size_t)r * 128 + kk); x.q1 = *(const u32x4*)(cb + (size_t)r * 128 + kk + 4); }
        else x.q0 = *(const u32x4*)(cm + (size_t)r * 512 + kk);
        return x;
    }
    DEV uint4 fin(const RawV& x, int, int r, int kcg) const {
        const int seg = kcg >> 4, kk = (kcg & 15) * 8;
        float f[8];
        if (seg == 0 || seg == 2) {
            const bool fwd = seg == 0;
            if (fwd ? (kk > r) : (kk + 7 < r)) return make_uint4(0u, 0u, 0u, 0u);
            float cbv[8];
#pragma unroll
            for (int e = 0; e < 4; ++e) { cbv[e] = __uint_as_float(x.q0[e]); cbv[4 + e] = __uint_as_float(x.q1[e]); }
            const float* cu = sv + (fwd ? 0 : 128); const float* dt = sv + (fwd ? 256 : 384);
            const float4 c0 = *(const float4*)(cu + kk), c1 = *(const float4*)(cu + kk + 4), d0 = *(const float4*)(dt + kk), d1 = *(const float4*)(dt + kk + 4);
            const float cus[8] = {c0.x, c0.y, c0.z, c0.w, c1.x, c1.y, c1.z, c1.w}, dts[8] = {d0.x, d0.y, d0.z, d0.w, d1.x, d1.y, d1.z, d1.w};
            const float cl = cu[r];
#pragma unroll
            for (int e = 0; e < 8; ++e) {
                const int s = kk + e;
                const bool on = fwd ? (s <= r) : (s >= r);
                const float ex = fwd ? __expf(cl - cus[e]) : __expf(cus[e] - cl);
                float v = on ? cbv[e] * ex * dts[e] : 0.f;
                if (fwd && s == r) v += dsk;
                f[e] = v;
            }
        } else {
            unpack8(as_uint4(x.q0), f);
            const float sc = seg == 1 ? __expf(sv[r]) : __expf(totb - sv[128 + r]);
#pragma unroll
            for (int e = 0; e < 8; ++e) f[e] *= sc;
        }
        return pack8(f);
    }
};
struct LdXS {
    const bf16_t* xt; const bf16_t* sf; const bf16_t* sb;
    DEV RawV raw(int, int r, int kcg) const {
        const int seg = kcg >> 4, kk = (kcg & 15) * 8;
        const bf16_t* base = (seg == 1) ? sf : (seg == 3 ? sb : xt);
        RawV x; x.q0 = *(const u32x4*)(base + (size_t)r * 128 + kk); return x;
    }
    DEV uint4 fin(const RawV& x, int, int, int) const { return as_uint4(x.q0); }
};
struct EpSsd {
    const bf16_t* z; bf16_t* o; float* ssq;
    u32x4 zr[4];
    DEV void pre(int tid) {
#pragma unroll
        for (int i = 0; i < 4; ++i) { const int id = tid + 256 * i, r = id >> 3, c8 = id & 7; zr[i] = *(const u32x4*)(z + (size_t)r * NIN + c8 * 8); }
    }
    DEV void operator()(const float* ct, int tid) const {
#pragma unroll
        for (int i = 0; i < 4; ++i) {
            const int id = tid + 256 * i, r = id >> 3, c8 = id & 7;
            float v[8], zz[8]; ld8f(ct, r * 64 + c8 * 8, v);
            unpack8(as_uint4(zr[i]), zz);
            float ss = 0.f;
#pragma unroll
            for (int e = 0; e < 8; ++e) { v[e] *= silu_f(zz[e]); ss += v[e] * v[e]; }
            *(uint4*)(o + (size_t)r * DM + c8 * 8) = pack8(v);
            ss += __shfl_xor(ss, 1); ss += __shfl_xor(ss, 2); ss += __shfl_xor(ss, 4);
            if (c8 == 0) ssq[(size_t)r * 8] = ss;
        }
    }
};
DEV void phase_pf(const P& p, int layer, unsigned char* lds) {
    const bf16_t* XT = (const bf16_t*)(wsp(p) + WS_XT); const bf16_t* CF = (const bf16_t*)(wsp(p) + WS_CF); const bf16_t* SST = (const bf16_t*)(wsp(p) + WS_SST);
    const float* CB = (const float*)(wsp(p) + WS_CB); const float* CUM = (const float*)(wsp(p) + WS_CUM); const float* DTT = (const float*)(wsp(p) + WS_DTT); const float* TOT = (const float*)(wsp(p) + WS_TOT);
    const bf16_t* QK = (const bf16_t*)(wsp(p) + WS_QKVZX); bf16_t* AS = (bf16_t*)(wsp(p) + WS_AS); float* SSQ = (float*)(wsp(p) + WS_SSQ);
    const int nch = (layer == 0) ? NCH : NCHL;
    const int tid = tidx(), lane = tid & 63, wid = tid >> 6, lr = lane & 31, lh = lane >> 5;
    float* sv = (float*)(lds + wid * 2048);
    for (int u = vbid(); u < nch * 8; u += vgrid()) {
        const int ch = u >> 3, h = u & 7, g = h >> 2, tok0 = ch * 128, l = wid * 32 + lr;
        {
            const float* c0 = CUM + ((size_t)ch * 16 + h) * 128 + lane; const float* d0 = DTT + ((size_t)ch * 16 + h) * 128 + lane;
            const float a0 = c0[0], a1 = c0[64], b0 = c0[1024], b1 = c0[1088], e0 = d0[0], e1 = d0[64], f0 = d0[1024], f1 = d0[1088];
            sv[lane] = a0; sv[64 + lane] = a1; sv[128 + lane] = b0; sv[192 + lane] = b1; sv[256 + lane] = e0; sv[320 + lane] = e1; sv[384 + lane] = f0; sv[448 + lane] = f1;
        }
        const float totb = TOT[ch * 16 + 8 + h], dsk = p.d_skip[layer * 8 + h];
        const char* cbU = uni_ptr(CB + ((size_t)ch * 2 + g) * 128 * 128); const char* xtU = uni_ptr(XT + ((size_t)ch * 8 + h) * 64 * 128);
        const char* cmU = uni_ptr(CF + ((size_t)ch * 2 + g) * 128 * 128);
        const char* sfU = uni_ptr(SST + (((size_t)ch * 2 + 0) * 8 + h) * 64 * 128); const char* sbU = uni_ptr(SST + (((size_t)ch * 2 + 1) * 8 + h) * 64 * 128);
        unsigned ocb = (unsigned)(lh * 128 + l) * 32u, oxt = (unsigned)(lh * 64 + lr) * 16u, ocm = (unsigned)(lh * 128 + l) * 16u;
        asm volatile("" : "+v"(ocb), "+v"(oxt), "+v"(ocm));
#define PF_LD16(base, voff, imm) (*(const u32x4*)((base) + (voff) + (imm)))
        u32x4 rc0[8], rc1[8], rx0[8], rx1[8];
#pragma unroll
        for (int i = 0; i < 8; ++i) { rc0[i] = PF_LD16(cbU, ocb, 8192 * i); rc1[i] = PF_LD16(cbU, ocb, 8192 * i + 16); rx0[i] = PF_LD16(xtU, oxt, 2048 * i); rx1[i] = PF_LD16(xtU, oxt, 2048 * i + 512); }
        f32x16 acc[2];
#pragma unroll
        for (int e = 0; e < 16; ++e) { acc[0][e] = 0.f; acc[1][e] = 0.f; }
        const float cfl = sv[l], cbl = sv[128 + l];
        u32x4 rcm[8], rf0[8], rf1[8], rb0[8], rb1[8];
#pragma unroll
        for (int i = 0; i < 8; ++i) {
            const int sb = 16 * i + 8 * lh;
            const float4 q0 = *(const float4*)(sv + sb), q1 = *(const float4*)(sv + sb + 4), q2 = *(const float4*)(sv + 128 + sb), q3 = *(const float4*)(sv + 128 + sb + 4);
            const float4 q4 = *(const float4*)(sv + 256 + sb), q5 = *(const float4*)(sv + 256 + sb + 4), q6 = *(const float4*)(sv + 384 + sb), q7 = *(const float4*)(sv + 384 + sb + 4);
            const float cfs[8] = {q0.x, q0.y, q0.z, q0.w, q1.x, q1.y, q1.z, q1.w}, cbs[8] = {q2.x, q2.y, q2.z, q2.w, q3.x, q3.y, q3.z, q3.w};
            const float dfs[8] = {q4.x, q4.y, q4.z, q4.w, q5.x, q5.y, q5.z, q5.w}, dbs[8] = {q6.x, q6.y, q6.z, q6.w, q7.x, q7.y, q7.z, q7.w};
            float gv[8];
#pragma unroll
            for (int j = 0; j < 8; ++j) {
                const int s = sb + j;
                const float cbv = __uint_as_float(j < 4 ? rc0[i][j & 3] : rc1[i][j & 3]);
                const float arg = s < l ? cfl - cfs[j] : cbs[j] - cbl;
                float dtv = s < l ? dfs[j] : dbs[j];
                if (s == l) dtv += dfs[j];
                float v = cbv * __expf(arg) * dtv;
                if (s == l) v += dsk;
                gv[j] = v;
            }
            const bf16x8 gf = __builtin_bit_cast(bf16x8, pack8(gv));
            acc[0] = __builtin_amdgcn_mfma_f32_32x32x16_bf16(__builtin_bit_cast(bf16x8, rx0[i]), gf, acc[0], 0, 0, 0);
            acc[1] = __builtin_amdgcn_mfma_f32_32x32x16_bf16(__builtin_bit_cast(bf16x8, rx1[i]), gf, acc[1], 0, 0, 0);
            rcm[i] = PF_LD16(cmU, ocm, 4096 * i); rf0[i] = PF_LD16(sfU, oxt, 2048 * i); rf1[i] = PF_LD16(sfU, oxt, 2048 * i + 512);
            rb0[i] = PF_LD16(sbU, oxt, 2048 * i); rb1[i] = PF_LD16(sbU, oxt, 2048 * i + 512);
            __builtin_amdgcn_sched_barrier(0);
        }
        const char* zU = uni_ptr(QK + (size_t)tok0 * NIN + C_Z + h * 64);
        unsigned oz = (unsigned)(l * NIN + 4 * lh) * 2u; asm volatile("" : "+v"(oz));
        uint2 zr[8];
#pragma unroll
        for (int q = 0; q < 8; ++q) zr[q] = *(const uint2*)(zU + oz + 16 * q);
        const float af = __expf(cfl), ab = __expf(totb - cbl);
#pragma unroll
        for (int i = 0; i < 8; ++i) {
            float c[8], cf8[8], cb8[8];
            unpack8(as_uint4(rcm[i]), c);
#pragma unroll
            for (int j = 0; j < 8; ++j) { cf8[j] = c[j] * af; cb8[j] = c[j] * ab; }
            const bf16x8 ff = __builtin_bit_cast(bf16x8, pack8(cf8)), fb = __builtin_bit_cast(bf16x8, pack8(cb8));
            acc[0] = __builtin_amdgcn_mfma_f32_32x32x16_bf16(__builtin_bit_cast(bf16x8, rf0[i]), ff, acc[0], 0, 0, 0);
            acc[1] = __builtin_amdgcn_mfma_f32_32x32x16_bf16(__builtin_bit_cast(bf16x8, rf1[i]), ff, acc[1], 0, 0, 0);
            acc[0] = __builtin_amdgcn_mfma_f32_32x32x16_bf16(__builtin_bit_cast(bf16x8, rb0[i]), fb, acc[0], 0, 0, 0);
            acc[1] = __builtin_amdgcn_mfma_f32_32x32x16_bf16(__builtin_bit_cast(bf16x8, rb1[i]), fb, acc[1], 0, 0, 0);
        }
        bf16_t* op = AS + (size_t)(tok0 + l) * DM + h * 64 + 4 * lh;
#undef PF_LD16
        float ss = 0.f;
#pragma unroll
        for (int pt = 0; pt < 2; ++pt)
#pragma unroll
            for (int q = 0; q < 4; ++q) {
                const uint2 zz = zr[pt * 4 + q];
                const float z0 = bflo(zz.x), z1 = bfhi(zz.x), z2 = bflo(zz.y), z3 = bfhi(zz.y);
                const float y0 = acc[pt][4 * q] * silu_f(z0), y1 = acc[pt][4 * q + 1] * silu_f(z1), y2 = acc[pt][4 * q + 2] * silu_f(z2), y3 = acc[pt][4 * q + 3] * silu_f(z3);
                ss += (y0 * y0 + y1 * y1) + (y2 * y2 + y3 * y3);
                *(uint2*)(op + 32 * pt + 8 * q) = make_uint2(pk2(y0, y1), pk2(y2, y3));
            }
        ss += __shfl_xor(ss, 32);
        if (lh == 0) SSQ[(size_t)(tok0 + l) * 8 + h] = ss;
    }
}

DEV float fexp2(float x) { return __builtin_amdgcn_exp2f(x); }
#define ATT_SCORE(S_, qf_, m_, kb_) do { \
        _Pragma("unroll") for (int mt = 0; mt < 2; ++mt) _Pragma("unroll") for (int e = 0; e < 16; ++e) S_[mt][e] = -(m_); \
        __builtin_amdgcn_s_setprio(1); \
        _Pragma("unroll") for (int kk = 0; kk < 4; ++kk) _Pragma("unroll") for (int mt = 0; mt < 2; ++mt) \
            S_[mt] = __builtin_amdgcn_mfma_f32_32x32x16_bf16(kf[kk][mt], qf_[kk], S_[mt], 0, 0, 0); \
        __builtin_amdgcn_s_setprio(0); } while (0)
#define ATT_SOFTMAX(S_, m_, l_, ot_, pb_) do { \
        float mx = S_[0][0]; \
        _Pragma("unroll") for (int e = 1; e < 16; ++e) mx = fmaxf(mx, S_[0][e]); \
        _Pragma("unroll") for (int e = 0; e < 16; ++e) mx = fmaxf(mx, S_[1][e]); \
        mx = fmaxf(mx, __shfl_xor(mx, 32)); \
        if (!__all(mx <= 8.f)) { \
            const float dm = fmaxf(mx, 0.f), alpha = fexp2(-dm); \
            m_ += dm; l_ *= alpha; \
            _Pragma("unroll") for (int dt = 0; dt < 2; ++dt) _Pragma("unroll") for (int e = 0; e < 16; ++e) ot_[dt][e] *= alpha; \
            _Pragma("unroll") for (int mt = 0; mt < 2; ++mt) _Pragma("unroll") for (int e = 0; e < 16; ++e) S_[mt][e] -= dm; \
        } \
        float ps = 0.f; \
        _Pragma("unroll") for (int mt = 0; mt < 2; ++mt) _Pragma("unroll") for (int e = 0; e < 16; ++e) { S_[mt][e] = fexp2(S_[mt][e]); ps += S_[mt][e]; } \
        l_ += ps; \
        _Pragma("unroll") for (int mt = 0; mt < 2; ++mt) _Pragma("unroll") for (int sx = 0; sx < 2; ++sx) { \
            const u32x4 pbu = {pk2(S_[mt][8 * sx], S_[mt][8 * sx + 1]), pk2(S_[mt][8 * sx + 2], S_[mt][8 * sx + 3]), pk2(S_[mt][8 * sx + 4], S_[mt][8 * sx + 5]), pk2(S_[mt][8 * sx + 6], S_[mt][8 * sx + 7])}; \
            pb_[mt][sx] = __builtin_bit_cast(bf16x8, pbu); } } while (0)
DEV void attn_unit(unsigned char* lds, const bf16_t* QP, const bf16_t* KP, const bf16_t* VT, bf16_t* AS, int b, int kvh, int hqa, int hqb, int tokA0, int tokB0, bool lat) {
    const int tid = tid512(), lane = tid & 63, wid = tid >> 6, lr = lane & 31, lh = lane >> 5;
    const int ntl = lat ? NKEY / 64 : LC / 64;
    const int tokA = tokA0 + wid * 32 + lr, tokB = tokB0 + wid * 32 + lr;
    bf16x8 qa[4], qb[4];
#pragma unroll
    for (int kk = 0; kk < 4; ++kk) { qa[kk] = *(const bf16x8*)(QP + (size_t)tokA * 512 + hqa * 64 + (2 * kk + lh) * 8); qb[kk] = *(const bf16x8*)(QP + (size_t)tokB * 512 + hqb * 64 + (2 * kk + lh) * 8); }
    f32x16 oa[2], ob[2];
#pragma unroll
    for (int dt = 0; dt < 2; ++dt)
#pragma unroll
        for (int e = 0; e < 16; ++e) { oa[dt][e] = 0.f; ob[dt][e] = 0.f; }
    float ma = 0.f, la = 0.f, mb = 0.f, lb = 0.f;
    const int sr = tid >> 3, sc = tid & 7;
    const bf16_t* vbase = VT + ((size_t)(b * 2 + kvh) * 64) * NKEY;
    const int fsw = (sc ^ ((sr >> 1) & 7)) << 4;
    u32x4 rk, rv;
#define ATT_LD(t_) do { const int tq = (t_); const int ktok0 = tq < 4 ? TL + b * LC + tq * 64 : b * SEQ + (tq - 4) * 64; \
        rk = *(const u32x4*)(KP + (size_t)(ktok0 + sr) * 128 + kvh * 64 + sc * 8); \
        rv = *(const u32x4*)(vbase + (size_t)sr * NKEY + tq * 64 + sc * 8); } while (0)
#define ATT_ST(buf_) do { unsigned char* kb_ = lds + (buf_) * 16384; unsigned char* vb_ = kb_ + 8192; \
        *(u32x4*)(kb_ + sr * 128 + fsw) = rk; \
        *(u32x4*)(vb_ + sr * 128 + fsw) = ((sr >> 4) & 1) ? __builtin_shufflevector(rv, rv, 2, 3, 0, 1) : rv; } while (0)
    const int rsw = (lr >> 1) & 7, hsw = (lr >> 4) & 1;
    ATT_LD(0);
    __syncthreads();
    ATT_ST(0);
    ATT_LD(1);
    ATT_ST(1);
    __syncthreads();
    for (int t = 0; t < ntl; ++t) {
        if (t + 2 < ntl) ATT_LD(t + 2);
        const unsigned char* kb = lds + (t % 3) * 16384; const unsigned char* vb = kb + 8192;
        bf16x8 kf[4][2];
#pragma unroll
        for (int kk = 0; kk < 4; ++kk)
#pragma unroll
            for (int mt = 0; mt < 2; ++mt) kf[kk][mt] = *(const bf16x8*)(kb + (mt * 32 + lr) * 128 + (((2 * kk + lh) ^ rsw) << 4));
        f32x16 st[2]; bf16x8 pa[2][2], pbb[2][2];
        ATT_SCORE(st, qa, ma, kb);
        ATT_SOFTMAX(st, ma, la, oa, pa);
        ATT_SCORE(st, qb, mb, kb);
        ATT_SOFTMAX(st, mb, lb, ob, pbb);
#pragma unroll
        for (int mt = 0; mt < 2; ++mt)
#pragma unroll
            for (int sx = 0; sx < 2; ++sx) {
                bf16x8 va[2];
#pragma unroll
                for (int dt = 0; dt < 2; ++dt) {
                    const unsigned char* vr = vb + (dt * 32 + lr) * 128 + ((lh ^ hsw) << 3);
                    const int c0 = 4 * mt + 2 * sx;
                    const uint2 h0 = *(const uint2*)(vr + ((c0 ^ rsw) << 4)), h1 = *(const uint2*)(vr + (((c0 + 1) ^ rsw) << 4));
                    va[dt] = __builtin_bit_cast(bf16x8, (u32x4){h0.x, h0.y, h1.x, h1.y});
                }
#pragma unroll
                for (int dt = 0; dt < 2; ++dt) {
                    oa[dt] = __builtin_amdgcn_mfma_f32_32x32x16_bf16(va[dt], pa[mt][sx], oa[dt], 0, 0, 0);
                    ob[dt] = __builtin_amdgcn_mfma_f32_32x32x16_bf16(va[dt], pbb[mt][sx], ob[dt], 0, 0, 0);
                }
            }
        if (t + 2 < ntl) ATT_ST((t + 2) % 3);
        __syncthreads();
    }
#undef ATT_LD
#undef ATT_ST
    la += __shfl_xor(la, 32); lb += __shfl_xor(lb, 32);
    const float ila = 1.f / la, ilb = 1.f / lb;
    bf16_t* rowA = AS + (size_t)tokA * DM + 512 + hqa * 64; bf16_t* rowB = AS + (size_t)tokB * DM + 512 + hqb * 64;
#pragma unroll
    for (int dt = 0; dt < 2; ++dt)
#pragma unroll
        for (int g = 0; g < 4; ++g) {
            const int d0 = 32 * dt + 8 * g + 4 * lh;
            *(uint2*)(rowA + d0) = make_uint2(pk2(oa[dt][4 * g] * ila, oa[dt][4 * g + 1] * ila), pk2(oa[dt][4 * g + 2] * ila, oa[dt][4 * g + 3] * ila));
            *(uint2*)(rowB + d0) = make_uint2(pk2(ob[dt][4 * g] * ilb, ob[dt][4 * g + 1] * ilb), pk2(ob[dt][4 * g + 2] * ilb, ob[dt][4 * g + 3] * ilb));
        }
}
DEV void phase_pg(const P& p, int layer, unsigned char* lds) {
    const bf16_t* QP = (const bf16_t*)(wsp(p) + WS_QP); const bf16_t* KP = (const bf16_t*)(wsp(p) + WS_KP); const bf16_t* VT = (const bf16_t*)(wsp(p) + WS_VT);
    bf16_t* AS = (bf16_t*)(wsp(p) + WS_AS);
    const int nctx = (layer == 0) ? 32 : 0;
    for (int u0 = blockIdx.x; u0 < 256 + nctx; u0 += gridDim.x) {
        const int u = (u0 < 256 && gridDim.x == 256) ? (u0 & 7) * 32 + (u0 >> 3) : u0;
        if (u < 256) { const int b = u >> 5, hq = (u >> 2) & 7, qb = u & 3; attn_unit(lds, QP, KP, VT, AS, b, hq >> 2, hq, hq, b * SEQ + qb * 512, b * SEQ + qb * 512 + 256, true); }
        else { const int uu = u - 256, b = uu >> 2, hp = uu & 3; attn_unit(lds, QP, KP, VT, AS, b, hp >> 1, 2 * hp, 2 * hp + 1, TL + b * LC, TL + b * LC, false); }
    }
}

struct EpiOut {
    static constexpr int MID_T = 8;
    bf16_t* O; const float* ssq;
    DEV void mid(g8::f32x4 (&acc)[2][2][4][2], const g8::Unit& u, int wr, int fr) const {
#pragma unroll
        for (int ai = 0; ai < 2; ++ai)
#pragma unroll
            for (int m = 0; m < 4; ++m) {
                const float* q = ssq + (size_t)(u.row0 + ai * 128 + wr * 64 + m * 16 + fr) * 8;
                const float4 a = *(const float4*)q, b = *(const float4*)(q + 4);
                const float rs = rsqrtf((((a.x + a.y) + (a.z + a.w)) + ((b.x + b.y) + (b.z + b.w))) * (1.f / 512.f) + EPS);
#pragma unroll
                for (int bj = 0; bj < 2; ++bj)
#pragma unroll
                    for (int n = 0; n < 2; ++n) acc[ai][bj][m][n] = acc[ai][bj][m][n] * rs;
            }
    }
    DEV void operator()(const g8::f32x4 (&acc)[2][2][4][2], const g8::Unit& u, int wr, int wc, int fr, int fq) const { g8::EpiStore{O, DM}(acc, u, wr, wc, fr, fq); }
};
DEV void phase_ph(const P& p, int layer, LAS unsigned char* lds) {
    const int nt = (layer == 0) ? TT : TL;
    g8::SchedDense S{(const bf16_t*)(wsp(p) + WS_AS), (const bf16_t*)(wsp(p) + WS_WOUT), DM, DM, nt / 256, DM / 256, (int)gridDim.x, (int)blockIdx.x};
    EpiOut E{(bf16_t*)(wsp(p) + WS_ML), (const float*)(wsp(p) + WS_SSQ)};
    g8::gemm(lds, S, E, DM / 64, DM);
}

struct MoeMap { int offs[66]; int tp[66]; };
DEV void build_map(const P& p, int layer, MoeMap* mm) {
    const unsigned* cnt = (const unsigned*)(wsp(p) + WS_CTL) + CW_CNT + layer * CNT_LAYER;
    const int nt = (layer == 0) ? TT : TL;
    __syncthreads();
    if (tidx() == 0) {
        int o = 0, t = 0;
        for (int e = 0; e < 65; ++e) {
            const int c = e < 64 ? (int)__hip_atomic_load(&cnt[e * CNT_STRIDE], __ATOMIC_RELAXED, __HIP_MEMORY_SCOPE_AGENT) : nt;
            mm->offs[e] = o; mm->tp[e] = t; o += c; t += (c + 255) >> 8;
        }
        mm->offs[65] = o; mm->tp[65] = t;
    }
    __syncthreads();
}
template <class MP> DEV int find_expert(MP mm, int ti) {
    const int l = hw_lane(); const bool le = mm->tp[l + 1] <= ti;
    return (int)__popcll(__ballot(le));
}

template <int mode> struct SchedMoe {
    static constexpr bool GATHER = (mode == 0), F8 = true;
    const MoeMap* mm; int nsub, G, c;
    const bf16_t* A; const bf16_t* W0; const bf16_t* W1; const uint2* LIST;
    DEV bool next(int i, g8::Unit& u) const {
        const LAS MoeMap* mm; { unsigned o = (unsigned)(size_t)(const LAS MoeMap*)this->mm; asm volatile("" : "+s"(o)); mm = (const LAS MoeMap*)(size_t)o; }
        const int ntile = __builtin_amdgcn_readfirstlane(mm->tp[65]), w = g8::deal(i, G, c, ntile * nsub); if (w < 0) return false;
        const int ti = w / nsub, sub = w % nsub, e = __builtin_amdgcn_readfirstlane(find_expert(mm, ti)), tt = __builtin_amdgcn_readfirstlane(ti - mm->tp[e]);
        const int cnt_e = __builtin_amdgcn_readfirstlane(mm->offs[e + 1] - mm->offs[e]), nvalid = min(256, cnt_e - tt * 256), slot0 = __builtin_amdgcn_readfirstlane(mm->offs[e]) + tt * 256;
        u.row0 = slot0; u.nvalid = nvalid; u.sub = sub;
        if (mode == 0) {
            u.a = (const char*)A; u.b0 = (const char*)W0 + ((size_t)e * FE + sub * 128) * DM; u.b1 = (const char*)W1 + ((size_t)e * FE + sub * 128) * DM;
            u.aux = e < 64 ? (const void*)(LIST + (size_t)e * CAP + tt * 256) : nullptr; u.col0 = tt * 256;
        } else {
            u.a = (const char*)A + (size_t)slot0 * FE; u.b0 = (const char*)W0 + ((size_t)e * DM + sub * 256) * FE; u.b1 = u.b0 + (size_t)128 * FE;
            u.aux = nullptr; u.col0 = sub * 256;
        }
        return true;
    }
    DEV size_t a_half() const { return mode == 0 ? (size_t)0 : (size_t)128 * FE; }
    DEV void a_off(const g8::Unit& u, unsigned (&v0)[2], unsigned (&v1)[2]) const {
        const int tz = tid512();
        if (mode == 0) {
            const uint2* lst = (const uint2*)u.aux;
#pragma unroll
            for (int i = 0; i < 2; ++i) {
                int R, C; g8::stage_rc(tz * 16 + i * 8192, R, C);
                const int ra = R < u.nvalid ? R : 0, rb = (128 + R) < u.nvalid ? 128 + R : 0;
                const unsigned ta = lst ? lst[ra].x : (unsigned)(u.col0 + ra), tb = lst ? lst[rb].x : (unsigned)(u.col0 + rb);
                v0[i] = ta * (unsigned)DM + (unsigned)C * 2u; v1[i] = tb * (unsigned)DM + (unsigned)C * 2u;
            }
        } else {
#pragma unroll
            for (int i = 0; i < 2; ++i) { int R, C; g8::stage_rc(tz * 16 + i * 8192, R, C); v0[i] = (unsigned)(R * FE + C * 2); v1[i] = v0[i]; }
        }
    }
};
struct EpiAct {
    static constexpr int MID_T = 0;
    unsigned char* act;
    DEV void operator()(const g8::f32x4 (&acc)[2][2][4][2], const g8::Unit& u, int wr, int wc, int fr, int fq) const {
        const uint2* lst = (const uint2*)u.aux;
#pragma unroll
        for (int ai = 0; ai < 2; ++ai)
#pragma unroll
            for (int m = 0; m < 4; ++m) {
                const int r = ai * 128 + wr * 64 + m * 16 + fr;
                if (r < u.nvalid) {
                    const float gate = (lst ? __builtin_bit_cast(float, lst[r].y) : 1.f) * (GU_DESCALE * A8_SCALE);
                    float o[8];
#pragma unroll
                    for (int n = 0; n < 2; ++n)
#pragma unroll
                        for (int j = 0; j < 4; ++j) o[4 * n + j] = silu_f(acc[ai][0][m][n][j] * GU_DESCALE) * acc[ai][1][m][n][j] * gate;
                    *(uint2*)(act + (size_t)(u.row0 + r) * FE + u.sub * 128 + wc * 32 + 8 * fq) = make_uint2(pk4_f8(o[0], o[1], o[2], o[3]), pk4_f8(o[4], o[5], o[6], o[7]));
                }
            }
    }
};
DEV void phase_pj(const P& p, int layer, LAS unsigned char* lds, MoeMap* mm) {
    build_map(p, layer, mm);
    SchedMoe<0> S{mm, 2, (int)gridDim.x, (int)blockIdx.x, (const bf16_t*)(wsp(p) + WS_H), (const bf16_t*)(wsp(p) + WS_WG), (const bf16_t*)(wsp(p) + WS_WU), (const uint2*)(wsp(p) + WS_LIST)};
    EpiAct E{(unsigned char*)(wsp(p) + WS_ACT)};
    g8::gemm(lds, S, E, DM / 128, DM / 2);
}
template <bool FP8> DEV void phase_pk(const P& p, int layer, LAS unsigned char* lds, MoeMap* mm) {
    build_map(p, layer, mm);
    SchedMoe<1> S{mm, 4, (int)gridDim.x, (int)blockIdx.x, (const bf16_t*)(wsp(p) + WS_ACT), (const bf16_t*)(wsp(p) + WS_WD), nullptr, nullptr};
    static_assert(FP8, "the down projection runs on e4m3 operands and parks e4m3 outputs");
    g8::EpiStore8 E{(unsigned char*)(wsp(p) + WS_YH), DM, DN_RESCALE}; g8::gemm(lds, S, E, FE / 128, FE / 2);
}
template <int RPW> DEV void phase_pm(const P& p, int layer, unsigned char* lds, MoeMap* mm, int row0, int nrows) {
    const bool last = (layer == 1);
    const int tid = tidx(), lane = tid & 63, wid = tid >> 6;
    const float* MOD = (const float*)(wsp(p) + WS_MOD);
    const bf16_t* YH = (const bf16_t*)(wsp(p) + WS_YH); const unsigned* TOPK = (const unsigned*)(wsp(p) + WS_TOPK);
    bf16_t* XB = (bf16_t*)(wsp(p) + WS_XB);
    bf16_t* H = (bf16_t*)(wsp(p) + WS_HIN1); float* DT = (float*)(wsp(p) + WS_DT);
    float* hl = (float*)lds; float* part = (float*)(lds + HL_BYTES);
    build_map(p, layer, mm);
    for (int task = vbid(); task < nrows / (4 * RPW); task += vgrid()) {
        const int tok0 = row0 + task * (4 * RPW) + wid * RPW;
        bf16_t* xb = XB + (size_t)tok0 * DM;
        const int mr = tok0 < TL ? tok0 / SEQ : 8;
        const float* md = MOD + ((size_t)layer * 9 + mr) * 6144;
        const float* md1 = MOD + ((size_t)(last ? layer : layer + 1) * 9 + mr) * 6144;
        float pa[16], pb[16], pc[16];
        ld_row16(md + 5120, lane, pa); ld_row16(md1 + 1024, lane, pb); ld_row16(md1 + 0, lane, pc);
        __syncthreads();
#pragma unroll 1
        for (int rr = 0; rr < RPW; ++rr) {
            const int tok = tok0 + rr;
            float x[16], y[16];
            ld_row16_bf(xb + (size_t)rr * DM, lane, x);
#pragma unroll
            for (int e = 0; e < 16; ++e) y[e] = 0.f;
#pragma unroll
            for (int k = 0; k < 9; ++k) {
                int slot;
                if (k < 8) { const unsigned tk = TOPK[(size_t)tok * 8 + k]; slot = mm->offs[tk & 255u] + (int)(tk >> 8); } else slot = mm->offs[64] + tok;
#pragma unroll
                for (int i = 0; i < 4; ++i) {
                    if (true) {
                        typedef float f32x2v __attribute__((ext_vector_type(2)));
                        const int q = *(const int*)((const unsigned char*)YH + (size_t)slot * DM + 4 * lane + 256 * i);
                        const f32x2v lo = __builtin_amdgcn_cvt_pk_f32_fp8(q, false), hi = __builtin_amdgcn_cvt_pk_f32_fp8(q, true);
                        y[4 * i] += lo[0]; y[4 * i + 1] += lo[1]; y[4 * i + 2] += hi[0]; y[4 * i + 3] += hi[1];
                    } else {
                        const uint2 q = *(const uint2*)(YH + (size_t)slot * DM + 4 * lane + 256 * i);
                        y[4 * i] += bflo(q.x); y[4 * i + 1] += bfhi(q.x); y[4 * i + 2] += bflo(q.y); y[4 * i + 3] += bfhi(q.y); }
                }
            }
            {
#pragma unroll
                for (int e = 0; e < 16; ++e) y[e] *= 0.0625f; }
            const float rsy = rstd16(y);
#pragma unroll
            for (int e = 0; e < 16; ++e) x[e] += pa[e] * (y[e] * rsy);
            if (last) st_row16(p.out + (size_t)tok * DM, lane, x); else st_row16_bf(xb + (size_t)rr * DM, lane, x);
            if (!last) {
                const float rs = rstd16(x);
                float h[16];
#pragma unroll
                for (int e = 0; e < 16; ++e) h[e] = x[e] * rs * pb[e] + pc[e];
                st_row16_bf(H + (size_t)tok * DM, lane, h);
                st_row16(hl + (wid * RPW + rr) * HLS, lane, h);
            }
        }
        if (!last) {
            __syncthreads();
            dt_tail16<RPW>(hl, (const float4*)(wsp(p) + WS_WD2) + 4096 * (layer + 1), p.dt_bias + (layer + 1) * 16, part, DT, row0 + task * (4 * RPW), tid);
        }
    }
}

#define XB_TMO      128
#define XB_XCNT(j)  (256  + 64 * (j))
#define XB_XSUB(j)  (1280 + 64 * (j))
#define XB_XGEN(j)  (2304 + 64 * (j))
#define XB_TOP      3328
#define XB_TOPGEN   3392
#define XCD_BAR_WORDS 3456
#define XB_SPIN_CAP (1u << 18)
static_assert((CW_QH + 64) * 4 <= (int)CTL_BYTES && CW_CNT + 2 * CNT_LAYER <= CW_QH, "control words");
static_assert(XCD_BAR_WORDS <= CW_CNT, "barrier words below the expert counters");

__device__ __forceinline__ unsigned xb_ld(unsigned* p)              { return __hip_atomic_load(p, __ATOMIC_RELAXED, __HIP_MEMORY_SCOPE_AGENT); }
__device__ __forceinline__ unsigned xb_add(unsigned* p, unsigned v) { return __hip_atomic_fetch_add(p, v, __ATOMIC_RELAXED, __HIP_MEMORY_SCOPE_AGENT); }
__device__ __forceinline__ unsigned xb_xcc_id() { return (unsigned)__builtin_amdgcn_s_getreg((3 << 11) | 20) & 0xFu; }
#define XB_SPIN(cond, bar) do { unsigned _sp = 0; while (cond) { __builtin_amdgcn_s_sleep(1); \
    if ((++_sp & 255u) == 0u) { if (xb_ld(&(bar)[XB_TMO])) break; if (_sp > XB_SPIN_CAP) { atomicAdd(&(bar)[XB_TMO], 1u); break; } } } } while (0)

struct XcdBarrier {
    unsigned* bar; unsigned x;
    volatile LAS unsigned* st;
};
__device__ __forceinline__ XcdBarrier xcd_barrier_post(unsigned* bar, volatile LAS unsigned* st) {
    XcdBarrier b; b.bar = bar; b.x = xb_xcc_id(); b.st = st;
    if (tid512() == 0) (void)xb_add(&bar[XB_XCNT(b.x)], 1u);
    return b;
}
__device__ __forceinline__ void xcd_barrier_complete(unsigned* bar, unsigned x, unsigned& nloc, unsigned& nx) {
    const unsigned G = gridDim.x * gridDim.y * gridDim.z;
    unsigned sum, cnt, mine, sp = 0u;
    for (;;) {
        sum = 0u; cnt = 0u; mine = 0u;
#pragma unroll
        for (unsigned j = 0; j < 16; ++j) { const unsigned c = xb_ld(&bar[XB_XCNT(j)]); sum += c; cnt += (c > 0u) ? 1u : 0u; mine = (j == x) ? c : mine; }
        if (sum == G) break;
        __builtin_amdgcn_s_sleep(1);
        if ((++sp & 255u) == 0u) { if (xb_ld(&bar[XB_TMO])) break; if (sp > XB_SPIN_CAP) { atomicAdd(&bar[XB_TMO], 1u); break; } }
    }
    nloc = mine > 0u ? mine : 1u; nx = cnt > 0u ? cnt : 1u;
}
__device__ __forceinline__ void xcd_barrier(const XcdBarrier& b) {
    asm volatile("s_waitcnt vmcnt(0)" ::: "memory");
    __syncthreads();
    if (tid512() == 0) {
        unsigned* bar = b.bar;
        __builtin_amdgcn_s_waitcnt(0);
        unsigned nloc = b.st[0], nx = b.st[1];
        if (nloc == 0u) { xcd_barrier_complete(bar, b.x, nloc, nx); b.st[0] = nloc; b.st[1] = nx; }
        const unsigned old = xb_add(&bar[XB_XSUB(b.x)], 1u);
        const unsigned gen = old / nloc;
        if (old + 1u == (gen + 1u) * nloc) {
            __builtin_amdgcn_fence(__ATOMIC_RELEASE, "agent");
            asm volatile("s_waitcnt vmcnt(0)" ::: "memory");
            const unsigned og = xb_add(&bar[XB_TOP], 1u);
            const unsigned tg = og / nx;
            if (og + 1u == (tg + 1u) * nx) xb_add(&bar[XB_TOPGEN], 1u);
            else XB_SPIN(xb_ld(&bar[XB_TOPGEN]) == tg, bar);
            __builtin_amdgcn_fence(__ATOMIC_ACQUIRE, "agent");
            xb_add(&bar[XB_XGEN(b.x)], 1u);
            asm volatile("s_waitcnt vmcnt(0)" ::: "memory");
        } else {
            XB_SPIN(xb_ld(&bar[XB_XGEN(b.x)]) == gen, bar);
            __builtin_amdgcn_fence(__ATOMIC_ACQUIRE, "agent");
            asm volatile("s_waitcnt vmcnt(0)" ::: "memory");
        }
    }
    __syncthreads();
}

DEV unsigned long long rfl64(unsigned long long v) { const unsigned lo = __builtin_amdgcn_readfirstlane((unsigned)v), hi = __builtin_amdgcn_readfirstlane((unsigned)(v >> 32)); return ((unsigned long long)hi << 32) | lo; }
DEV void park_params(const P& p, LAS unsigned long long* tab) { tab[0] = (unsigned long long)p.x; tab[1] = (unsigned long long)p.c; tab[2] = (unsigned long long)p.ctx; tab[3] = (unsigned long long)p.c_ctx; tab[4] = (unsigned long long)p.w_mod; tab[5] = (unsigned long long)p.b_mod; tab[6] = (unsigned long long)p.g_pre_mix; tab[7] = (unsigned long long)p.g_post_mix; tab[8] = (unsigned long long)p.g_pre_ffn; tab[9] = (unsigned long long)p.g_post_ffn; tab[10] = (unsigned long long)p.w_in; tab[11] = (unsigned long long)p.q_norm; tab[12] = (unsigned long long)p.k_norm; tab[13] = (unsigned long long)p.conv_w; tab[14] = (unsigned long long)p.conv_b; tab[15] = (unsigned long long)p.dt_bias; tab[16] = (unsigned long long)p.a_log; tab[17] = (unsigned long long)p.d_skip; tab[18] = (unsigned long long)p.ssd_norm; tab[19] = (unsigned long long)p.w_out; tab[20] = (unsigned long long)p.router_w; tab[21] = (unsigned long long)p.router_bias; tab[22] = (unsigned long long)p.w_gate; tab[23] = (unsigned long long)p.w_up; tab[24] = (unsigned long long)p.w_down; tab[25] = (unsigned long long)p.ws_gate; tab[26] = (unsigned long long)p.ws_up; tab[27] = (unsigned long long)p.ws_down; tab[28] = (unsigned long long)p.out; tab[29] = (unsigned long long)p.ws; }
DEV P load_params(const LAS unsigned long long* tab) { P q; q.x = (const float*)(GAS const float*)rfl64(tab[0]); q.c = (const float*)(GAS const float*)rfl64(tab[1]); q.ctx = (const float*)(GAS const float*)rfl64(tab[2]); q.c_ctx = (const float*)(GAS const float*)rfl64(tab[3]); q.w_mod = (const float*)(GAS const float*)rfl64(tab[4]); q.b_mod = (const float*)(GAS const float*)rfl64(tab[5]); q.g_pre_mix = (const float*)(GAS const float*)rfl64(tab[6]); q.g_post_mix = (const float*)(GAS const float*)rfl64(tab[7]); q.g_pre_ffn = (const float*)(GAS const float*)rfl64(tab[8]); q.g_post_ffn = (const float*)(GAS const float*)rfl64(tab[9]); q.w_in = (const float*)(GAS const float*)rfl64(tab[10]); q.q_norm = (const float*)(GAS const float*)rfl64(tab[11]); q.k_norm = (const float*)(GAS const float*)rfl64(tab[12]); q.conv_w = (const float*)(GAS const float*)rfl64(tab[13]); q.conv_b = (const float*)(GAS const float*)rfl64(tab[14]); q.dt_bias = (const float*)(GAS const float*)rfl64(tab[15]); q.a_log = (const float*)(GAS const float*)rfl64(tab[16]); q.d_skip = (const float*)(GAS const float*)rfl64(tab[17]); q.ssd_norm = (const float*)(GAS const float*)rfl64(tab[18]); q.w_out = (const float*)(GAS const float*)rfl64(tab[19]); q.router_w = (const float*)(GAS const float*)rfl64(tab[20]); q.router_bias = (const float*)(GAS const float*)rfl64(tab[21]); q.w_gate = (const float*)(GAS const float*)rfl64(tab[22]); q.w_up = (const float*)(GAS const float*)rfl64(tab[23]); q.w_down = (const float*)(GAS const float*)rfl64(tab[24]); q.ws_gate = (const float*)(GAS const float*)rfl64(tab[25]); q.ws_up = (const float*)(GAS const float*)rfl64(tab[26]); q.ws_down = (const float*)(GAS const float*)rfl64(tab[27]); q.out = (float*)(GAS float*)rfl64(tab[28]); q.ws = (unsigned char*)(GAS unsigned char*)rfl64(tab[29]); return q; }
static_assert(g8::STAGE_BYTES + 512 * 16 <= LDS_HALF + LDS_MAIN, "the 8-wave GEMM's stage buffers + parking slots must stay below the second half's MoE map");
static_assert(HL_BYTES + 16 * 64 * 4 + 512 <= LDS_MAIN, "row-phase LDS");
__device__ __noinline__ void grid_bar() {
    const LAS unsigned long long* ptab = (const LAS unsigned long long*)(smem_all + LDS_PT);
    XcdBarrier bar_; bar_.bar = (unsigned*)(GAS unsigned*)rfl64(ptab[29]); bar_.x = xb_xcc_id(); bar_.st = (volatile LAS unsigned*)(smem_all + LDS_XB);
    xcd_barrier(bar_);
}
__global__ void __launch_bounds__(NTHR, 2) k_mega(P p0) {
    if ((threadIdx.x & 63) == 0) ((LAS int*)(smem_all + LDS_WT))[hw_slot()] = (int)(threadIdx.x >> 6);
    __syncthreads();
    unsigned char* smem = smem_all + vhalf() * LDS_HALF;
    MoeMap* mm = (MoeMap*)(smem + LDS_MAIN);
    LAS unsigned long long* ptab = (LAS unsigned long long*)(smem_all + LDS_PT);
    if (tid512() == 0) { *(uint4*)(smem_all + LDS_XB) = make_uint4(0u, 0u, 0u, 0u); park_params(p0, ptab); }
    __syncthreads();
    (void)xcd_barrier_post((unsigned*)(p0.ws + WS_CTL), (volatile LAS unsigned*)(smem_all + LDS_XB));
#define GRID_BAR() grid_bar()
    phase_p0(load_params(ptab), 0, smem, 2, true);
    GRID_BAR();
    phase_pa0<4>(load_params(ptab), smem, 0, TL); phase_pa0<1>(load_params(ptab), smem, TL, TC);
    GRID_BAR();
#define LAYER_BODY(layer) do { \
        phase_pb(load_params(ptab), layer, (LAS unsigned char*)smem_all); \
        if (layer == 0 && blockIdx.x >= 136) fill_strips(load_params(ptab), smem, 3); \
        if (layer == 1) phase_p0(load_params(ptab), 1, smem, 1, false);        \
        GRID_BAR(); \
        phase_pc(load_params(ptab), layer, smem); \
        GRID_BAR(); \
        phase_pd(load_params(ptab), smem); phase_pg(load_params(ptab), layer, smem_all); \
        GRID_BAR(); \
        phase_pe(load_params(ptab)); \
        GRID_BAR(); \
        phase_pf(load_params(ptab), layer, smem); \
        if (layer == 0 && blockIdx.x >= 64) fill_strips(load_params(ptab), smem, 2); \
        GRID_BAR(); \
        phase_ph(load_params(ptab), layer, (LAS unsigned char*)smem_all); \
        if (layer == 0 && blockIdx.x >= 32) fill_strips(load_params(ptab), smem, 3); \
        GRID_BAR(); \
        phase_pi<4>(load_params(ptab), layer, smem, 0, TL); if (layer == 0) phase_pi<1>(load_params(ptab), layer, smem, TL, TC); \
        if (layer == 0) fill_strips(load_params(ptab), smem, -1); \
        GRID_BAR(); \
        phase_pj(load_params(ptab), layer, (LAS unsigned char*)smem_all, (MoeMap*)(smem_all + LDS_HALF + LDS_MAIN)); \
        GRID_BAR(); \
        phase_pk<true>(load_params(ptab), layer, (LAS unsigned char*)smem_all, (MoeMap*)(smem_all + LDS_HALF + LDS_MAIN)); \
        GRID_BAR(); \
        phase_pm<4>(load_params(ptab), layer, smem, mm, 0, TL); if (layer == 0) phase_pm<1>(load_params(ptab), layer, smem, mm, TL, TC); \
        if (layer == 0) { phase_p0(load_params(ptab), 1, smem, 0, false); GRID_BAR(); } \
    } while (0)
    LAYER_BODY(0);
    LAYER_BODY(1);
#undef LAYER_BODY
}

extern "C" void kernel_launch(void* const* d_in, const int* in_sizes, int n_in, void* d_out, int out_size, void* d_ws, size_t ws_size, hipStream_t stream) {
    if (ws_size < WS_END) { fprintf(stderr, "workspace too small: %zu < %zu\n", ws_size, (size_t)WS_END); return; }
    static int grid = 0;
    if (!grid) {
        int dev = 0, cus = 0, per_cu = 0;
        (void)hipGetDevice(&dev);
        (void)hipDeviceGetAttribute(&cus, hipDeviceAttributeMultiprocessorCount, dev);
        (void)hipFuncSetAttribute((const void*)k_mega, hipFuncAttributeMaxDynamicSharedMemorySize, LDS_BYTES);
        (void)hipOccupancyMaxActiveBlocksPerMultiprocessor(&per_cu, (const void*)k_mega, NTHR, LDS_BYTES);
        if (per_cu < 1) per_cu = 1;
        grid = cus;
    }
    P p{};
    const float** pp = (const float**)&p;
    for (int i = 0; i < 28; ++i) pp[i] = (const float*)d_in[i];
    p.out = (float*)d_out; p.ws = (unsigned char*)d_ws;
    (void)hipMemsetAsync(d_ws, 0, CTL_BYTES, stream);
    hipLaunchKernelGGL(k_mega, dim3(grid), dim3(NTHR), LDS_BYTES, stream, p);
}
```

```cpp
#include <hip/hip_runtime.h>
#include <stdint.h>
#include <stdio.h>

#define DEV __device__ __forceinline__
typedef unsigned short bf16_t;
typedef short bf16x8 __attribute__((ext_vector_type(8)));
typedef float f32x16 __attribute__((ext_vector_type(16)));
typedef __bf16 bf16x2_t __attribute__((ext_vector_type(2)));
typedef float f32x2_t __attribute__((ext_vector_type(2)));
typedef unsigned u32x4 __attribute__((ext_vector_type(4)));
typedef unsigned u32x2 __attribute__((ext_vector_type(2)));
typedef float f32x4v __attribute__((ext_vector_type(4)));

constexpr int NB = 8, SEQ = 2048, LC = 256, DM = 1024;
constexpr int TL = NB * SEQ, TC = NB * LC, TT = TL + TC;
constexpr int NCH = TT / 128, NCHL = TL / 128;
constexpr int NIN = 2304, NINF = 2320;
constexpr int C_Q = 0, C_K = 512, C_V = 640, C_Z = 768, C_X = 1280;
constexpr int NKEY = LC + SEQ;
constexpr int NEXP = 64, FE = 256, CAP = TT;
constexpr float EPS = 1e-6f;
constexpr float QSCALE = 0.125f * 1.4426950408889634f;
constexpr int NTHR = 512;
#define NWAVE_TOT (vgrid() * 4)

constexpr size_t al256(size_t x) { return (x + 255) & ~(size_t)255; }
constexpr size_t WS_CTL = 0, CTL_BYTES = 65536;
constexpr size_t WS_MOD = WS_CTL + CTL_BYTES;
constexpr size_t WS_ROPE = WS_MOD + al256((size_t)2 * 9 * 6144 * 4);
constexpr size_t WS_RW2 = WS_ROPE + (size_t)2048 * 32 * 8;
constexpr size_t WS_WD2 = WS_RW2 + (size_t)2 * 65536 * 4;
constexpr size_t WS_WIN = WS_WD2 + (size_t)2 * 16384 * 4;
constexpr size_t WS_WOUT = WS_WIN + (size_t)NIN * DM * 2;
constexpr size_t WS_WD = WS_WOUT + (size_t)DM * DM * 2;
constexpr size_t WS_XB = WS_WD + (size_t)65 * FE * DM * 2;
constexpr size_t WS_DT = WS_XB + (size_t)TT * DM * 2;
constexpr size_t WS_TOPK = WS_DT + (size_t)TT * 16 * 4;
constexpr size_t WS_LIST = WS_TOPK + (size_t)TT * 8 * 4;
constexpr size_t WS_CUM = WS_LIST + (size_t)NEXP * CAP * 8;
constexpr size_t WS_WST = WS_CUM + (size_t)NCH * 16 * 128 * 4;
constexpr size_t WS_DTT = WS_WST + (size_t)NCH * 16 * 128 * 4;
constexpr size_t WS_TOT = WS_DTT + (size_t)NCH * 16 * 128 * 4;
constexpr size_t WS_SSQ = WS_TOT + al256((size_t)NCH * 16 * 4);
constexpr size_t WS_ACT = WS_SSQ + (size_t)TT * 8 * 4;
constexpr size_t WS_HIN1 = WS_ACT;
constexpr size_t WS_WG = WS_ACT + (size_t)TT * 9 * FE * 2;
constexpr size_t WS_YH = WS_WG;
constexpr size_t WS_WU = WS_WG + (size_t)65 * FE * DM * 2;
constexpr size_t WS_H = WS_WU + (size_t)65 * FE * DM * 2;
constexpr size_t WS_R1 = WS_H + (size_t)TT * DM * 2;
constexpr size_t WS_QKVZX = WS_R1;
constexpr size_t WS_ML = WS_R1;
constexpr size_t WS_QP = WS_QKVZX + (size_t)TT * NIN * 2;
constexpr size_t WS_KP = WS_QP + (size_t)TT * 512 * 2;
constexpr size_t WS_VT = WS_KP + (size_t)TT * 128 * 2;
constexpr size_t WS_XT = WS_VT + (size_t)NB * 2 * 64 * NKEY * 2;
constexpr size_t WS_BT = WS_XT + (size_t)NCH * 8 * 64 * 128 * 2;
constexpr size_t WS_BC = WS_BT + (size_t)NCH * 2 * 128 * 128 * 2;
constexpr size_t WS_SST = WS_BC + (size_t)TT * 512 * 2;
constexpr size_t WS_CB = WS_SST + (size_t)NCH * 2 * 8 * 64 * 128 * 2;
constexpr size_t WS_AS = WS_CB + (size_t)NCH * 2 * 128 * 128 * 4;
constexpr size_t WS_CF = WS_BC;
constexpr size_t WS_BF = WS_BC + (size_t)NCH * 2 * 128 * 128 * 2;
constexpr size_t WS_R1A_END = WS_AS + (size_t)TT * DM * 2;
constexpr size_t WS_YH_END = WS_YH + (size_t)TT * 9 * DM * 2;
constexpr size_t WS_END = WS_R1A_END > WS_YH_END ? WS_R1A_END : WS_YH_END;
static_assert(WS_END <= (size_t)536 * 1024 * 1024, "workspace map too large");
constexpr float H8_SCALE = 4.f, W8_SCALE = 256.f, GU_DESCALE = 1.f / (H8_SCALE * W8_SCALE);
constexpr float A8_SCALE = 16.f, WD8_SCALE = 128.f, YH8_SCALE = 16.f, DN_RESCALE = YH8_SCALE / (A8_SCALE * WD8_SCALE);
constexpr int CW_CNT = 4096, CNT_STRIDE = 32, CNT_LAYER = 64 * CNT_STRIDE;

struct P {
    const float *x, *c, *ctx, *c_ctx, *w_mod, *b_mod, *g_pre_mix, *g_post_mix, *g_pre_ffn, *g_post_ffn, *w_in, *q_norm, *k_norm, *conv_w, *conv_b,
        *dt_bias, *a_log, *d_skip, *ssd_norm, *w_out, *router_w, *router_bias, *w_gate, *w_up, *w_down, *ws_gate, *ws_up, *ws_down;
    float* out;
    unsigned char* ws;
};

#define LAS __attribute__((address_space(3)))
extern __shared__ __attribute__((aligned(16))) unsigned char smem_all[];
constexpr int LDS_MAIN = 73728, LDS_HALF = LDS_MAIN + 1024, LDS_XB = 2 * LDS_HALF, LDS_PT = LDS_XB + 64, LDS_WT = LDS_PT + 256, LDS_QB = LDS_WT + 256, LDS_BYTES = LDS_QB + 64;
DEV int hw_slot() { return (int)__builtin_amdgcn_s_getreg((5 << 11) | 4) & 63; }
DEV int hw_wave() { return __builtin_amdgcn_readfirstlane(((const LAS int*)(smem_all + LDS_WT))[hw_slot()]); }
DEV int hw_lane() { unsigned z = 0u; asm volatile("" : "+v"(z)); return (int)__builtin_amdgcn_mbcnt_hi(~0u, __builtin_amdgcn_mbcnt_lo(~0u, z)); }
DEV int tid512() { int t = hw_wave() * 64 + hw_lane(); asm volatile("" : "+v"(t)); return t; }
DEV int tidx() { int t = (hw_wave() & 3) * 64 + hw_lane(); asm volatile("" : "+v"(t)); return t; }
DEV int vhalf() { int h = hw_wave() >> 2; asm volatile("" : "+s"(h)); return h; }
DEV int vbid() { return (int)blockIdx.x * 2 + vhalf(); }
DEV int vgrid() { return (int)gridDim.x * 2; }
#define GAS __attribute__((address_space(1)))
DEV unsigned char* wsp(const P& p) { GAS unsigned char* w = (GAS unsigned char*)p.ws; asm volatile("" : "+s"(w)); return (unsigned char*)w; }
DEV unsigned pk2(float lo, float hi) { f32x2_t v = {lo, hi}; bf16x2_t b = __builtin_convertvector(v, bf16x2_t); return __builtin_bit_cast(unsigned, b); }
DEV float bflo(unsigned u) { return __builtin_bit_cast(float, u << 16); }
DEV float bfhi(unsigned u) { return __builtin_bit_cast(float, u & 0xffff0000u); }
DEV void unpack8(uint4 q, float* f) { f[0] = bflo(q.x); f[1] = bfhi(q.x); f[2] = bflo(q.y); f[3] = bfhi(q.y); f[4] = bflo(q.z); f[5] = bfhi(q.z); f[6] = bflo(q.w); f[7] = bfhi(q.w); }
DEV unsigned pk4_f8(float a, float b, float c, float d) {
    a = __builtin_amdgcn_fmed3f(a, -448.f, 448.f); b = __builtin_amdgcn_fmed3f(b, -448.f, 448.f); c = __builtin_amdgcn_fmed3f(c, -448.f, 448.f); d = __builtin_amdgcn_fmed3f(d, -448.f, 448.f);
    int w = 0; w = __builtin_amdgcn_cvt_pk_fp8_f32(a, b, w, false); w = __builtin_amdgcn_cvt_pk_fp8_f32(c, d, w, true); return (unsigned)w;
}
DEV uint4 pack8(const float* f) { uint4 q; q.x = pk2(f[0], f[1]); q.y = pk2(f[2], f[3]); q.z = pk2(f[4], f[5]); q.w = pk2(f[6], f[7]); return q; }
#define DPPF(old_, src_, ctrl, rmask, bmask, bc) __int_as_float(__builtin_amdgcn_update_dpp(__float_as_int(old_), __float_as_int(src_), ctrl, rmask, bmask, bc))
DEV float wave_sum(float v) {
    v += DPPF(0.f, v, 0x111, 0xf, 0xf, true); v += DPPF(0.f, v, 0x112, 0xf, 0xf, true); v += DPPF(0.f, v, 0x114, 0xf, 0xf, true); v += DPPF(0.f, v, 0x118, 0xf, 0xf, true);
    v += DPPF(0.f, v, 0x142, 0xa, 0xf, false); v += DPPF(0.f, v, 0x143, 0xc, 0xf, false);
    return __int_as_float(__builtin_amdgcn_readlane(__float_as_int(v), 63));
}
DEV float lane_xor1(float v) { return DPPF(v, v, 0xB1, 0xf, 0xf, false); }
DEV float lane_xor2(float v) { return DPPF(v, v, 0x4E, 0xf, 0xf, false); }
DEV float lane_xor4(float v) { const float a = DPPF(v, v, 0x104, 0xf, 0x5, false); return DPPF(a, v, 0x114, 0xf, 0xA, false); }
DEV float half_max(float v) { const auto r = __builtin_amdgcn_permlane32_swap(__float_as_uint(v), __float_as_uint(v), false, false); return fmaxf(__uint_as_float(r[0]), __uint_as_float(r[1])); }
DEV float half_sum(float v) { const auto r = __builtin_amdgcn_permlane32_swap(__float_as_uint(v), __float_as_uint(v), false, false); return __uint_as_float(r[0]) + __uint_as_float(r[1]); }
DEV float half_mirror(float v) { return DPPF(v, v, 0x141, 0xf, 0xf, false); }
DEV float wave_max_dpp(float v) {
#define WM_STEP(ctrl, rmask) { const int iv_ = __float_as_int(v); v = fmaxf(v, __int_as_float(__builtin_amdgcn_update_dpp(iv_, iv_, ctrl, rmask, 0xf, false))); }
    WM_STEP(0x111, 0xf) WM_STEP(0x112, 0xf) WM_STEP(0x114, 0xf) WM_STEP(0x118, 0xf) WM_STEP(0x142, 0xa) WM_STEP(0x143, 0xc)
#undef WM_STEP
    return __int_as_float(__builtin_amdgcn_readlane(__float_as_int(v), 63));
}
DEV float silu_f(float v) { return v * __builtin_amdgcn_rcpf(1.f + __expf(-v)); }
DEV float sigmoid_f(float v) { return __builtin_amdgcn_rcpf(1.f + __expf(-v)); }
DEV float softplus_f(float v) { return v > 20.f ? v : log1pf(__expf(v)); }

struct RawV { u32x4 q0, q1, q2; };
template <int BN, int NK, class AL, class BL, class EP>
DEV void gemm_tile(unsigned char* lds, AL& al, BL& bl, EP& ep) {
    constexpr int NT = BN / 64;
    constexpr int NBCH = BN / 32;
    constexpr int A_BYTES = 128 * 128, B_BYTES = BN * 128, STAGE = A_BYTES + B_BYTES;
    const int tid = tidx(), lane = tid & 63, wid = tid >> 6, wr = wid >> 1, wc = wid & 1;
    const int kc = tid & 7, r0 = tid >> 3;
    const int wsw = (kc ^ ((r0 >> 1) & 7)) << 4;
    const int rsw = (lane >> 1) & 7, lr = lane & 31, lh = lane >> 5;
    f32x16 acc[2][NT];
#pragma unroll
    for (int mi = 0; mi < 2; ++mi)
#pragma unroll
        for (int ni = 0; ni < NT; ++ni)
#pragma unroll
            for (int e = 0; e < 16; ++e) acc[mi][ni][e] = 0.f;
    RawV xa[2][4], xb[2][NBCH];
#define GT_RAW(set, ks_) do { _Pragma("unroll") for (int i = 0; i < 4; ++i) xa[set][i] = al.raw(i, r0 + 32 * i, (ks_) * 8 + kc); \
                              _Pragma("unroll") for (int i = 0; i < NBCH; ++i) xb[set][i] = bl.raw(i, r0 + 32 * i, (ks_) * 8 + kc); } while (0)
#define GT_PUT(set, ks_, stg) do { unsigned char* da_ = lds + (stg) * STAGE; \
        _Pragma("unroll") for (int i = 0; i < 4; ++i) *(uint4*)(da_ + (r0 + 32 * i) * 128 + wsw) = al.fin(xa[set][i], i, r0 + 32 * i, (ks_) * 8 + kc); \
        _Pragma("unroll") for (int i = 0; i < NBCH; ++i) *(uint4*)(da_ + A_BYTES + (r0 + 32 * i) * 128 + wsw) = bl.fin(xb[set][i], i, r0 + 32 * i, (ks_) * 8 + kc); } while (0)
    GT_RAW(0, 0);
    if (NK > 1) GT_RAW(1, 1);
    ep.pre(tid);
    __syncthreads();
    GT_PUT(0, 0, 0);
    __syncthreads();
#pragma unroll
    for (int ks = 0; ks < NK; ++ks) {
        const int cur = ks & 1;
        if (ks + 2 < NK) GT_RAW(cur, ks + 2);
        const unsigned char* sa = lds + cur * STAGE;
        const unsigned char* sb = sa + A_BYTES;
#pragma unroll
        for (int kk = 0; kk < 4; ++kk) {
            const int co = ((2 * kk + lh) ^ rsw) << 4;
            bf16x8 fa[2], fb[NT];
#pragma unroll
            for (int mi = 0; mi < 2; ++mi) fa[mi] = *(const bf16x8*)(sa + (wr * 64 + mi * 32 + lr) * 128 + co);
#pragma unroll
            for (int ni = 0; ni < NT; ++ni) fb[ni] = *(const bf16x8*)(sb + (wc * (BN / 2) + ni * 32 + lr) * 128 + co);
#pragma unroll
            for (int mi = 0; mi < 2; ++mi)
#pragma unroll
                for (int ni = 0; ni < NT; ++ni) acc[mi][ni] = __builtin_amdgcn_mfma_f32_32x32x16_bf16(fa[mi], fb[ni], acc[mi][ni], 0, 0, 0);
        }
        if (ks + 1 < NK) GT_PUT(cur ^ 1, ks + 1, cur ^ 1);
        __syncthreads();
    }
#undef GT_RAW
#undef GT_PUT
    float* ct = (float*)lds;
#pragma unroll
    for (int mi = 0; mi < 2; ++mi)
#pragma unroll
        for (int ni = 0; ni < NT; ++ni)
#pragma unroll
            for (int e = 0; e < 16; ++e) {
                const int row = wr * 64 + mi * 32 + (e & 3) + 8 * (e >> 2) + 4 * lh;
                const int col = wc * (BN / 2) + ni * 32 + lr;
                ct[row * (BN + 4) + col] = acc[mi][ni][e];
            }
    __syncthreads();
    ep(ct, tid);
}
DEV void ld8f(const float* ct, int off, float* v) {
    const float4 a = *(const float4*)(ct + off), b = *(const float4*)(ct + off + 4);
    v[0] = a.x; v[1] = a.y; v[2] = a.z; v[3] = a.w; v[4] = b.x; v[5] = b.y; v[6] = b.z; v[7] = b.w;
}

namespace g8 {
typedef float f32x4 __attribute__((ext_vector_type(4)));
constexpr int BM = 256, BK = 64, HALF = 128, HTB = HALF * BK * 2, STAGE_BYTES = 8 * HTB;
DEV int lds_byte(int r, int c) { const int st = (r >> 4) * 2 + (c >> 5), rr = r & 15, cc = c & 31, ob = rr * 64 + cc * 2; return st * 1024 + (ob ^ (((ob >> 9) & 1) << 5)); }
DEV void stage_rc(int b, int& R, int& C) { const int st = b / 1024, sb = b % 1024, swz = sb ^ (((sb >> 9) & 1) << 5); R = (st >> 1) * 16 + swz / 64; C = (st & 1) * 32 + (swz % 64) / 2; }
DEV int perm32(int rho) { const int n = rho >> 4, i = rho & 15; return 8 * (i >> 2) + 4 * n + (i & 3); }
struct Unit { const char* a; const char* b0; const char* b1; const void* aux; int row0, col0, nvalid, sub; };
typedef int i32x8 __attribute__((ext_vector_type(8)));
typedef int i32x4 __attribute__((ext_vector_type(4)));
DEV i32x8 cat8(const bf16x8 a, const bf16x8 b) { return __builtin_shufflevector(__builtin_bit_cast(i32x4, a), __builtin_bit_cast(i32x4, b), 0, 1, 2, 3, 4, 5, 6, 7); }
DEV const char* uni(const char* p) { const unsigned long long v = (unsigned long long)p; const unsigned lo = __builtin_amdgcn_readfirstlane((unsigned)v), hi = __builtin_amdgcn_readfirstlane((unsigned)(v >> 32)); return (const char*)(GAS const char*)(((unsigned long long)hi << 32) | lo); }
template <class Epi, class Sched>
DEV void gemm(LAS unsigned char* lds, const Sched& S, const Epi& E, const int nt  , const int ldb  ) {
    const int tid = tid512(), wid = __builtin_amdgcn_readfirstlane(tid >> 6), lane = tid & 63, wr = wid >> 2, wc = wid & 3, fr = lane & 15, fq = lane >> 4;
    unsigned voffB[2];
#pragma unroll
    for (int i = 0; i < 2; ++i) { int R, C; stage_rc(tid * 16 + i * 8192, R, C);
        const int Rb = Sched::P16 ? 64 * (R >> 5) + 16 * ((R >> 2) & 3) + 4 * ((R >> 4) & 1) + (R & 3) : (R & ~31) + perm32(R & 31);
        voffB[i] = (unsigned)(Rb * ldb + C) * 2u; }
    const size_t kstep = (size_t)(BK * 2);
    const unsigned ldsw = (unsigned)wid * 1024u;
    const int swz = lds_byte(fr, fq * 8); const int aS = wr * 8192, bS = wc * 4096;
    const unsigned pko = (unsigned)tid * 32u;
#define G8_PSLOT(sl) ((LAS u32x4*)(lds + STAGE_BYTES + pko) + (sl))
#define G8_AOFF(dst, sl, half) unsigned dst[2]; { const u32x2 _q = *((const LAS u32x2*)G8_PSLOT(sl) + (half)); dst[0] = _q[0]; dst[1] = _q[1]; }
#define G8_SA(b, h) (((b) * 2 + (h)) * HTB)
#define G8_SB(b, h) ((4 + (b) * 2 + (h)) * HTB)
#define G8_STAGE(bufoff, gbase, voff) do { _Pragma("unroll") for (int _i = 0; _i < 2; ++_i) { unsigned _o = (voff)[_i]; asm volatile("" : "+v"(_o));   \
        __builtin_amdgcn_global_load_lds((const unsigned*)((const char*)(gbase) + _o), (LAS unsigned*)(lds + (bufoff) + ldsw + _i * 8192), 16, 0, 0); } } while (0)
#define G8_LDA(dst, b, h) do { _Pragma("unroll") for (int m = 0; m < 4; ++m) _Pragma("unroll") for (int k = 0; k < 2; ++k) dst[m][k] = *(const LAS bf16x8*)(lds + (G8_SA(b, h) + aS) + swz + m * 2048 + k * 1024); } while (0)
#define G8_LDB(dst, b, h) do { _Pragma("unroll") for (int n = 0; n < 2; ++n) _Pragma("unroll") for (int k = 0; k < 2; ++k) dst[n][k] = *(const LAS bf16x8*)(lds + (G8_SB(b, h) + bS) + swz + n * 2048 + k * 1024); } while (0)
#define G8_MMA(ai, bj, At, Bt) do { __builtin_amdgcn_s_setprio(1); _Pragma("unroll") for (int m = 0; m < 4; ++m) _Pragma("unroll") for (int n = 0; n < 2; ++n) { \
        if constexpr (Sched::F8) acc[ai][bj][m][n] = __builtin_amdgcn_mfma_scale_f32_16x16x128_f8f6f4(cat8(Bt[n][0], Bt[n][1]), cat8(At[m][0], At[m][1]), acc[ai][bj][m][n], 0, 0, 0, 0, 0, 0); \
        else { _Pragma("unroll") for (int k = 0; k < 2; ++k) acc[ai][bj][m][n] = __builtin_amdgcn_mfma_f32_16x16x32_bf16(Bt[n][k], At[m][k], acc[ai][bj][m][n], 0, 0, 0); } } __builtin_amdgcn_s_setprio(0); } while (0)
#define G8_WAIT_V(n) asm volatile("s_waitcnt vmcnt(" #n ")" ::: "memory")
#define G8_WAIT_L(n) asm volatile("s_waitcnt lgkmcnt(" #n ")" ::: "memory")
#define G8_BAR __builtin_amdgcn_s_barrier()
#define G8_SCHED __builtin_amdgcn_sched_barrier(0)
    Unit cur, nxt; int ui = 0;
    if (!S.next(0, cur)) return;
    f32x4 acc[2][2][4][2];
#pragma unroll
    for (int a = 0; a < 2; ++a)
#pragma unroll
        for (int b = 0; b < 2; ++b)
#pragma unroll
            for (int m = 0; m < 4; ++m)
#pragma unroll
                for (int n = 0; n < 2; ++n) acc[a][b][m][n] = (f32x4){0.f, 0.f, 0.f, 0.f};
    bf16x8 At[4][2], B0[2][2], B1[2][2];
    unsigned va0[2], va1x[2];
    S.a_off(cur, va0, va1x);
    unsigned (&va1)[2] = Sched::GATHER ? va1x : va0;
    if constexpr (Sched::GATHER) *G8_PSLOT(0) = (u32x4){va0[0], va0[1], va1x[0], va1x[1]};
    const char* cA0 = uni(cur.a); const char* cA1 = uni(cur.a + S.a_half());
    const char* cB0 = uni(cur.b0); const char* cB1 = uni(cur.b1);
    G8_STAGE(G8_SB(0, 0), cB0, voffB); G8_STAGE(G8_SB(0, 1), cB1, voffB); G8_STAGE(G8_SA(0, 0), cA0, va0); G8_STAGE(G8_SA(0, 1), cA1, va1);
    if (wr == 1) G8_BAR;
    G8_WAIT_V(2); G8_BAR;
    G8_STAGE(G8_SB(1, 0), uni(cB0 + kstep), voffB); G8_STAGE(G8_SA(1, 0), uni(cA0 + kstep), va0); G8_STAGE(G8_SB(1, 1), uni(cB1 + kstep), voffB);
    G8_WAIT_V(6); G8_BAR;
    for (;;) {
        const bool has_next = S.next(ui + 1, nxt);
        if constexpr (Sched::GATHER) {
            if (!has_next) nxt = cur;
            unsigned n0[2], n1[2];
            S.a_off(nxt, n0, n1);
            *G8_PSLOT((ui + 1) & 1) = (u32x4){n0[0], n0[1], n1[0], n1[1]};
        }
        const char* nA0 = has_next ? nxt.a : cA0 - 0; const char* nB0 = has_next ? nxt.b0 : cB0; const char* nB1 = has_next ? nxt.b1 : cB1;
        if (!has_next) nA0 = cur.a;
        const char* nA1 = nA0 + S.a_half();
        for (int t = 0; t < nt; t += 2) {
            const bool last = (t == nt - 2);
            if constexpr (Epi::MID_T > 0) { if (t == Epi::MID_T) E.mid(acc, cur, wr, fr); }
            const char* a11 = uni(cA1 + (size_t)(t + 1) * kstep);
            const char* a20 = uni(last ? nA0 : cA0 + (size_t)(t + 2) * kstep); const char* a21 = uni(last ? nA1 : cA1 + (size_t)(t + 2) * kstep);
            const char* b20 = uni(last ? nB0 : cB0 + (size_t)(t + 2) * kstep); const char* b21 = uni(last ? nB1 : cB1 + (size_t)(t + 2) * kstep);
            const char* a30 = uni(a20 + kstep); const char* b30 = uni(b20 + kstep); const char* b31 = uni(b21 + kstep);
            const int slc = ui & 1, sln = last ? (slc ^ 1) : slc;
#define G8_STAGE_A(bufoff, gbase, sl, half) do { if constexpr (Sched::GATHER) { G8_AOFF(_ao, sl, half); G8_STAGE(bufoff, gbase, _ao); } else { G8_STAGE(bufoff, gbase, va0); } } while (0)
            G8_LDB(B0, 0, 0); G8_LDB(B1, 0, 1); G8_SCHED; G8_LDA(At, 0, 0); G8_STAGE_A(G8_SA(1, 1), a11, slc, 1);
            G8_WAIT_V(8); G8_WAIT_L(0); G8_BAR; G8_MMA(0, 0, At, B0); G8_MMA(0, 1, At, B1); G8_BAR; G8_SCHED;
            G8_LDA(At, 0, 1); G8_STAGE(G8_SB(0, 0), b20, voffB); G8_STAGE(G8_SB(0, 1), b21, voffB); G8_STAGE_A(G8_SA(0, 0), a20, sln, 0);
            G8_WAIT_V(8); G8_WAIT_L(0); G8_BAR; G8_MMA(1, 0, At, B0); G8_MMA(1, 1, At, B1); G8_BAR; G8_SCHED;
            G8_LDB(B0, 1, 0); G8_LDB(B1, 1, 1); G8_SCHED; G8_LDA(At, 1, 0); G8_STAGE_A(G8_SA(0, 1), a21, sln, 1);
            G8_WAIT_V(8); G8_WAIT_L(0); G8_BAR; G8_MMA(0, 0, At, B0); G8_MMA(0, 1, At, B1); G8_BAR; G8_SCHED;
            G8_LDA(At, 1, 1); G8_STAGE(G8_SB(1, 0), b30, voffB); G8_STAGE(G8_SB(1, 1), b31, voffB); G8_STAGE_A(G8_SA(1, 0), a30, sln, 0);
            G8_WAIT_V(8); G8_WAIT_L(0); G8_BAR; G8_MMA(1, 0, At, B0); G8_MMA(1, 1, At, B1); G8_BAR; G8_SCHED;
#undef G8_STAGE_A
        }
        if (wr == 0) G8_BAR;
        { const int l2 = hw_lane(); E(acc, cur, wr, wc, l2 & 15, l2 >> 4); }
        if (!has_next) break;
#pragma unroll
        for (int a = 0; a < 2; ++a)
#pragma unroll
            for (int b = 0; b < 2; ++b)
#pragma unroll
                for (int m = 0; m < 4; ++m)
#pragma unroll
                    for (int n = 0; n < 2; ++n) acc[a][b][m][n] = (f32x4){0.f, 0.f, 0.f, 0.f};
        cur = nxt; cA0 = nA0; cA1 = nA1; cB0 = nB0; cB1 = nB1; ++ui;
        if (wr == 1) G8_BAR;
    }
    G8_WAIT_V(0);
    G8_BAR;
#undef G8_PSLOT
#undef G8_AOFF
#undef G8_SA
#undef G8_SB
#undef G8_STAGE
#undef G8_LDA
#undef G8_LDB
#undef G8_MMA
#undef G8_WAIT_V
#undef G8_WAIT_L
#undef G8_BAR
#undef G8_SCHED
}
DEV int deal(int i, int G, int c, int nwg) {
    const long L = (long)i * G + c; if (L >= nwg) return -1;
    const int w = (int)L, q = nwg / 8, r = nwg % 8, xcd = w % 8, off = w / 8;
    return (xcd < r ? xcd * (q + 1) : r * (q + 1) + (xcd - r) * q) + off;
}
struct EpiStore {
    static constexpr int MID_T = 0;
    bf16_t* O; int ld;
    DEV void operator()(const f32x4 (&acc)[2][2][4][2], const Unit& u, int wr, int wc, int fr, int fq) const {
#pragma unroll
        for (int ai = 0; ai < 2; ++ai)
#pragma unroll
            for (int m = 0; m < 4; ++m) {
                const int r = ai * HALF + wr * 64 + m * 16 + fr;
                if (r < u.nvalid) {
                    bf16_t* rowp = O + (size_t)(u.row0 + r) * ld + u.col0 + wc * 32 + 8 * fq;
#pragma unroll
                    for (int bj = 0; bj < 2; ++bj) {
                        const f32x4 v0 = acc[ai][bj][m][0], v1 = acc[ai][bj][m][1];
                        *(u32x4*)(rowp + bj * HALF) = (u32x4){pk2(v0[0], v0[1]), pk2(v0[2], v0[3]), pk2(v1[0], v1[1]), pk2(v1[2], v1[3])};
                    }
                }
            }
    }
};
struct EpiStore8 {
    static constexpr int MID_T = 0;
    unsigned char* O; int ld; float sc;
    DEV void operator()(const f32x4 (&acc)[2][2][4][2], const Unit& u, int wr, int wc, int fr, int fq) const {
#pragma unroll
        for (int ai = 0; ai < 2; ++ai)
#pragma unroll
            for (int m = 0; m < 4; ++m) {
                const int r = ai * HALF + wr * 64 + m * 16 + fr;
                if (r < u.nvalid) {
                    unsigned char* rowp = O + (size_t)(u.row0 + r) * ld + u.col0 + wc * 64 + 16 * fq;
                    unsigned w4[4];
#pragma unroll
                    for (int bj = 0; bj < 2; ++bj) {
                        const f32x4 v0 = acc[ai][bj][m][0] * sc, v1 = acc[ai][bj][m][1] * sc;
                        w4[2 * bj] = pk4_f8(v0[0], v0[1], v0[2], v0[3]); w4[2 * bj + 1] = pk4_f8(v1[0], v1[1], v1[2], v1[3]);
                    }
                    *(u32x4*)rowp = (u32x4){w4[0], w4[1], w4[2], w4[3]};
                }
            }
    }
};
struct SchedDense {
    static constexpr bool GATHER = false, F8 = false, P16 = false;
    const bf16_t* A; const bf16_t* Bt; int lda, ldb, nM, nN, G, c;
    DEV bool next(int i, Unit& u) const {
        const int w = deal(i, G, c, nM * nN); if (w < 0) return false;
        const int nig = 8 * nN, gid = w / nig, fm = gid * 8, gsz = (nM - fm) < 8 ? (nM - fm) : 8;
        const int pm = fm + ((w % nig) % gsz), pn = (w % nig) / gsz;
        u.a = (const char*)(A + (size_t)pm * BM * lda); u.b0 = (const char*)(Bt + (size_t)pn * BM * ldb); u.b1 = u.b0 + (size_t)HALF * ldb * 2;
        u.aux = nullptr; u.row0 = pm * BM; u.col0 = pn * BM; u.nvalid = BM; u.sub = 0; return true;
    }
    DEV size_t a_half() const { return (size_t)HALF * lda * 2; }
    DEV void a_off(const Unit&, unsigned (&v0)[2], unsigned (&v1)[2]) const {
        const int tz = tid512();
#pragma unroll
        for (int i = 0; i < 2; ++i) { int R, C; stage_rc(tz * 16 + i * 8192, R, C); v0[i] = (unsigned)(R * lda + C) * 2u; v1[i] = v0[i]; }
    }
};
}

DEV uint4 as_uint4(const u32x4 q) { return make_uint4(q[0], q[1], q[2], q[3]); }
struct LdRows {
    const bf16_t* base; size_t ld; int cs;
    DEV RawV raw(int, int r, int kcg) const { RawV x; x.q0 = *(const u32x4*)(base + (size_t)r * ld + kcg * cs); return x; }
    DEV uint4 fin(const RawV& x, int, int, int) const { return as_uint4(x.q0); }
};
struct EpStoreBf16 {
    bf16_t* O;
    DEV void pre(int) {}
    DEV void operator()(const float* ct, int tid) const {
#pragma unroll
        for (int i = 0; i < 8; ++i) {
            const int id = tid + 256 * i, c8 = id >> 7, r = id & 127;
            float v[8]; ld8f(ct, r * 132 + c8 * 8, v);
            *(uint4*)(O + (size_t)(r >> 6) * 8192 + c8 * 512 + (r & 63) * 8) = pack8(v);
        }
    }
};

struct Strip { const float* src; unsigned char* dst; const float* rscale; int ld_src, ld_dst; float f8; };
DEV void strip_of(const P& p, int layer, int it, Strip& st) {
    bf16_t* WIN = (bf16_t*)(wsp(p) + WS_WIN); bf16_t* WOUT = (bf16_t*)(wsp(p) + WS_WOUT);
    bf16_t* WG = (bf16_t*)(wsp(p) + WS_WG); bf16_t* WU = (bf16_t*)(wsp(p) + WS_WU); bf16_t* WD = (bf16_t*)(wsp(p) + WS_WD);
    constexpr int T0 = 144, T1 = T0 + 64, T2 = T1 + 1024, T3 = T2 + 1024, T4 = T3 + 1024, T5 = T4 + 16, T6 = T5 + 16;
    const float* src; bf16_t* dst; int ls, ld, r0, c0, rd0 = -1; st.rscale = nullptr;
    const bool f8 = it >= T1;
    unsigned char* WG8 = (unsigned char*)WG; unsigned char* WU8 = (unsigned char*)WU; unsigned char* WD8 = (unsigned char*)WD; unsigned char* dst8 = nullptr;
    if (it < T0) { r0 = (it / 9) * 64; c0 = (it % 9) * 256; src = p.w_in + (size_t)layer * DM * NINF; ls = NINF; dst = WIN; ld = DM; }
    else if (it < T1) { const int ti = it - T0, rt = ti >> 2; r0 = rt * 64; c0 = (ti & 3) * 256; src = p.w_out + (size_t)layer * DM * DM; ls = DM; dst = WOUT; ld = DM;
        rd0 = (r0 + 512) & 1023; if (rt >= 8) st.rscale = p.ssd_norm + layer * 512 + (rt - 8) * 64; }
    else if (it < T2) { const int ti = it - T1, e = ti >> 4; r0 = (ti & 15) * 64; c0 = 0; src = p.w_gate + ((size_t)layer * 64 + e) * DM * FE; ls = FE; dst = nullptr; dst8 = WG8 + (size_t)e * FE * DM; ld = DM; }
    else if (it < T3) { const int ti = it - T2, e = ti >> 4; r0 = (ti & 15) * 64; c0 = 0; src = p.w_up + ((size_t)layer * 64 + e) * DM * FE; ls = FE; dst = nullptr; dst8 = WU8 + (size_t)e * FE * DM; ld = DM; }
    else if (it < T4) { const int ti = it - T3, e = ti >> 4; r0 = ((ti >> 2) & 3) * 64; c0 = (ti & 3) * 256; src = p.w_down + ((size_t)layer * 64 + e) * FE * DM; ls = DM; dst = nullptr; dst8 = WD8 + (size_t)e * DM * FE; ld = FE; }
    else if (it < T5) { r0 = (it - T4) * 64; c0 = 0; src = p.ws_gate + (size_t)layer * DM * FE; ls = FE; dst = nullptr; dst8 = WG8 + (size_t)64 * FE * DM; ld = DM; }
    else if (it < T6) { r0 = (it - T5) * 64; c0 = 0; src = p.ws_up + (size_t)layer * DM * FE; ls = FE; dst = nullptr; dst8 = WU8 + (size_t)64 * FE * DM; ld = DM; }
    else { const int ti = it - T6; r0 = (ti >> 2) * 64; c0 = (ti & 3) * 256; src = p.ws_down + (size_t)layer * FE * DM; ls = DM; dst = nullptr; dst8 = WD8 + (size_t)64 * DM * FE; ld = FE; }
    if (rd0 < 0) rd0 = r0;
    st.src = src + (size_t)r0 * ls + c0; st.dst = f8 ? dst8 + (size_t)c0 * ld + rd0 : (unsigned char*)(dst + (size_t)c0 * ld + rd0); st.ld_src = ls; st.ld_dst = ld; st.f8 = !f8 ? 0.f : (ld == FE ? WD8_SCALE : W8_SCALE);
}
DEV const char* uni_ptr(const void* p) { const unsigned long long v = (unsigned long long)p; const unsigned lo = __builtin_amdgcn_readfirstlane((unsigned)v), hi = __builtin_amdgcn_readfirstlane((unsigned)(v >> 32)); return (const char*)(GAS const char*)(((unsigned long long)hi << 32) | lo); }
DEV void strip_load(const Strip& st, int tid, float4 (&v)[16]) {
    const char* sb = uni_ptr(st.src);
    unsigned off = (unsigned)((tid >> 6) * st.ld_src + (tid & 63) * 4) * 4u; const unsigned step = (unsigned)st.ld_src * 16u;
#pragma unroll
    for (int i = 0; i < 16; ++i) { const f32x4v q = __builtin_nontemporal_load((const f32x4v*)(sb + off)); v[i] = make_float4(q[0], q[1], q[2], q[3]); off += step; }
}
DEV void strip_park(float* t, int tid, const float4 (&v)[16]) {
    const int lane = tid & 63, rot = (lane >> 3) & 3;
    float* base = t + (tid >> 6) * 257 + 4 * lane;
    const int o0 = rot, o1 = (rot + 1) & 3, o2 = (rot + 2) & 3, o3 = (rot + 3) & 3;
#pragma unroll
    for (int i = 0; i < 16; ++i) {
        float a = v[i].x, b = v[i].y, c = v[i].z, d = v[i].w;
        if (rot & 1) { const float t0 = a; a = b; b = c; c = d; d = t0; }
        if (rot & 2) { const float t0 = a, t1 = b; a = c; b = d; c = t0; d = t1; }
        float* q = base + i * 4 * 257;
        q[o0] = a; q[o1] = b; q[o2] = c; q[o3] = d;
    }
}
DEV void strip_emit(const float* t, int tid, const Strip& cur) {
#pragma unroll
    for (int i = 0; i < 8; ++i) {
        const int idx = tid + 256 * i, c = idx >> 3, r8 = (idx & 7) * 8;
        float o[8];
#pragma unroll
        for (int e = 0; e < 8; ++e) o[e] = t[(r8 + e) * 257 + c] * (cur.rscale ? cur.rscale[r8 + e] : 1.f);
        if (cur.f8 != 0.f) { const float sc = cur.f8; *(uint2*)(cur.dst + (size_t)c * cur.ld_dst + r8) = make_uint2(pk4_f8(o[0] * sc, o[1] * sc, o[2] * sc, o[3] * sc), pk4_f8(o[4] * sc, o[5] * sc, o[6] * sc, o[7] * sc)); }
        else *(uint4*)((bf16_t*)cur.dst + (size_t)c * cur.ld_dst + r8) = pack8(o);
    }
}
DEV int strip_index(int part, int i) {
    if (part == 0) return i < 208 ? i : (i < 208 + 1024 ? 2256 + (i - 208) : 3312 + (i - 1232));
    return i < 2048 ? 208 + i : 3280 + (i - 2048);
}
DEV void strips_loop(const P& p, int layer, unsigned char* lds, int id0, int n, int stride, int part) {
    float* t = (float*)lds;
    const int tid = tidx();
    Strip cur, nxt; float4 v[16];
    if (n > 0) { strip_of(p, layer, part < 0 ? id0 : strip_index(part, id0), cur); strip_load(cur, tid, v); }
    for (int k = 0; k < n; ++k) {
        __syncthreads();
        strip_park(t, tid, v);
        const bool more = k + 1 < n;
        if (more) { const int id = id0 + (k + 1) * stride; strip_of(p, layer, part < 0 ? id : strip_index(part, id), nxt); strip_load(nxt, tid, v); }
        __syncthreads();
        strip_emit(t, tid, cur);
        if (more) cur = nxt;
    }
}
constexpr int CW_QH = 8192, NQ_PAIRS = (3328 - 208) / 2;
DEV void fill_strips(const P& p, unsigned char* lds, int budget) {
    volatile LAS int* bc = (volatile LAS int*)(smem_all + LDS_QB);
    unsigned* qh = (unsigned*)(wsp(p) + WS_CTL) + CW_QH;
    const int want = budget < 0 ? 2 : budget;
    for (;;) {
        __syncthreads();
        if (tid512() == 0) *bc = (int)__hip_atomic_fetch_add(qh, (unsigned)want, __ATOMIC_RELAXED, __HIP_MEMORY_SCOPE_AGENT);
        __syncthreads();
        const int q0 = __builtin_amdgcn_readfirstlane(*bc);
        if (q0 >= NQ_PAIRS) break;
        const int n = min(want, NQ_PAIRS - q0);
        strips_loop(p, 0, lds, 208 + 2 * q0 + vhalf(), n, 2, -1);
        if (budget >= 0) break;
    }
}
DEV void phase_p0(const P& p, int layer, unsigned char* lds, int part, bool extras, int nlimit = -1) {
    constexpr int T7 = 3328;
    const int nstrip = nlimit >= 0 ? nlimit : (part == 0 ? 1248 : (part == 1 ? 2080 : 208));
    const int nextra = extras ? (192 + 256 + 128 + 32) : 0;
    { const int v0 = vbid(); const int n = v0 < nstrip ? (nstrip - v0 + vgrid() - 1) / vgrid() : 0; strips_loop(p, layer, lds, v0, n, vgrid(), part == 2 ? 0 : part); }
    for (int it = T7 + (vbid() + vgrid() - (nstrip % vgrid())) % vgrid(); it < T7 + nextra; it += vgrid()) {
        if (false) {}
        else if (it < T7 + 192) {
            const int mi = it - T7, l = mi / 96, cg = mi % 96, tid = tidx(), lane = tid & 63, wid = tid >> 6;
            float* sc = (float*)lds;
            float* part = sc + 9 * 1024;
            __syncthreads();
            for (int i = tid; i < 9 * 1024; i += 256) { const float v = (i < 8192) ? p.c[i] : p.c_ctx[i - 8192]; sc[i] = silu_f(v); }
            __syncthreads();
            float a9[9];
#pragma unroll
            for (int r = 0; r < 9; ++r) a9[r] = 0.f;
            const float* wm = p.w_mod + (size_t)l * DM * 6144 + cg * 64 + lane;
#pragma unroll 1
            for (int k0 = wid * 256; k0 < wid * 256 + 256; k0 += 16) {
                float w[16];
#pragma unroll
                for (int j = 0; j < 16; ++j) w[j] = wm[(size_t)(k0 + j) * 6144];
#pragma unroll
                for (int j = 0; j < 16; ++j)
#pragma unroll
                    for (int r = 0; r < 9; ++r) a9[r] += sc[r * 1024 + k0 + j] * w[j];
            }
#pragma unroll
            for (int r = 0; r < 9; ++r) part[(wid * 9 + r) * 64 + lane] = a9[r];
            __syncthreads();
            float* MOD = (float*)(wsp(p) + WS_MOD);
            for (int i = tid; i < 9 * 64; i += 256) {
                const int r = i >> 6, j = i & 63;
                const float s = ((part[(0 * 9 + r) * 64 + j] + part[(1 * 9 + r) * 64 + j]) + part[(2 * 9 + r) * 64 + j]) + part[(3 * 9 + r) * 64 + j];
                const float v = s + p.b_mod[l * 6144 + cg * 64 + j];
                const int T = cg >> 4, c = (cg & 15) * 64 + j;
                float o = v;
                if (T == 1) o = p.g_pre_mix[l * DM + c] * (1.f + v);
                if (T == 2) o = v * p.g_post_mix[l * DM + c];
                if (T == 4) o = p.g_pre_ffn[l * DM + c] * (1.f + v);
                if (T == 5) o = v * p.g_post_ffn[l * DM + c];
                MOD[((size_t)l * 9 + r) * 6144 + cg * 64 + j] = o;
            }
        } else if (it >= T7 + 192 + 256) {
            const int idx = (it - T7 - 192 - 256) * 256 + tidx();
            if (idx < 32768) {
                const int l = idx >> 14, wid = (idx >> 12) & 3, q = (idx >> 6) & 63, lane = idx & 63;
                const float* src = p.router_w + (size_t)l * DM * NEXP + (size_t)(16 * q + 4 * (lane >> 4)) * NEXP + 16 * wid + (lane & 15);
                ((float4*)(wsp(p) + WS_RW2))[idx] = make_float4(src[0], src[NEXP], src[2 * NEXP], src[3 * NEXP]);
            } else {
                const int id2 = idx - 32768, l = id2 >> 12, wid = (id2 >> 10) & 3, q = (id2 >> 6) & 15, lane = id2 & 63;
                const float* src = p.w_in + (size_t)l * DM * NINF + (size_t)(256 * wid + 16 * q + 4 * (lane >> 4)) * NINF + NIN + (lane & 15);
                ((float4*)(wsp(p) + WS_WD2))[id2] = make_float4(src[0], src[NINF], src[2 * NINF], src[3 * NINF]);
            }
        } else {
            const int idx = (it - T7 - 192) * 256 + tidx(), pos = idx >> 5, i = idx & 31, f = i & 15;
            const float inv = powf(10000.f, -(float)f / 16.f);
            const float ang = (float)((i < 16) ? (pos >> 6) : (pos & 63)) * inv;
            float2* ROPE = (float2*)(wsp(p) + WS_ROPE);
            ROPE[idx] = make_float2(cosf(ang), sinf(ang));
        }
    }
}

DEV void ld_row16(const float* row, int lane, float* v) {
#pragma unroll
    for (int i = 0; i < 4; ++i) { const float4 q = *(const float4*)(row + 4 * lane + 256 * i); v[4 * i] = q.x; v[4 * i + 1] = q.y; v[4 * i + 2] = q.z; v[4 * i + 3] = q.w; }
}
DEV void st_row16(float* row, int lane, const float* v) {
#pragma unroll
    for (int i = 0; i < 4; ++i) *(float4*)(row + 4 * lane + 256 * i) = make_float4(v[4 * i], v[4 * i + 1], v[4 * i + 2], v[4 * i + 3]);
}
DEV void ld_row16_bf(const bf16_t* row, int lane, float* v) {
#pragma unroll
    for (int i = 0; i < 4; ++i) { const uint2 q = *(const uint2*)(row + 4 * lane + 256 * i); v[4 * i] = bflo(q.x); v[4 * i + 1] = bfhi(q.x); v[4 * i + 2] = bflo(q.y); v[4 * i + 3] = bfhi(q.y); }
}
DEV void st_row16_bf(bf16_t* row, int lane, const float* v) {
#pragma unroll
    for (int i = 0; i < 4; ++i) *(uint2*)(row + 4 * lane + 256 * i) = make_uint2(pk2(v[4 * i], v[4 * i + 1]), pk2(v[4 * i + 2], v[4 * i + 3]));
}
DEV float rstd16(const float* v) {
    float s = 0.f;
#pragma unroll
    for (int e = 0; e < 16; ++e) s += v[e] * v[e];
    s = wave_sum(s);
    return rsqrtf(s * (1.f / 1024.f) + EPS);
}
constexpr int HLS = 1028;
constexpr int HL_BYTES = 16 * HLS * 4;
DEV f32x4v mfma4(const float4 a, const float4 b, f32x4v acc) {
    acc = __builtin_amdgcn_mfma_f32_16x16x4f32(a.x, b.x, acc, 0, 0, 0); acc = __builtin_amdgcn_mfma_f32_16x16x4f32(a.y, b.y, acc, 0, 0, 0);
    acc = __builtin_amdgcn_mfma_f32_16x16x4f32(a.z, b.z, acc, 0, 0, 0); acc = __builtin_amdgcn_mfma_f32_16x16x4f32(a.w, b.w, acc, 0, 0, 0);
    return acc;
}
template <int RPW> DEV void dt_tail16(const float* hl, const float4* wd2  , const float* bias, float* part, float* DT, int tok0, int tid) {
    const int lane = tid & 63, wid = tid >> 6, ar = lane & 15, kq = lane >> 4;
    f32x4v acc = {0.f, 0.f, 0.f, 0.f};
    const float* ap = hl + ar * HLS + wid * 256 + 4 * kq;
    const float4* bp = wd2 + (size_t)wid * 16 * 64 + lane;
#pragma unroll 8
    for (int q = 0; q < 16; ++q) acc = mfma4(*(const float4*)(ap + 16 * q), bp[q * 64], acc);
#pragma unroll
    for (int e = 0; e < 4; ++e) part[(wid * 16 + kq * 4 + e) * 16 + ar] = acc[e];
    __syncthreads();
    const int r = tid >> 4, j = tid & 15;
    const float v = ((part[(0 * 16 + r) * 16 + j] + part[(1 * 16 + r) * 16 + j]) + part[(2 * 16 + r) * 16 + j]) + part[(3 * 16 + r) * 16 + j];
    if (r < 4 * RPW) DT[(size_t)(tok0 + r) * 16 + j] = softplus_f(v + bias[j]);
}
template <int RPW> DEV void phase_pa0(const P& p, unsigned char* lds, int row0, int nrows) {
    const int tid = tidx(), lane = tid & 63, wid = tid >> 6;
    const float* MOD = (const float*)(wsp(p) + WS_MOD);
    bf16_t* H = (bf16_t*)(wsp(p) + WS_H); float* DT = (float*)(wsp(p) + WS_DT);
    float* hl = (float*)lds; float* part = (float*)(lds + HL_BYTES);
    for (int task = vbid(); task < nrows / (4 * RPW); task += vgrid()) {
        const int tok0 = row0 + task * (4 * RPW) + wid * RPW;
        const float* xb = tok0 < TL ? p.x + (size_t)tok0 * DM : p.ctx + (size_t)(tok0 - TL) * DM;
        const float* md = MOD + (size_t)(tok0 < TL ? tok0 / SEQ : 8) * 6144;
        float x[RPW][16], pb[16], pc[16];
#pragma unroll
        for (int rr = 0; rr < RPW; ++rr) ld_row16(xb + (size_t)rr * DM, lane, x[rr]);
        ld_row16(md + 1024, lane, pb); ld_row16(md + 0, lane, pc);
        __syncthreads();
#pragma unroll
        for (int rr = 0; rr < RPW; ++rr) {
            const float rs = rstd16(x[rr]);
            float h[16];
#pragma unroll
            for (int e = 0; e < 16; ++e) h[e] = x[rr][e] * rs * pb[e] + pc[e];
            st_row16_bf(H + (size_t)(tok0 + rr) * DM, lane, h);
            st_row16(hl + (wid * RPW + rr) * HLS, lane, h);
        }
        __syncthreads();
        dt_tail16<RPW>(hl, (const float4*)(wsp(p) + WS_WD2), p.dt_bias, part, DT, row0 + task * (4 * RPW), tid);
    }
}
template <int RPW> DEV void phase_pi(const P& p, int layer, unsigned char* lds, int row0, int nrows) {
    const int tid = tidx(), lane = tid & 63, wid = tid >> 6;
    const float* MOD = (const float*)(wsp(p) + WS_MOD);
    const bf16_t* ML = (const bf16_t*)(wsp(p) + WS_ML);
    bf16_t* XB = (bf16_t*)(wsp(p) + WS_XB);
    bf16_t* H = (bf16_t*)(wsp(p) + WS_H);
    unsigned* TOPK = (unsigned*)(wsp(p) + WS_TOPK);
    uint2* LIST = (uint2*)(wsp(p) + WS_LIST);
    unsigned* cnt = (unsigned*)(wsp(p) + WS_CTL) + CW_CNT + layer * CNT_LAYER;
    float* hl = (float*)lds; float* lgl = (float*)(lds + HL_BYTES);
    unsigned* lcnt = (unsigned*)(lds + HL_BYTES + 4096); unsigned* lbase = lcnt + 64;
    if (tid < 64) lcnt[tid] = 0u;
    const float4* rw2 = (const float4*)(wsp(p) + WS_RW2) + (size_t)layer * 16384 + (size_t)wid * 4096 + lane;
    const float rbias = p.router_bias[layer * NEXP + lane];
    for (int task = vbid(); task < nrows / (4 * RPW); task += vgrid()) {
        const int tok0 = row0 + task * (4 * RPW) + wid * RPW;
        const float* xin = tok0 < TL ? p.x + (size_t)tok0 * DM : p.ctx + (size_t)(tok0 - TL) * DM;
        bf16_t* xout = XB + (size_t)tok0 * DM;
        const float* md = MOD + ((size_t)layer * 9 + (tok0 < TL ? tok0 / SEQ : 8)) * 6144;
        float pa[16], pb[16], pc[16];
        ld_row16(md + 2048, lane, pa); ld_row16(md + 4096, lane, pb); ld_row16(md + 3072, lane, pc);
        __syncthreads();
#pragma unroll 1
        for (int hp = 0; hp < 2; ++hp) {
            float x[2][16]; uint2 yp[2][4];
#pragma unroll
            for (int r2 = 0; r2 < 2; ++r2) {
                const int rr = hp * 2 + r2;
                if (rr < RPW) {
                    if (layer == 0) ld_row16(xin + (size_t)rr * DM, lane, x[r2]); else ld_row16_bf(xout + (size_t)rr * DM, lane, x[r2]);
#pragma unroll
                    for (int i = 0; i < 4; ++i) yp[r2][i] = *(const uint2*)(ML + (size_t)(tok0 + rr) * DM + 4 * lane + 256 * i);
                }
            }
#pragma unroll
            for (int r2 = 0; r2 < 2; ++r2) {
                const int rr = hp * 2 + r2;
                if (rr >= RPW) continue;
                float y[16];
#pragma unroll
                for (int i = 0; i < 4; ++i) { y[4 * i] = bflo(yp[r2][i].x); y[4 * i + 1] = bfhi(yp[r2][i].x); y[4 * i + 2] = bflo(yp[r2][i].y); y[4 * i + 3] = bfhi(yp[r2][i].y); }
                const float rsy = rstd16(y);
#pragma unroll
                for (int e = 0; e < 16; ++e) x[r2][e] += pa[e] * (y[e] * rsy);
                st_row16_bf(xout + (size_t)rr * DM, lane, x[r2]);
                const float rs = rstd16(x[r2]);
                float h[16];
#pragma unroll
                for (int e = 0; e < 16; ++e) h[e] = x[r2][e] * rs * pb[e] + pc[e];
                {
                    unsigned char* h8 = (unsigned char*)H + (size_t)(tok0 + rr) * DM + 4 * lane;
#pragma unroll
                    for (int i = 0; i < 4; ++i) *(unsigned*)(h8 + 256 * i) = pk4_f8(h[4 * i] * H8_SCALE, h[4 * i + 1] * H8_SCALE, h[4 * i + 2] * H8_SCALE, h[4 * i + 3] * H8_SCALE);
                }
                st_row16(hl + (wid * RPW + rr) * HLS, lane, h);
            }
        }
        __syncthreads();
        {
            const int ar = lane & 15, kq = lane >> 4, hf = vhalf();
            const float* hmine = hl; const float* hother = (const float*)(smem_all + (1 - hf) * LDS_HALF);
            float* lgo = (float*)(smem_all + (1 - hf) * LDS_HALF + HL_BYTES);
            f32x4v acc = {0.f, 0.f, 0.f, 0.f}, acf = {0.f, 0.f, 0.f, 0.f};
            const float* ap = hmine + ar * HLS + 4 * kq + 512 * hf; const float* af = hother + ar * HLS + 4 * kq + 512 * hf;
            const float4* rwh = rw2 + 32 * 64 * hf;
#pragma unroll 32
            for (int q = 0; q < 32; ++q) { const float4 w = rwh[q * 64]; acc = mfma4(*(const float4*)(ap + 16 * q), w, acc); acf = mfma4(*(const float4*)(af + 16 * q), w, acf); }
#pragma unroll
            for (int e = 0; e < 4; ++e) lgo[(kq * 4 + e) * 64 + wid * 16 + ar] = acf[e];
            __syncthreads();
#pragma unroll
            for (int e = 0; e < 4; ++e) lgl[(kq * 4 + e) * 64 + wid * 16 + ar] += acc[e];
        }
        __syncthreads();
        unsigned selm = 0; float gatev[RPW]; int posv[RPW]; unsigned lrk[RPW];
#pragma unroll
        for (int rr = 0; rr < RPW; ++rr) {
            const float score = sigmoid_f(lgl[(wid * RPW + rr) * 64 + lane]), choice = score + rbias;
            float g1 = fmaxf(choice, lane_xor1(choice)); g1 = fmaxf(g1, lane_xor2(g1)); g1 = fmaxf(g1, half_mirror(g1));
            const unsigned gb = (unsigned)(__ballot(choice == g1) >> (lane & ~7)) & 0xffu;
            float g2 = ((lane & 7) == __builtin_ctz(gb)) ? -INFINITY : choice;
            g2 = fmaxf(g2, lane_xor1(g2)); g2 = fmaxf(g2, lane_xor2(g2)); g2 = fmaxf(g2, half_mirror(g2));
            const float gs = g1 + g2;
            bool ok = false;
            {
                float cg = gs;
#pragma unroll
                for (int it = 0; it < 4; ++it) {
                    const float mx = wave_max_dpp(cg);
                    const int wg = __builtin_ctzll(__ballot(cg == mx)) >> 3;
                    if ((lane >> 3) == wg) { ok = true; cg = -INFINITY; }
                }
            }
            const float m = ok ? choice : -INFINITY;
            bool sel = false;
            {
                float cur = m;
#pragma unroll
                for (int it = 0; it < 8; ++it) {
                    const float mx = wave_max_dpp(cur);
                    const unsigned long long eq = __ballot(cur == mx);
                    const int win = __builtin_ctzll(eq);
                    if (lane == win) { sel = true; cur = -INFINITY; }
                }
            }
            const float wsum = wave_sum(sel ? score : 0.f);
            const unsigned long long bal = __ballot(sel);
            gatev[rr] = score * __builtin_amdgcn_rcpf(wsum) * 2.5f;
            posv[rr] = __popcll(bal & ((1ull << lane) - 1ull));
            lrk[rr] = 0;
            if (sel) { selm |= 1u << rr; lrk[rr] = atomicAdd(&lcnt[lane], 1u); }
        }
        __syncthreads();
        if (tid < 64 && vhalf() == 0) {
            unsigned* lcnt1 = (unsigned*)(smem_all + LDS_HALF + HL_BYTES + 4096); unsigned* lbase1 = lcnt1 + 64;
            const unsigned c0 = lcnt[tid], c1 = lcnt1[tid];
            const unsigned b = (c0 + c1) ? atomicAdd(&cnt[tid * CNT_STRIDE], c0 + c1) : 0u;
            lbase[tid] = b; lbase1[tid] = b + c0; lcnt[tid] = 0u; lcnt1[tid] = 0u;
        }
        __syncthreads();
        const unsigned base = lbase[lane];
#pragma unroll
        for (int rr = 0; rr < RPW; ++rr)
            if (selm & (1u << rr)) {
                const unsigned rk = base + lrk[rr];
                LIST[(size_t)lane * CAP + rk] = make_uint2((unsigned)(tok0 + rr), __builtin_bit_cast(unsigned, gatev[rr]));
                TOPK[(size_t)(tok0 + rr) * 8 + posv[rr]] = (unsigned)lane | (rk << 8);
            }
    }
}

DEV void phase_pb(const P& p, int layer, LAS unsigned char* lds) {
    const bf16_t* H = (const bf16_t*)(wsp(p) + (layer == 0 ? WS_H : WS_HIN1)); const bf16_t* WIN = (const bf16_t*)(wsp(p) + WS_WIN); bf16_t* O = (bf16_t*)(wsp(p) + WS_QKVZX);
    g8::SchedDense S{H, WIN, DM, DM, TT / 256, NIN / 256, (int)gridDim.x, (int)blockIdx.x};
    g8::EpiStore E{O, NIN};
    g8::gemm(lds, S, E, DM / 64, DM);
}

template <int FRAG = 0> DEV void store_transposed(unsigned char* lds, const float (*v)[8], bf16_t* dst, size_t stride) {
    bf16_t* t = (bf16_t*)lds;
    const int tid = tidx();
    __syncthreads();
#pragma unroll
    for (int i = 0; i < 4; ++i) *(uint4*)(t + ((tid >> 3) + 32 * i) * 72 + (tid & 7) * 8) = pack8(v[i]);
    __syncthreads();
    const int c = tid >> 2, sp = (tid & 3) * 32;
#pragma unroll
    for (int jj = 0; jj < 4; ++jj) {
        unsigned w[4];
#pragma unroll
        for (int e = 0; e < 4; ++e) w[e] = (unsigned)t[(sp + jj * 8 + 2 * e) * 72 + c] | ((unsigned)t[(sp + jj * 8 + 2 * e + 1) * 72 + c] << 16);
        if (FRAG) *(uint4*)(dst + (size_t)((sp >> 3) + jj) * FRAG + c * 8) = make_uint4(w[0], w[1], w[2], w[3]);
        else *(uint4*)(dst + (size_t)c * stride + sp + jj * 8) = make_uint4(w[0], w[1], w[2], w[3]);
    }
}
struct PcRegs { u32x4 ra[4], rb[4], rc[4]; f32x4v w[8]; };
DEV void pc_unit(int layer, int u, int& ch, int& sub) {
    if (layer == 0 || u < NCHL * 29) { ch = u / 29; sub = u % 29; }
    else { const int v = u - NCHL * 29; ch = NCHL + v / 21; const int s21 = v % 21; sub = s21 < 16 ? s21 : s21 + 8; }
}
DEV void pc_issue(const P& p, int layer, int u, PcRegs& R) {
    const bf16_t* QK = (const bf16_t*)(wsp(p) + WS_QKVZX);
    const int tid = tidx(), c8 = (tid & 7) * 8, s0 = tid >> 3;
    int ch, sub; pc_unit(layer, u, ch, sub);
    const bool lat = ch < NCHL;
    const int tok0 = ch * 128;
    const int pos0 = lat ? (ch & 15) * 128 : ((ch - NCHL) & 1) * 128;
    const int slen = lat ? SEQ : LC;
    if (sub < 16) {
        const int cc = sub * 64 + c8;
        const float* cw = p.conv_w + (size_t)layer * 3 * 1024 + cc; const float* cbp = p.conv_b + layer * 1024 + cc;
        R.w[0] = *(const f32x4v*)cw; R.w[1] = *(const f32x4v*)(cw + 4); R.w[2] = *(const f32x4v*)(cw + 1024); R.w[3] = *(const f32x4v*)(cw + 1028);
        R.w[4] = *(const f32x4v*)(cw + 2048); R.w[5] = *(const f32x4v*)(cw + 2052); R.w[6] = *(const f32x4v*)cbp; R.w[7] = *(const f32x4v*)(cbp + 4);
#pragma unroll
        for (int i = 0; i < 4; ++i) {
            const int s = s0 + 32 * i, pos = pos0 + s;
            const bf16_t* src = QK + (size_t)(tok0 + s) * NIN + C_X + cc;
            R.rb[i] = *(const u32x4*)src; R.ra[i] = *(const u32x4*)(pos > 0 ? src - NIN : src); R.rc[i] = *(const u32x4*)(pos < slen - 1 ? src + NIN : src);
        }
    } else if (sub < 28) {
        const int hs = sub - 16;
        const int col = hs < 8 ? C_Q + hs * 64 : (hs < 10 ? C_K + (hs - 8) * 64 : C_V + (hs - 10) * 64);
#pragma unroll
        for (int i = 0; i < 4; ++i) R.rb[i] = *(const u32x4*)(QK + (size_t)(tok0 + s0 + 32 * i) * NIN + col + c8);
        const float* g = (hs < 8 ? p.q_norm : p.k_norm) + layer * 64 + c8;
        R.w[0] = *(const f32x4v*)g; R.w[1] = *(const f32x4v*)(g + 4);
    }
}
DEV void pc_consume(const P& p, int layer, unsigned char* lds, int u, const PcRegs& R) {
    bf16_t* QP = (bf16_t*)(wsp(p) + WS_QP); bf16_t* KP = (bf16_t*)(wsp(p) + WS_KP); bf16_t* VT = (bf16_t*)(wsp(p) + WS_VT);
    bf16_t* XT = (bf16_t*)(wsp(p) + WS_XT); bf16_t* BT = (bf16_t*)(wsp(p) + WS_BT); bf16_t* BF = (bf16_t*)(wsp(p) + WS_BF); bf16_t* CF = (bf16_t*)(wsp(p) + WS_CF);
    const float2* ROPE = (const float2*)(wsp(p) + WS_ROPE);
    const float* DT = (const float*)(wsp(p) + WS_DT);
    float* CUM = (float*)(wsp(p) + WS_CUM); float* WST = (float*)(wsp(p) + WS_WST); float* DTT = (float*)(wsp(p) + WS_DTT); float* TOT = (float*)(wsp(p) + WS_TOT);
    const int tid = tidx(), c8 = (tid & 7) * 8, s0 = tid >> 3;
    {
        int ch, sub; pc_unit(layer, u, ch, sub);
        const bool lat = ch < NCHL;
        const int tok0 = ch * 128;
        const int pos0 = lat ? (ch & 15) * 128 : ((ch - NCHL) & 1) * 128;
        const int slen = lat ? SEQ : LC;
        if (sub < 16) {
            const int cg = sub, cc = cg * 64 + c8;
            float w0[8], w1[8], w2[8], bb[8];
#pragma unroll
            for (int e = 0; e < 4; ++e) { w0[e] = R.w[0][e]; w0[4 + e] = R.w[1][e]; w1[e] = R.w[2][e]; w1[4 + e] = R.w[3][e]; w2[e] = R.w[4][e]; w2[4 + e] = R.w[5][e]; bb[e] = R.w[6][e]; bb[4 + e] = R.w[7][e]; }
            float o[4][8];
#pragma unroll
            for (int i = 0; i < 4; ++i) {
                const int s = s0 + 32 * i, pos = pos0 + s;
                float a[8], b[8], c[8];
                const u32x4 zz4 = {0u, 0u, 0u, 0u};
                unpack8(as_uint4(pos > 0 ? R.ra[i] : zz4), a); unpack8(as_uint4(R.rb[i]), b); unpack8(as_uint4(pos < slen - 1 ? R.rc[i] : zz4), c);
#pragma unroll
                for (int e = 0; e < 8; ++e) o[i][e] = silu_f(bb[e] + w0[e] * a[e] + w1[e] * b[e] + w2[e] * c[e]);
                if (cg >= 12) *(uint4*)(CF + (((size_t)ch * 2 + ((cg - 12) >> 1)) * 16 + (((cc - 768) & 127) >> 3)) * 1024 + s * 8) = pack8(o[i]);
                else if (cg >= 8) *(uint4*)(BF + (((size_t)ch * 2 + ((cg - 8) >> 1)) * 16 + (((cc - 512) & 127) >> 3)) * 1024 + s * 8) = pack8(o[i]);
            }
            if (cg < 8) store_transposed<512>(lds, o, XT + ((size_t)ch * 8 + cg) * 64 * 128, 128);
            else if (cg < 12) store_transposed<1024>(lds, o, BT + ((size_t)ch * 2 + ((cg - 8) >> 1)) * 128 * 128 + ((cg - 8) & 1) * 64 * 8, 128);
            else { __syncthreads(); __syncthreads(); }
            __syncthreads();
        } else if (sub < 28) {
            const int hs = sub - 16;
            float o[4][8];
#pragma unroll
            for (int i = 0; i < 4; ++i) {
                const int s = s0 + 32 * i;
                unpack8(as_uint4(R.rb[i]), o[i]);
                if (hs < 10) {
                    float ss = 0.f;
#pragma unroll
                    for (int e = 0; e < 8; ++e) ss += o[i][e] * o[i][e];
                    ss += lane_xor1(ss); ss += lane_xor2(ss); ss += half_mirror(ss);
                    const float rs = rsqrtf(ss * (1.f / 64.f) + EPS);
#pragma unroll
                    for (int e = 0; e < 8; ++e) o[i][e] = o[i][e] * rs * (e < 4 ? R.w[0][e & 3] : R.w[1][e & 3]);
                    if (lat) {
                        const int pos = pos0 + s, half = (tid & 7) >> 2;
                        const float2* rp = ROPE + (size_t)pos * 32 + (c8 & 31);
#pragma unroll
                        for (int e = 0; e < 8; ++e) {
                            const float other = lane_xor4(o[i][e]);
                            const float2 cs = rp[e];
                            o[i][e] = half ? (other * cs.y + o[i][e] * cs.x) : (o[i][e] * cs.x - other * cs.y);
                        }
                    }
                    if (hs < 8) {
#pragma unroll
                        for (int e = 0; e < 8; ++e) o[i][e] *= QSCALE;
                        *(uint4*)(QP + (size_t)(tok0 + s) * 512 + hs * 64 + c8) = pack8(o[i]);
                    } else *(uint4*)(KP + (size_t)(tok0 + s) * 128 + (hs - 8) * 64 + c8) = pack8(o[i]);
                }
            }
            if (hs >= 10) {
                const int b = lat ? ch >> 4 : (ch - NCHL) >> 1;
                const int kp0 = lat ? LC + pos0 : pos0;
                store_transposed(lds, o, VT + ((size_t)(b * 2 + (hs - 10)) * 64) * NKEY + kp0, NKEY);
            } else { __syncthreads(); __syncthreads(); }
            __syncthreads();
        } else {
            __syncthreads(); __syncthreads(); __syncthreads();
            const int lane = tid & 63, wv = tid >> 6;
#pragma unroll
            for (int jj = 0; jj < 4; ++jj) {
                const int j = wv * 4 + jj;
                const float nega = -__expf(p.a_log[layer * 16 + j]);
                const float d0 = DT[(size_t)(tok0 + 2 * lane) * 16 + j], d1 = DT[(size_t)(tok0 + 2 * lane + 1) * 16 + j];
                const float l0 = d0 * nega, l1 = d1 * nega;
                float incl = l0 + l1;
                incl += DPPF(0.f, incl, 0x111, 0xf, 0xf, true); incl += DPPF(0.f, incl, 0x112, 0xf, 0xf, true); incl += DPPF(0.f, incl, 0x114, 0xf, 0xf, true); incl += DPPF(0.f, incl, 0x118, 0xf, 0xf, true);
                incl += DPPF(0.f, incl, 0x142, 0xa, 0xf, false); incl += DPPF(0.f, incl, 0x143, 0xc, 0xf, false);
                const float tot = __int_as_float(__builtin_amdgcn_readlane(__float_as_int(incl), 63)), excl = incl - (l0 + l1);
                const float cu0 = j < 8 ? excl + l0 : excl, cu1 = j < 8 ? incl : excl + l0;
                float* dd = DTT + ((size_t)ch * 16 + j) * 128 + 2 * lane; float* cc = CUM + ((size_t)ch * 16 + j) * 128 + 2 * lane; float* ww = WST + ((size_t)ch * 16 + j) * 128 + 2 * lane;
                *(float2*)dd = make_float2(d0, d1);
                *(float2*)cc = make_float2(cu0, cu1);
                *(float2*)ww = make_float2(d0 * (j < 8 ? __expf(tot - cu0) : __expf(cu0)), d1 * (j < 8 ? __expf(tot - cu1) : __expf(cu1)));
                if (lane == 0) TOT[ch * 16 + j] = tot;
            }
        }
    }
}
DEV void phase_pc(const P& p, int layer, unsigned char* lds) {
    const int N = layer == 0 ? NCH * 29 : NCHL * 29 + (NCH - NCHL) * 21, G = vgrid();
    PcRegs A, B;
    int u = vbid();
    if (u < N) pc_issue(p, layer, u, A);
    for (; u < N; u += 2 * G) {
        const int u1 = u + G, u2 = u + 2 * G;
        if (u1 < N) pc_issue(p, layer, u1, B);
        pc_consume(p, layer, lds, u, A);
        if (u1 >= N) break;
        if (u2 < N) pc_issue(p, layer, u2, A);
        pc_consume(p, layer, lds, u1, B);
    }
}

struct LdXTw {
    const bf16_t* xt; const float* w;
    DEV RawV raw(int, int r, int kcg) const {
        RawV x; x.q0 = *(const u32x4*)(xt + (size_t)(r >> 6) * 8192 + kcg * 512 + (r & 63) * 8);
        const float* wp = w + (r >> 6) * 128 + kcg * 8;
        x.q1 = *(const u32x4*)wp; x.q2 = *(const u32x4*)(wp + 4); return x;
    }
    DEV uint4 fin(const RawV& x, int, int, int) const {
        float f[8]; unpack8(as_uint4(x.q0), f);
#pragma unroll
        for (int e = 0; e < 4; ++e) { f[e] *= __uint_as_float(x.q1[e]); f[4 + e] *= __uint_as_float(x.q2[e]); }
        return pack8(f);
    }
};
struct EpStoreF32 {
    float* O;
    DEV void pre(int) {}
    DEV void operator()(const float* ct, int tid) const {
#pragma unroll
        for (int i = 0; i < 8; ++i) {
            const int id = tid + 256 * i, c8 = id >> 7, r = id & 127;
            *(float4*)(O + (size_t)c8 * 1024 + r * 8) = *(const float4*)(ct + r * 132 + c8 * 8);
            *(float4*)(O + (size_t)c8 * 1024 + r * 8 + 4) = *(const float4*)(ct + r * 132 + c8 * 8 + 4);
        }
    }
};
#define PD_LD16(base, voff, imm) (*(const u32x4*)((base) + (voff) + (imm)))
DEV void pd_chain(const P& p, float* wp, int c, int lane) {
    const char* XT = (const char*)(wsp(p) + WS_XT); const char* BT = (const char*)(wsp(p) + WS_BT);
    const float* WST = (const float*)(wsp(p) + WS_WST); const float* TOT = (const float*)(wsp(p) + WS_TOT);
    bf16_t* SST = (bf16_t*)(wsp(p) + WS_SST);
    const int lr = lane & 31, lh = lane >> 5;
    unsigned o128 = (unsigned)(lh * 128 + lr) * 16u, o64 = (unsigned)(lh * 64 + lr) * 16u;
    asm volatile("" : "+v"(o128), "+v"(o64));
    const int b = c >> 7, dir = (c >> 6) & 1, h = (c >> 3) & 7, nt = (c >> 1) & 3, pt = c & 1, g = h >> 2;
    f32x16 run;
#pragma unroll
    for (int e = 0; e < 16; ++e) run[e] = 0.f;
    u32x4 A0[8], B0[8], A1[8], B1[8]; float wa0, wb0, wa1, wb1, dk0, dk1;
#define PD_CH(st) (dir == 0 ? ((st) < 2 ? NCHL + b * 2 + (st) : b * 16 + ((st) - 2)) : ((st) < 2 ? NCHL + b * 2 + (1 - (st)) : b * 16 + (17 - (st))))
#define PD_ISSUE(A_, B_, wa_, wb_, dk_, st) do { const int ch_ = PD_CH(st); \
    const char* aU_ = uni_ptr(BT + (((size_t)ch_ * 2 + g) * 128 * 128 + nt * 32 * 8) * 2); const char* bU_ = uni_ptr(XT + (((size_t)ch_ * 8 + h) * 64 * 128 + pt * 32 * 8) * 2); \
    const float* wU_ = WST + ((size_t)ch_ * 16 + dir * 8 + h) * 128; \
    _Pragma("unroll") for (int i = 0; i < 8; ++i) { A_[i] = PD_LD16(aU_, o128, 4096 * i); B_[i] = PD_LD16(bU_, o64, 2048 * i); } \
    wa_ = wU_[lane]; wb_ = wU_[64 + lane]; dk_ = TOT[ch_ * 16 + dir * 8 + h]; } while (0)
#define PD_PROC(A_, B_, wa_, wb_, dk_, st) do { const int ch_ = PD_CH(st); float* wb2_ = wp + ((st) & 1) * 128; wb2_[lane] = wa_; wb2_[64 + lane] = wb_; \
    f32x16 loc_; _Pragma("unroll") for (int e = 0; e < 16; ++e) loc_[e] = 0.f; \
    _Pragma("unroll") for (int i = 0; i < 8; ++i) { float x_[8]; unpack8(as_uint4(B_[i]), x_); \
        const float4 q0_ = *(const float4*)(wb2_ + 16 * i + 8 * lh), q1_ = *(const float4*)(wb2_ + 16 * i + 8 * lh + 4); \
        x_[0] *= q0_.x; x_[1] *= q0_.y; x_[2] *= q0_.z; x_[3] *= q0_.w; x_[4] *= q1_.x; x_[5] *= q1_.y; x_[6] *= q1_.z; x_[7] *= q1_.w; \
        loc_ = __builtin_amdgcn_mfma_f32_32x32x16_bf16(__builtin_bit_cast(bf16x8, A_[i]), __builtin_bit_cast(bf16x8, pack8(x_)), loc_, 0, 0, 0); } \
      \
    { unsigned x0_ = pk2(run[0], run[1]), x1_ = pk2(run[2], run[3]), y0_ = pk2(run[4], run[5]), y1_ = pk2(run[6], run[7]); \
      unsigned z0_ = pk2(run[8], run[9]), z1_ = pk2(run[10], run[11]), w0_ = pk2(run[12], run[13]), w1_ = pk2(run[14], run[15]); \
      const auto s0_ = __builtin_amdgcn_permlane32_swap(x0_, z0_, false, false), s1_ = __builtin_amdgcn_permlane32_swap(x1_, z1_, false, false); \
      const auto s2_ = __builtin_amdgcn_permlane32_swap(y0_, w0_, false, false), s3_ = __builtin_amdgcn_permlane32_swap(y1_, w1_, false, false); \
      bf16_t* o_ = SST + (((size_t)ch_ * 2 + dir) * 8 + h) * 64 * 128 + (size_t)(nt * 4 + 2 * lh) * 512 + (pt * 32 + lr) * 8; \
      *(u32x4*)o_ = (u32x4){s0_[0], s1_[0], s0_[1], s1_[1]}; *(u32x4*)(o_ + 512) = (u32x4){s2_[0], s3_[0], s2_[1], s3_[1]}; } \
    const float d_ = __expf(dk_); _Pragma("unroll") for (int e = 0; e < 16; ++e) run[e] = d_ * run[e] + loc_[e]; } while (0)
    PD_ISSUE(A0, B0, wa0, wb0, dk0, 0);
#pragma unroll 1
    for (int st = 0; st < 18; st += 2) {
        PD_ISSUE(A1, B1, wa1, wb1, dk1, st + 1);
        PD_PROC(A0, B0, wa0, wb0, dk0, st);
        if (st + 2 < 18) PD_ISSUE(A0, B0, wa0, wb0, dk0, st + 2);
        PD_PROC(A1, B1, wa1, wb1, dk1, st + 1);
    }
#undef PD_CH
#undef PD_ISSUE
#undef PD_PROC
}
DEV void pd_cb_unit(const P& p, int u, int lane) {
    const char* BF = (const char*)(wsp(p) + WS_BF); const char* CF = (const char*)(wsp(p) + WS_CF);
    float* CB = (float*)(wsp(p) + WS_CB);
    const int lr = lane & 31, lh = lane >> 5;
    unsigned o128 = (unsigned)(lh * 128 + lr) * 16u;
    asm volatile("" : "+v"(o128));
    const int ch = u >> 4, r2 = u & 15, g = r2 >> 3, st = (r2 >> 1) & 3, lp = r2 & 1;
    const char* aU = uni_ptr(BF + (((size_t)ch * 2 + g) * 128 * 128 + st * 32 * 8) * 2);
    const char* bU = uni_ptr(CF + (((size_t)ch * 2 + g) * 128 * 128 + lp * 64 * 8) * 2);
    f32x16 acc[2];
#pragma unroll
    for (int e = 0; e < 16; ++e) { acc[0][e] = 0.f; acc[1][e] = 0.f; }
    u32x4 ra[8], rb0[8], rb1[8];
#pragma unroll
    for (int i = 0; i < 8; ++i) { ra[i] = PD_LD16(aU, o128, 4096 * i); rb0[i] = PD_LD16(bU, o128, 4096 * i); rb1[i] = PD_LD16(bU, o128, 4096 * i + 512); }
#pragma unroll
    for (int i = 0; i < 8; ++i) {
        const bf16x8 af = __builtin_bit_cast(bf16x8, ra[i]);
        acc[0] = __builtin_amdgcn_mfma_f32_32x32x16_bf16(af, __builtin_bit_cast(bf16x8, rb0[i]), acc[0], 0, 0, 0);
        acc[1] = __builtin_amdgcn_mfma_f32_32x32x16_bf16(af, __builtin_bit_cast(bf16x8, rb1[i]), acc[1], 0, 0, 0);
    }
    float* o = CB + ((size_t)ch * 2 + g) * 128 * 128 + (size_t)(st * 4) * 1024 + (lp * 64 + lr) * 8 + 4 * lh;
#pragma unroll
    for (int lt = 0; lt < 2; ++lt)
#pragma unroll
        for (int q = 0; q < 4; ++q)
            *(float4*)(o + q * 1024 + lt * 256) = make_float4(acc[lt][4 * q], acc[lt][4 * q + 1], acc[lt][4 * q + 2], acc[lt][4 * q + 3]);
}
#undef PD_LD16
DEV void phase_pd(const P& p, unsigned char* lds8  ) {
    const int t8 = tid512(), w8 = t8 >> 6, lane = t8 & 63;
    float* wp = (float*)(lds8 + w8 * 1024);
    if (gridDim.x >= 256) {
        if (blockIdx.x < 128) pd_chain(p, wp, (int)blockIdx.x * 8 + w8, lane);
        else for (int u = ((int)blockIdx.x - 128) * 8 + w8; u < NCH * 16; u += ((int)gridDim.x - 128) * 8) pd_cb_unit(p, u, lane);
    } else {
        const int wv = ((int)blockIdx.x * 8 + w8) >> 1, nwv = (int)gridDim.x * 4;
        if ((w8 & 1) == 0) { for (int c = wv; c < NB * 2 * 8 * 4 * 2; c += nwv) pd_chain(p, wp, c, lane); }
        else { for (int u = wv; u < NCH * 16; u += nwv) pd_cb_unit(p, u, lane); }
    }
}
DEV void phase_pe(const P& p) {
    bf16_t* SST = (bf16_t*)(wsp(p) + WS_SST); const float* TOT = (const float*)(wsp(p) + WS_TOT);
    for (int gid = vbid() * 256 + tidx(); gid < NB * 2 * 8 * 64 * 16; gid += vgrid() * 256) {
        const int n8 = gid & 15, pp = (gid >> 4) & 63, h = (gid >> 10) & 7, dir = (gid >> 13) & 1, b = gid >> 14;
        u32x4 loc[18]; float dec[18];
#pragma unroll
        for (int st = 0; st < 18; ++st) {
            const int ch = dir == 0 ? (st < 2 ? NCHL + b * 2 + st : b * 16 + (st - 2)) : (st < 2 ? NCHL + b * 2 + (1 - st) : b * 16 + (17 - st));
            loc[st] = *(const u32x4*)(SST + ((((size_t)ch * 2 + dir) * 8 + h) * 64 + pp) * 128 + n8 * 8);
            dec[st] = TOT[ch * 16 + dir * 8 + h];
        }
        float run[8];
#pragma unroll
        for (int e = 0; e < 8; ++e) run[e] = 0.f;
#pragma unroll
        for (int st = 0; st < 18; ++st) {
            const int ch = dir == 0 ? (st < 2 ? NCHL + b * 2 + st : b * 16 + (st - 2)) : (st < 2 ? NCHL + b * 2 + (1 - st) : b * 16 + (17 - st));
            *(uint4*)(SST + ((((size_t)ch * 2 + dir) * 8 + h) * 64 + pp) * 128 + n8 * 8) = pack8(run);
            const float d = __expf(dec[st]);
            const u32x4 q = loc[st];
            run[0] = d * run[0] + bflo(q.x); run[1] = d * run[1] + bfhi(q.x); run[2] = d * run[2] + bflo(q.y); run[3] = d * run[3] + bfhi(q.y);
            run[4] = d * run[4] + bflo(q.z); run[5] = d * run[5] + bfhi(q.z); run[6] = d * run[6] + bflo(q.w); run[7] = d * run[7] + bfhi(q.w);
        }
    }
}
struct LdG {
    const float* cb; const bf16_t* cm; const float* sv; float totb, dsk;
    DEV RawV raw(int, int r, int kcg) const {
        const int seg = kcg >> 4, kk = (kcg & 15) * 8;
        RawV x;
        if (seg == 0 || seg == 2) { x.q0 = *(const u32x4*)(cb + (size_t)r * 128 + kk); x.q1 = *(const u32x4*)(cb + (size_t)r * 128 + kk + 4); }
        else x.q0 = *(const u32x4*)(cm + (size_t)r * 512 + kk);
        return x;
    }
    DEV uint4 fin(const RawV& x, int, int r, int kcg) const {
        const int seg = kcg >> 4, kk = (kcg & 15) * 8;
        float f[8];
        if (seg == 0 || seg == 2) {
            const bool fwd = seg == 0;
            if (fwd ? (kk > r) : (kk + 7 < r)) return make_uint4(0u, 0u, 0u, 0u);
            float cbv[8];
#pragma unroll
            for (int e = 0; e < 4; ++e) { cbv[e] = __uint_as_float(x.q0[e]); cbv[4 + e] = __uint_as_float(x.q1[e]); }
            const float* cu = sv + (fwd ? 0 : 128); const float* dt = sv + (fwd ? 256 : 384);
            const float4 c0 = *(const float4*)(cu + kk), c1 = *(const float4*)(cu + kk + 4), d0 = *(const float4*)(dt + kk), d1 = *(const float4*)(dt + kk + 4);
            const float cus[8] = {c0.x, c0.y, c0.z, c0.w, c1.x, c1.y, c1.z, c1.w}, dts[8] = {d0.x, d0.y, d0.z, d0.w, d1.x, d1.y, d1.z, d1.w};
            const float cl = cu[r];
#pragma unroll
            for (int e = 0; e < 8; ++e) {
                const int s = kk + e;
                const bool on = fwd ? (s <= r) : (s >= r);
                const float ex = fwd ? __expf(cl - cus[e]) : __expf(cus[e] - cl);
                float v = on ? cbv[e] * ex * dts[e] : 0.f;
                if (fwd && s == r) v += dsk;
                f[e] = v;
            }
        } else {
            unpack8(as_uint4(x.q0), f);
            const float sc = seg == 1 ? __expf(sv[r]) : __expf(totb - sv[128 + r]);
#pragma unroll
            for (int e = 0; e < 8; ++e) f[e] *= sc;
        }
        return pack8(f);
    }
};
struct LdXS {
    const bf16_t* xt; const bf16_t* sf; const bf16_t* sb;
    DEV RawV raw(int, int r, int kcg) const {
        const int seg = kcg >> 4, kk = (kcg & 15) * 8;
        const bf16_t* base = (seg == 1) ? sf : (seg == 3 ? sb : xt);
        RawV x; x.q0 = *(const u32x4*)(base + (size_t)r * 128 + kk); return x;
    }
    DEV uint4 fin(const RawV& x, int, int, int) const { return as_uint4(x.q0); }
};
struct EpSsd {
    const bf16_t* z; bf16_t* o; float* ssq;
    u32x4 zr[4];
    DEV void pre(int tid) {
#pragma unroll
        for (int i = 0; i < 4; ++i) { const int id = tid + 256 * i, r = id >> 3, c8 = id & 7; zr[i] = *(const u32x4*)(z + (size_t)r * NIN + c8 * 8); }
    }
    DEV void operator()(const float* ct, int tid) const {
#pragma unroll
        for (int i = 0; i < 4; ++i) {
            const int id = tid + 256 * i, r = id >> 3, c8 = id & 7;
            float v[8], zz[8]; ld8f(ct, r * 64 + c8 * 8, v);
            unpack8(as_uint4(zr[i]), zz);
            float ss = 0.f;
#pragma unroll
            for (int e = 0; e < 8; ++e) { v[e] *= silu_f(zz[e]); ss += v[e] * v[e]; }
            *(uint4*)(o + (size_t)r * DM + c8 * 8) = pack8(v);
            ss += __shfl_xor(ss, 1); ss += __shfl_xor(ss, 2); ss += __shfl_xor(ss, 4);
            if (c8 == 0) ssq[(size_t)r * 8] = ss;
        }
    }
};
DEV void phase_pf(const P& p, int layer, unsigned char* lds) {
    const bf16_t* XT = (const bf16_t*)(wsp(p) + WS_XT); const bf16_t* CF = (const bf16_t*)(wsp(p) + WS_CF); const bf16_t* SST = (const bf16_t*)(wsp(p) + WS_SST);
    const float* CB = (const float*)(wsp(p) + WS_CB); const float* CUM = (const float*)(wsp(p) + WS_CUM); const float* DTT = (const float*)(wsp(p) + WS_DTT); const float* TOT = (const float*)(wsp(p) + WS_TOT);
    const bf16_t* QK = (const bf16_t*)(wsp(p) + WS_QKVZX); bf16_t* AS = (bf16_t*)(wsp(p) + WS_AS); float* SSQ = (float*)(wsp(p) + WS_SSQ);
    const int nch = (layer == 0) ? NCH : NCHL;
    const int tid = tidx(), lane = tid & 63, wid = tid >> 6, lr = lane & 31, lh = lane >> 5;
    float* sv = (float*)(lds + wid * 2048);
    for (int u = vbid(); u < nch * 8; u += vgrid()) {
        const int ch = u >> 3, h = u & 7, g = h >> 2, tok0 = ch * 128, l = wid * 32 + lr;
        {
            const float* c0 = CUM + ((size_t)ch * 16 + h) * 128 + lane; const float* d0 = DTT + ((size_t)ch * 16 + h) * 128 + lane;
            const float a0 = c0[0], a1 = c0[64], b0 = c0[1024], b1 = c0[1088], e0 = d0[0], e1 = d0[64], f0 = d0[1024], f1 = d0[1088];
            sv[lane] = a0; sv[64 + lane] = a1; sv[128 + lane] = b0; sv[192 + lane] = b1; sv[256 + lane] = e0; sv[320 + lane] = e1; sv[384 + lane] = f0; sv[448 + lane] = f1;
        }
        const float totb = TOT[ch * 16 + 8 + h], dsk = p.d_skip[layer * 8 + h];
        const char* cbU = uni_ptr(CB + ((size_t)ch * 2 + g) * 128 * 128); const char* xtU = uni_ptr(XT + ((size_t)ch * 8 + h) * 64 * 128);
        const char* cmU = uni_ptr(CF + ((size_t)ch * 2 + g) * 128 * 128);
        const char* sfU = uni_ptr(SST + (((size_t)ch * 2 + 0) * 8 + h) * 64 * 128); const char* sbU = uni_ptr(SST + (((size_t)ch * 2 + 1) * 8 + h) * 64 * 128);
        unsigned ocb = (unsigned)(lh * 128 + l) * 32u, oxt = (unsigned)(lh * 64 + lr) * 16u, ocm = (unsigned)(lh * 128 + l) * 16u;
        asm volatile("" : "+v"(ocb), "+v"(oxt), "+v"(ocm));
#define PF_LD16(base, voff, imm) (*(const u32x4*)((base) + (voff) + (imm)))
        u32x4 rc0[8], rc1[8], rx0[8], rx1[8];
#pragma unroll
        for (int i = 0; i < 8; ++i) { rc0[i] = PF_LD16(cbU, ocb, 8192 * i); rc1[i] = PF_LD16(cbU, ocb, 8192 * i + 16); rx0[i] = PF_LD16(xtU, oxt, 2048 * i); rx1[i] = PF_LD16(xtU, oxt, 2048 * i + 512); }
        f32x16 acc[2];
#pragma unroll
        for (int e = 0; e < 16; ++e) { acc[0][e] = 0.f; acc[1][e] = 0.f; }
        const float cfl = sv[l], cbl = sv[128 + l];
        u32x4 rcm[8], rf0[8], rf1[8], rb0[8], rb1[8];
#pragma unroll
        for (int i = 0; i < 8; ++i) {
            const int sb = 16 * i + 8 * lh;
            const float4 q0 = *(const float4*)(sv + sb), q1 = *(const float4*)(sv + sb + 4), q2 = *(const float4*)(sv + 128 + sb), q3 = *(const float4*)(sv + 128 + sb + 4);
            const float4 q4 = *(const float4*)(sv + 256 + sb), q5 = *(const float4*)(sv + 256 + sb + 4), q6 = *(const float4*)(sv + 384 + sb), q7 = *(const float4*)(sv + 384 + sb + 4);
            const float cfs[8] = {q0.x, q0.y, q0.z, q0.w, q1.x, q1.y, q1.z, q1.w}, cbs[8] = {q2.x, q2.y, q2.z, q2.w, q3.x, q3.y, q3.z, q3.w};
            const float dfs[8] = {q4.x, q4.y, q4.z, q4.w, q5.x, q5.y, q5.z, q5.w}, dbs[8] = {q6.x, q6.y, q6.z, q6.w, q7.x, q7.y, q7.z, q7.w};
            float gv[8];
#pragma unroll
            for (int j = 0; j < 8; ++j) {
                const int s = sb + j;
                const float cbv = __uint_as_float(j < 4 ? rc0[i][j & 3] : rc1[i][j & 3]);
                const float arg = s < l ? cfl - cfs[j] : cbs[j] - cbl;
                float dtv = s < l ? dfs[j] : dbs[j];
                if (s == l) dtv += dfs[j];
                float v = cbv * __expf(arg) * dtv;
                if (s == l) v += dsk;
                gv[j] = v;
            }
            const bf16x8 gf = __builtin_bit_cast(bf16x8, pack8(gv));
            acc[0] = __builtin_amdgcn_mfma_f32_32x32x16_bf16(__builtin_bit_cast(bf16x8, rx0[i]), gf, acc[0], 0, 0, 0);
            acc[1] = __builtin_amdgcn_mfma_f32_32x32x16_bf16(__builtin_bit_cast(bf16x8, rx1[i]), gf, acc[1], 0, 0, 0);
            rcm[i] = PF_LD16(cmU, ocm, 4096 * i); rf0[i] = PF_LD16(sfU, oxt, 2048 * i); rf1[i] = PF_LD16(sfU, oxt, 2048 * i + 512);
            rb0[i] = PF_LD16(sbU, oxt, 2048 * i); rb1[i] = PF_LD16(sbU, oxt, 2048 * i + 512);
            __builtin_amdgcn_sched_barrier(0);
        }
        const int tr = lane >> 1, hh = lane & 1;
        const char* zU = uni_ptr(QK + (size_t)tok0 * NIN + C_Z + h * 64);
        unsigned oz = (unsigned)((wid * 32 + tr) * NIN + 32 * hh) * 2u; asm volatile("" : "+v"(oz));
        u32x4 zr[4];
#pragma unroll
        for (int q = 0; q < 4; ++q) zr[q] = *(const u32x4*)(zU + oz + 16 * q);
        const float af = __expf(cfl), ab = __expf(totb - cbl);
#pragma unroll
        for (int i = 0; i < 8; ++i) {
            float c[8], cf8[8], cb8[8];
            unpack8(as_uint4(rcm[i]), c);
#pragma unroll
            for (int j = 0; j < 8; ++j) { cf8[j] = c[j] * af; cb8[j] = c[j] * ab; }
            const bf16x8 ff = __builtin_bit_cast(bf16x8, pack8(cf8)), fb = __builtin_bit_cast(bf16x8, pack8(cb8));
            acc[0] = __builtin_amdgcn_mfma_f32_32x32x16_bf16(__builtin_bit_cast(bf16x8, rf0[i]), ff, acc[0], 0, 0, 0);
            acc[1] = __builtin_amdgcn_mfma_f32_32x32x16_bf16(__builtin_bit_cast(bf16x8, rf1[i]), ff, acc[1], 0, 0, 0);
            acc[0] = __builtin_amdgcn_mfma_f32_32x32x16_bf16(__builtin_bit_cast(bf16x8, rb0[i]), fb, acc[0], 0, 0, 0);
            acc[1] = __builtin_amdgcn_mfma_f32_32x32x16_bf16(__builtin_bit_cast(bf16x8, rb1[i]), fb, acc[1], 0, 0, 0);
        }
#undef PF_LD16
        float* yp = (float*)(lds + 8192 + wid * (32 * 68 * 4));
#pragma unroll
        for (int pt = 0; pt < 2; ++pt)
#pragma unroll
            for (int q = 0; q < 4; ++q) *(float4*)(yp + lr * 68 + 32 * pt + 8 * q + 4 * lh) = make_float4(acc[pt][4 * q], acc[pt][4 * q + 1], acc[pt][4 * q + 2], acc[pt][4 * q + 3]);
        bf16_t* op = AS + (size_t)(tok0 + wid * 32 + tr) * DM + h * 64 + 32 * hh;
        float ss = 0.f;
#pragma unroll
        for (int q = 0; q < 4; ++q) {
            const float4 ya = *(const float4*)(yp + tr * 68 + 32 * hh + 8 * q), yb = *(const float4*)(yp + tr * 68 + 32 * hh + 8 * q + 4);
            float zz[8]; unpack8(as_uint4(zr[q]), zz);
            const float y[8] = {ya.x * silu_f(zz[0]), ya.y * silu_f(zz[1]), ya.z * silu_f(zz[2]), ya.w * silu_f(zz[3]), yb.x * silu_f(zz[4]), yb.y * silu_f(zz[5]), yb.z * silu_f(zz[6]), yb.w * silu_f(zz[7])};
#pragma unroll
            for (int e = 0; e < 8; ++e) ss += y[e] * y[e];
            *(uint4*)(op + 8 * q) = pack8(y);
        }
        ss += lane_xor1(ss);
        if (hh == 0) SSQ[(size_t)(tok0 + wid * 32 + tr) * 8 + h] = ss;
    }
}

DEV float fexp2(float x) { return __builtin_amdgcn_exp2f(x); }
#define ATT_SCORE(S_, qf_, m_, kb_) do { \
        _Pragma("unroll") for (int mt = 0; mt < 2; ++mt) _Pragma("unroll") for (int e = 0; e < 16; ++e) S_[mt][e] = -(m_); \
        __builtin_amdgcn_s_setprio(1); \
        _Pragma("unroll") for (int kk = 0; kk < 4; ++kk) _Pragma("unroll") for (int mt = 0; mt < 2; ++mt) \
            S_[mt] = __builtin_amdgcn_mfma_f32_32x32x16_bf16(kf[kk][mt], qf_[kk], S_[mt], 0, 0, 0); \
        __builtin_amdgcn_s_setprio(0); } while (0)
#define ATT_SOFTMAX(S_, m_, l_, ot_, pb_) do { \
        float mx = S_[0][0]; \
        _Pragma("unroll") for (int e = 1; e < 16; ++e) mx = fmaxf(mx, S_[0][e]); \
        _Pragma("unroll") for (int e = 0; e < 16; ++e) mx = fmaxf(mx, S_[1][e]); \
        mx = half_max(mx); \
        if (!__all(mx <= 8.f)) { \
            const float dm = fmaxf(mx, 0.f), alpha = fexp2(-dm); \
            m_ += dm; l_ *= alpha; \
            _Pragma("unroll") for (int dt = 0; dt < 2; ++dt) _Pragma("unroll") for (int e = 0; e < 16; ++e) ot_[dt][e] *= alpha; \
            _Pragma("unroll") for (int mt = 0; mt < 2; ++mt) _Pragma("unroll") for (int e = 0; e < 16; ++e) S_[mt][e] -= dm; \
        } \
        float ps = 0.f; \
        _Pragma("unroll") for (int mt = 0; mt < 2; ++mt) _Pragma("unroll") for (int e = 0; e < 16; ++e) { S_[mt][e] = fexp2(S_[mt][e]); ps += S_[mt][e]; } \
        l_ += ps; \
        _Pragma("unroll") for (int mt = 0; mt < 2; ++mt) _Pragma("unroll") for (int sx = 0; sx < 2; ++sx) { \
            const u32x4 pbu = {pk2(S_[mt][8 * sx], S_[mt][8 * sx + 1]), pk2(S_[mt][8 * sx + 2], S_[mt][8 * sx + 3]), pk2(S_[mt][8 * sx + 4], S_[mt][8 * sx + 5]), pk2(S_[mt][8 * sx + 6], S_[mt][8 * sx + 7])}; \
            pb_[mt][sx] = __builtin_bit_cast(bf16x8, pbu); } } while (0)
DEV void attn_unit(unsigned char* lds, const bf16_t* QP, const bf16_t* KP, const bf16_t* VT, bf16_t* AS, int b, int kvh, int hqa, int hqb, int tokA0, int tokB0, bool lat) {
    const int tid = tid512(), lane = tid & 63, wid = tid >> 6, lr = lane & 31, lh = lane >> 5;
    const int ntl = lat ? NKEY / 64 : LC / 64;
    const int tokA = tokA0 + wid * 32 + lr, tokB = tokB0 + wid * 32 + lr;
    bf16x8 qa[4], qb[4];
#pragma unroll
    for (int kk = 0; kk < 4; ++kk) { qa[kk] = *(const bf16x8*)(QP + (size_t)tokA * 512 + hqa * 64 + (2 * kk + lh) * 8); qb[kk] = *(const bf16x8*)(QP + (size_t)tokB * 512 + hqb * 64 + (2 * kk + lh) * 8); }
    f32x16 oa[2], ob[2];
#pragma unroll
    for (int dt = 0; dt < 2; ++dt)
#pragma unroll
        for (int e = 0; e < 16; ++e) { oa[dt][e] = 0.f; ob[dt][e] = 0.f; }
    float ma = 0.f, la = 0.f, mb = 0.f, lb = 0.f;
    const int sr = tid >> 3, sc = tid & 7;
    const bf16_t* vbase = VT + ((size_t)(b * 2 + kvh) * 64) * NKEY;
    const int fsw = (sc ^ ((sr >> 1) & 7)) << 4;
    u32x4 rk, rv;
#define ATT_LD(t_) do { const int tq = (t_); const int ktok0 = tq < 4 ? TL + b * LC + tq * 64 : b * SEQ + (tq - 4) * 64; \
        rk = *(const u32x4*)(KP + (size_t)(ktok0 + sr) * 128 + kvh * 64 + sc * 8); \
        rv = *(const u32x4*)(vbase + (size_t)sr * NKEY + tq * 64 + sc * 8); } while (0)
#define ATT_ST(buf_) do { unsigned char* kb_ = lds + (buf_) * 16384; unsigned char* vb_ = kb_ + 8192; \
        *(u32x4*)(kb_ + sr * 128 + fsw) = rk; \
        *(u32x4*)(vb_ + sr * 128 + fsw) = ((sr >> 4) & 1) ? __builtin_shufflevector(rv, rv, 2, 3, 0, 1) : rv; } while (0)
    const int rsw = (lr >> 1) & 7, hsw = (lr >> 4) & 1;
    ATT_LD(0);
    __syncthreads();
    ATT_ST(0);
    ATT_LD(1);
    ATT_ST(1);
    __syncthreads();
    for (int t = 0; t < ntl; ++t) {
        if (t + 2 < ntl) ATT_LD(t + 2);
        const unsigned char* kb = lds + (t % 3) * 16384; const unsigned char* vb = kb + 8192;
        bf16x8 kf[4][2];
#pragma unroll
        for (int kk = 0; kk < 4; ++kk)
#pragma unroll
            for (int mt = 0; mt < 2; ++mt) kf[kk][mt] = *(const bf16x8*)(kb + (mt * 32 + lr) * 128 + (((2 * kk + lh) ^ rsw) << 4));
        f32x16 st[2]; bf16x8 pa[2][2], pbb[2][2];
        ATT_SCORE(st, qa, ma, kb);
        ATT_SOFTMAX(st, ma, la, oa, pa);
        ATT_SCORE(st, qb, mb, kb);
        ATT_SOFTMAX(st, mb, lb, ob, pbb);
#pragma unroll
        for (int mt = 0; mt < 2; ++mt)
#pragma unroll
            for (int sx = 0; sx < 2; ++sx) {
                bf16x8 va[2];
#pragma unroll
                for (int dt = 0; dt < 2; ++dt) {
                    const unsigned char* vr = vb + (dt * 32 + lr) * 128 + ((lh ^ hsw) << 3);
                    const int c0 = 4 * mt + 2 * sx;
                    const uint2 h0 = *(const uint2*)(vr + ((c0 ^ rsw) << 4)), h1 = *(const uint2*)(vr + (((c0 + 1) ^ rsw) << 4));
                    va[dt] = __builtin_bit_cast(bf16x8, (u32x4){h0.x, h0.y, h1.x, h1.y});
                }
#pragma unroll
                for (int dt = 0; dt < 2; ++dt) {
                    oa[dt] = __builtin_amdgcn_mfma_f32_32x32x16_bf16(va[dt], pa[mt][sx], oa[dt], 0, 0, 0);
                    ob[dt] = __builtin_amdgcn_mfma_f32_32x32x16_bf16(va[dt], pbb[mt][sx], ob[dt], 0, 0, 0);
                }
            }
        if (t + 2 < ntl) ATT_ST((t + 2) % 3);
        __syncthreads();
    }
#undef ATT_LD
#undef ATT_ST
    la = half_sum(la); lb = half_sum(lb);
    const float ila = 1.f / la, ilb = 1.f / lb;
    bf16_t* rowA = AS + (size_t)tokA * DM + 512 + hqa * 64; bf16_t* rowB = AS + (size_t)tokB * DM + 512 + hqb * 64;
#pragma unroll
    for (int dt = 0; dt < 2; ++dt)
#pragma unroll
        for (int g = 0; g < 4; ++g) {
            const int d0 = 32 * dt + 8 * g + 4 * lh;
            *(uint2*)(rowA + d0) = make_uint2(pk2(oa[dt][4 * g] * ila, oa[dt][4 * g + 1] * ila), pk2(oa[dt][4 * g + 2] * ila, oa[dt][4 * g + 3] * ila));
            *(uint2*)(rowB + d0) = make_uint2(pk2(ob[dt][4 * g] * ilb, ob[dt][4 * g + 1] * ilb), pk2(ob[dt][4 * g + 2] * ilb, ob[dt][4 * g + 3] * ilb));
        }
}
DEV void phase_pg(const P& p, int layer, unsigned char* lds) {
    const bf16_t* QP = (const bf16_t*)(wsp(p) + WS_QP); const bf16_t* KP = (const bf16_t*)(wsp(p) + WS_KP); const bf16_t* VT = (const bf16_t*)(wsp(p) + WS_VT);
    bf16_t* AS = (bf16_t*)(wsp(p) + WS_AS);
    const int nctx = (layer == 0) ? 32 : 0;
    const int first = (gridDim.x == 256 && blockIdx.x >= 128) ? (int)blockIdx.x + 128 : (int)blockIdx.x;
    for (int it = 0; it < 2; ++it) {
        int u0;
        if (gridDim.x == 256) { u0 = it == 0 ? (first >= 256 ? (first < 256 + nctx ? first : (int)blockIdx.x) : first) : (first >= 256 && first < 256 + nctx ? (int)blockIdx.x : 1 << 30); }
        else { u0 = (int)blockIdx.x + it * (int)gridDim.x; }
        if (gridDim.x != 256 && it == 1) { for (; u0 < 256 + nctx; u0 += gridDim.x) { const int u = u0;
            if (u < 256) { const int b = u >> 5, hq = (u >> 2) & 7, qb = u & 3; attn_unit(lds, QP, KP, VT, AS, b, hq >> 2, hq, hq, b * SEQ + qb * 512, b * SEQ + qb * 512 + 256, true); }
            else { const int uu = u - 256, b = uu >> 2, hp = uu & 3; attn_unit(lds, QP, KP, VT, AS, b, hp >> 1, 2 * hp, 2 * hp + 1, TL + b * LC, TL + b * LC, false); } } break; }
        if (u0 >= 256 + nctx) break;
        const int u = (u0 < 256 && gridDim.x == 256) ? (u0 & 7) * 32 + (u0 >> 3) : u0;
        if (u < 256) { const int b = u >> 5, hq = (u >> 2) & 7, qb = u & 3; attn_unit(lds, QP, KP, VT, AS, b, hq >> 2, hq, hq, b * SEQ + qb * 512, b * SEQ + qb * 512 + 256, true); }
        else { const int uu = u - 256, b = uu >> 2, hp = uu & 3; attn_unit(lds, QP, KP, VT, AS, b, hp >> 1, 2 * hp, 2 * hp + 1, TL + b * LC, TL + b * LC, false); }
    }
}

struct EpiOut {
    static constexpr int MID_T = 8;
    bf16_t* O; const float* ssq;
    DEV void mid(g8::f32x4 (&acc)[2][2][4][2], const g8::Unit& u, int wr, int fr) const {
#pragma unroll
        for (int ai = 0; ai < 2; ++ai)
#pragma unroll
            for (int m = 0; m < 4; ++m) {
                const float* q = ssq + (size_t)(u.row0 + ai * 128 + wr * 64 + m * 16 + fr) * 8;
                const float4 a = *(const float4*)q, b = *(const float4*)(q + 4);
                const float rs = rsqrtf((((a.x + a.y) + (a.z + a.w)) + ((b.x + b.y) + (b.z + b.w))) * (1.f / 512.f) + EPS);
#pragma unroll
                for (int bj = 0; bj < 2; ++bj)
#pragma unroll
                    for (int n = 0; n < 2; ++n) acc[ai][bj][m][n] = acc[ai][bj][m][n] * rs;
            }
    }
    DEV void operator()(const g8::f32x4 (&acc)[2][2][4][2], const g8::Unit& u, int wr, int wc, int fr, int fq) const { g8::EpiStore{O, DM}(acc, u, wr, wc, fr, fq); }
};
DEV void phase_ph(const P& p, int layer, LAS unsigned char* lds) {
    const int nt = (layer == 0) ? TT : TL;
    g8::SchedDense S{(const bf16_t*)(wsp(p) + WS_AS), (const bf16_t*)(wsp(p) + WS_WOUT), DM, DM, nt / 256, DM / 256, (int)gridDim.x, (int)blockIdx.x};
    EpiOut E{(bf16_t*)(wsp(p) + WS_ML), (const float*)(wsp(p) + WS_SSQ)};
    g8::gemm(lds, S, E, DM / 64, DM);
}

struct MoeMap { int offs[66]; int tp[66]; };
DEV void build_map(const P& p, int layer, MoeMap* mm) {
    const unsigned* cnt = (const unsigned*)(wsp(p) + WS_CTL) + CW_CNT + layer * CNT_LAYER;
    const int nt = (layer == 0) ? TT : TL;
    __syncthreads();
    if (tidx() == 0) {
        int o = 0, t = 0;
        for (int e = 0; e < 65; ++e) {
            const int c = e < 64 ? (int)__hip_atomic_load(&cnt[e * CNT_STRIDE], __ATOMIC_RELAXED, __HIP_MEMORY_SCOPE_AGENT) : nt;
            mm->offs[e] = o; mm->tp[e] = t; o += c; t += (c + 255) >> 8;
        }
        mm->offs[65] = o; mm->tp[65] = t;
    }
    __syncthreads();
}
template <class MP> DEV int find_expert(MP mm, int ti) {
    const int l = hw_lane(); const bool le = mm->tp[l + 1] <= ti;
    return (int)__popcll(__ballot(le));
}

template <int mode> struct SchedMoe {
    static constexpr bool GATHER = (mode == 0), F8 = true, P16 = (mode == 1);
    const MoeMap* mm; int nsub, G, c;
    const bf16_t* A; const bf16_t* W0; const bf16_t* W1; const uint2* LIST;
    DEV bool next(int i, g8::Unit& u) const {
        const LAS MoeMap* mm; { unsigned o = (unsigned)(size_t)(const LAS MoeMap*)this->mm; asm volatile("" : "+s"(o)); mm = (const LAS MoeMap*)(size_t)o; }
        const int ntile = __builtin_amdgcn_readfirstlane(mm->tp[65]), w = g8::deal(i, G, c, ntile * nsub); if (w < 0) return false;
        const int ti = w / nsub, sub = w % nsub, e = __builtin_amdgcn_readfirstlane(find_expert(mm, ti)), tt = __builtin_amdgcn_readfirstlane(ti - mm->tp[e]);
        const int cnt_e = __builtin_amdgcn_readfirstlane(mm->offs[e + 1] - mm->offs[e]), nvalid = min(256, cnt_e - tt * 256), slot0 = __builtin_amdgcn_readfirstlane(mm->offs[e]) + tt * 256;
        u.row0 = slot0; u.nvalid = nvalid; u.sub = sub;
        if (mode == 0) {
            u.a = (const char*)A; u.b0 = (const char*)W0 + ((size_t)e * FE + sub * 128) * DM; u.b1 = (const char*)W1 + ((size_t)e * FE + sub * 128) * DM;
            u.aux = e < 64 ? (const void*)(LIST + (size_t)e * CAP + tt * 256) : nullptr; u.col0 = tt * 256;
        } else {
            u.a = (const char*)A + (size_t)slot0 * FE; u.b0 = (const char*)W0 + ((size_t)e * DM + sub * 256) * FE; u.b1 = u.b0 + (size_t)8 * FE;
            u.aux = nullptr; u.col0 = sub * 256;
        }
        return true;
    }
    DEV size_t a_half() const { return mode == 0 ? (size_t)0 : (size_t)128 * FE; }
    DEV void a_off(const g8::Unit& u, unsigned (&v0)[2], unsigned (&v1)[2]) const {
        const int tz = tid512();
        if (mode == 0) {
            const uint2* lst = (const uint2*)u.aux;
#pragma unroll
            for (int i = 0; i < 2; ++i) {
                int R, C; g8::stage_rc(tz * 16 + i * 8192, R, C);
                const int ra = R < u.nvalid ? R : 0, rb = (128 + R) < u.nvalid ? 128 + R : 0;
                const unsigned ta = lst ? lst[ra].x : (unsigned)(u.col0 + ra), tb = lst ? lst[rb].x : (unsigned)(u.col0 + rb);
                v0[i] = ta * (unsigned)DM + (unsigned)C * 2u; v1[i] = tb * (unsigned)DM + (unsigned)C * 2u;
            }
        } else {
#pragma unroll
            for (int i = 0; i < 2; ++i) { int R, C; g8::stage_rc(tz * 16 + i * 8192, R, C); v0[i] = (unsigned)(R * FE + C * 2); v1[i] = v0[i]; }
        }
    }
};
struct EpiAct {
    static constexpr int MID_T = 0;
    unsigned char* act;
    DEV void operator()(const g8::f32x4 (&acc)[2][2][4][2], const g8::Unit& u, int wr, int wc, int fr, int fq) const {
        const uint2* lst = (const uint2*)u.aux;
#pragma unroll
        for (int ai = 0; ai < 2; ++ai)
#pragma unroll
            for (int m = 0; m < 4; ++m) {
                const int r = ai * 128 + wr * 64 + m * 16 + fr;
                if (r < u.nvalid) {
                    const float gate = (lst ? __builtin_bit_cast(float, lst[r].y) : 1.f) * (GU_DESCALE * A8_SCALE);
                    float o[8];
#pragma unroll
                    for (int n = 0; n < 2; ++n)
#pragma unroll
                        for (int j = 0; j < 4; ++j) {
                            const float g = acc[ai][0][m][n][j];
                            o[4 * n + j] = (g * acc[ai][1][m][n][j]) * (__builtin_amdgcn_rcpf(1.f + __builtin_amdgcn_exp2f(g * (-GU_DESCALE * 1.4426950408889634f))) * (gate * GU_DESCALE));
                        }
                    *(uint2*)(act + (size_t)(u.row0 + r) * FE + u.sub * 128 + wc * 32 + 8 * fq) = make_uint2(pk4_f8(o[0], o[1], o[2], o[3]), pk4_f8(o[4], o[5], o[6], o[7]));
                }
            }
    }
};
DEV void phase_pj(const P& p, int layer, LAS unsigned char* lds, MoeMap* mm) {
    build_map(p, layer, mm);
    SchedMoe<0> S{mm, 2, (int)gridDim.x, (int)blockIdx.x, (const bf16_t*)(wsp(p) + WS_H), (const bf16_t*)(wsp(p) + WS_WG), (const bf16_t*)(wsp(p) + WS_WU), (const uint2*)(wsp(p) + WS_LIST)};
    EpiAct E{(unsigned char*)(wsp(p) + WS_ACT)};
    g8::gemm(lds, S, E, DM / 128, DM / 2);
}
template <bool FP8> DEV void phase_pk(const P& p, int layer, LAS unsigned char* lds, MoeMap* mm) {
    build_map(p, layer, mm);
    SchedMoe<1> S{mm, 4, (int)gridDim.x, (int)blockIdx.x, (const bf16_t*)(wsp(p) + WS_ACT), (const bf16_t*)(wsp(p) + WS_WD), nullptr, nullptr};
    static_assert(FP8, "the down projection runs on e4m3 operands and parks e4m3 outputs");
    g8::EpiStore8 E{(unsigned char*)(wsp(p) + WS_YH), DM, DN_RESCALE}; g8::gemm(lds, S, E, FE / 128, FE / 2);
}
template <int RPW> DEV void phase_pm(const P& p, int layer, unsigned char* lds, MoeMap* mm, int row0, int nrows) {
    const bool last = (layer == 1);
    const int tid = tidx(), lane = tid & 63, wid = tid >> 6;
    const float* MOD = (const float*)(wsp(p) + WS_MOD);
    const bf16_t* YH = (const bf16_t*)(wsp(p) + WS_YH); const unsigned* TOPK = (const unsigned*)(wsp(p) + WS_TOPK);
    bf16_t* XB = (bf16_t*)(wsp(p) + WS_XB);
    bf16_t* H = (bf16_t*)(wsp(p) + WS_HIN1); float* DT = (float*)(wsp(p) + WS_DT);
    float* hl = (float*)lds; float* part = (float*)(lds + HL_BYTES);
    build_map(p, layer, mm);
    for (int task = vbid(); task < nrows / (4 * RPW); task += vgrid()) {
        const int tok0 = row0 + task * (4 * RPW) + wid * RPW;
        bf16_t* xb = XB + (size_t)tok0 * DM;
        const int mr = tok0 < TL ? tok0 / SEQ : 8;
        const float* md = MOD + ((size_t)layer * 9 + mr) * 6144;
        const float* md1 = MOD + ((size_t)(last ? layer : layer + 1) * 9 + mr) * 6144;
        float pa[16], pb[16], pc[16];
        ld_row16(md + 5120, lane, pa); ld_row16(md1 + 1024, lane, pb); ld_row16(md1 + 0, lane, pc);
        __syncthreads();
#pragma unroll 1
        for (int rr = 0; rr < RPW; ++rr) {
            const int tok = tok0 + rr;
            float x[16], y[16];
            ld_row16_bf(xb + (size_t)rr * DM, lane, x);
#pragma unroll
            for (int e = 0; e < 16; ++e) y[e] = 0.f;
#pragma unroll
            for (int k = 0; k < 9; ++k) {
                int slot;
                if (k < 8) { const unsigned tk = TOPK[(size_t)tok * 8 + k]; slot = mm->offs[tk & 255u] + (int)(tk >> 8); } else slot = mm->offs[64] + tok;
#pragma unroll
                for (int i = 0; i < 4; ++i) {
                    if (true) {
                        typedef float f32x2v __attribute__((ext_vector_type(2)));
                        const int q = *(const int*)((const unsigned char*)YH + (size_t)slot * DM + 4 * lane + 256 * i);
                        const f32x2v lo = __builtin_amdgcn_cvt_pk_f32_fp8(q, false), hi = __builtin_amdgcn_cvt_pk_f32_fp8(q, true);
                        y[4 * i] += lo[0]; y[4 * i + 1] += lo[1]; y[4 * i + 2] += hi[0]; y[4 * i + 3] += hi[1];
                    } else {
                        const uint2 q = *(const uint2*)(YH + (size_t)slot * DM + 4 * lane + 256 * i);
                        y[4 * i] += bflo(q.x); y[4 * i + 1] += bfhi(q.x); y[4 * i + 2] += bflo(q.y); y[4 * i + 3] += bfhi(q.y); }
                }
            }
            {
#pragma unroll
                for (int e = 0; e < 16; ++e) y[e] *= 0.0625f; }
            const float rsy = rstd16(y);
#pragma unroll
            for (int e = 0; e < 16; ++e) x[e] += pa[e] * (y[e] * rsy);
            if (last) st_row16(p.out + (size_t)tok * DM, lane, x); else st_row16_bf(xb + (size_t)rr * DM, lane, x);
            if (!last) {
                const float rs = rstd16(x);
                float h[16];
#pragma unroll
                for (int e = 0; e < 16; ++e) h[e] = x[e] * rs * pb[e] + pc[e];
                st_row16_bf(H + (size_t)tok * DM, lane, h);
                st_row16(hl + (wid * RPW + rr) * HLS, lane, h);
            }
        }
        if (!last) {
            __syncthreads();
            dt_tail16<RPW>(hl, (const float4*)(wsp(p) + WS_WD2) + 4096 * (layer + 1), p.dt_bias + (layer + 1) * 16, part, DT, row0 + task * (4 * RPW), tid);
        }
    }
}

#define XB_TMO      128
#define XB_XCNT(j)  (256  + 64 * (j))
#define XB_XSUB(j)  (1280 + 64 * (j))
#define XB_XGEN(j)  (2304 + 64 * (j))
#define XB_TOP      3328
#define XB_TOPGEN   3392
#define XCD_BAR_WORDS 3456
#define XB_SPIN_CAP (1u << 18)
static_assert((CW_QH + 64) * 4 <= (int)CTL_BYTES && CW_CNT + 2 * CNT_LAYER <= CW_QH, "control words");
static_assert(XCD_BAR_WORDS <= CW_CNT, "barrier words below the expert counters");

__device__ __forceinline__ unsigned xb_ld(unsigned* p)              { return __hip_atomic_load(p, __ATOMIC_RELAXED, __HIP_MEMORY_SCOPE_AGENT); }
__device__ __forceinline__ unsigned xb_add(unsigned* p, unsigned v) { return __hip_atomic_fetch_add(p, v, __ATOMIC_RELAXED, __HIP_MEMORY_SCOPE_AGENT); }
__device__ __forceinline__ unsigned xb_xcc_id() { return (unsigned)__builtin_amdgcn_s_getreg((3 << 11) | 20) & 0xFu; }
#define XB_SPIN(cond, bar) do { unsigned _sp = 0; while (cond) { __builtin_amdgcn_s_sleep(1); \
    if ((++_sp & 255u) == 0u) { if (xb_ld(&(bar)[XB_TMO])) break; if (_sp > XB_SPIN_CAP) { atomicAdd(&(bar)[XB_TMO], 1u); break; } } } } while (0)

struct XcdBarrier {
    unsigned* bar; unsigned x;
    volatile LAS unsigned* st;
};
__device__ __forceinline__ XcdBarrier xcd_barrier_post(unsigned* bar, volatile LAS unsigned* st) {
    XcdBarrier b; b.bar = bar; b.x = xb_xcc_id(); b.st = st;
    if (tid512() == 0) (void)xb_add(&bar[XB_XCNT(b.x)], 1u);
    return b;
}
__device__ __forceinline__ void xcd_barrier_complete(unsigned* bar, unsigned x, unsigned& nloc, unsigned& nx) {
    const unsigned G = gridDim.x * gridDim.y * gridDim.z;
    unsigned sum, cnt, mine, sp = 0u;
    for (;;) {
        sum = 0u; cnt = 0u; mine = 0u;
#pragma unroll
        for (unsigned j = 0; j < 16; ++j) { const unsigned c = xb_ld(&bar[XB_XCNT(j)]); sum += c; cnt += (c > 0u) ? 1u : 0u; mine = (j == x) ? c : mine; }
        if (sum == G) break;
        __builtin_amdgcn_s_sleep(1);
        if ((++sp & 255u) == 0u) { if (xb_ld(&bar[XB_TMO])) break; if (sp > XB_SPIN_CAP) { atomicAdd(&bar[XB_TMO], 1u); break; } }
    }
    nloc = mine > 0u ? mine : 1u; nx = cnt > 0u ? cnt : 1u;
}
__device__ __forceinline__ void xcd_barrier(const XcdBarrier& b) {
    asm volatile("s_waitcnt vmcnt(0)" ::: "memory");
    __syncthreads();
    if (tid512() == 0) {
        unsigned* bar = b.bar;
        __builtin_amdgcn_s_waitcnt(0);
        unsigned nloc = b.st[0], nx = b.st[1];
        if (nloc == 0u) { xcd_barrier_complete(bar, b.x, nloc, nx); b.st[0] = nloc; b.st[1] = nx; }
        const unsigned old = xb_add(&bar[XB_XSUB(b.x)], 1u);
        const unsigned gen = old / nloc;
        if (old + 1u == (gen + 1u) * nloc) {
            __builtin_amdgcn_fence(__ATOMIC_RELEASE, "agent");
            asm volatile("s_waitcnt vmcnt(0)" ::: "memory");
            const unsigned og = xb_add(&bar[XB_TOP], 1u);
            const unsigned tg = og / nx;
            if (og + 1u == (tg + 1u) * nx) xb_add(&bar[XB_TOPGEN], 1u);
            else XB_SPIN(xb_ld(&bar[XB_TOPGEN]) == tg, bar);
            __builtin_amdgcn_fence(__ATOMIC_ACQUIRE, "agent");
            xb_add(&bar[XB_XGEN(b.x)], 1u);
            asm volatile("s_waitcnt vmcnt(0)" ::: "memory");
        } else {
            XB_SPIN(xb_ld(&bar[XB_XGEN(b.x)]) == gen, bar);
            __builtin_amdgcn_fence(__ATOMIC_ACQUIRE, "agent");
            asm volatile("s_waitcnt vmcnt(0)" ::: "memory");
        }
    }
    __syncthreads();
}

DEV unsigned long long rfl64(unsigned long long v) { const unsigned lo = __builtin_amdgcn_readfirstlane((unsigned)v), hi = __builtin_amdgcn_readfirstlane((unsigned)(v >> 32)); return ((unsigned long long)hi << 32) | lo; }
DEV void park_params(const P& p, LAS unsigned long long* tab) { tab[0] = (unsigned long long)p.x; tab[1] = (unsigned long long)p.c; tab[2] = (unsigned long long)p.ctx; tab[3] = (unsigned long long)p.c_ctx; tab[4] = (unsigned long long)p.w_mod; tab[5] = (unsigned long long)p.b_mod; tab[6] = (unsigned long long)p.g_pre_mix; tab[7] = (unsigned long long)p.g_post_mix; tab[8] = (unsigned long long)p.g_pre_ffn; tab[9] = (unsigned long long)p.g_post_ffn; tab[10] = (unsigned long long)p.w_in; tab[11] = (unsigned long long)p.q_norm; tab[12] = (unsigned long long)p.k_norm; tab[13] = (unsigned long long)p.conv_w; tab[14] = (unsigned long long)p.conv_b; tab[15] = (unsigned long long)p.dt_bias; tab[16] = (unsigned long long)p.a_log; tab[17] = (unsigned long long)p.d_skip; tab[18] = (unsigned long long)p.ssd_norm; tab[19] = (unsigned long long)p.w_out; tab[20] = (unsigned long long)p.router_w; tab[21] = (unsigned long long)p.router_bias; tab[22] = (unsigned long long)p.w_gate; tab[23] = (unsigned long long)p.w_up; tab[24] = (unsigned long long)p.w_down; tab[25] = (unsigned long long)p.ws_gate; tab[26] = (unsigned long long)p.ws_up; tab[27] = (unsigned long long)p.ws_down; tab[28] = (unsigned long long)p.out; tab[29] = (unsigned long long)p.ws; }
DEV P load_params(const LAS unsigned long long* tab) { P q; q.x = (const float*)(GAS const float*)rfl64(tab[0]); q.c = (const float*)(GAS const float*)rfl64(tab[1]); q.ctx = (const float*)(GAS const float*)rfl64(tab[2]); q.c_ctx = (const float*)(GAS const float*)rfl64(tab[3]); q.w_mod = (const float*)(GAS const float*)rfl64(tab[4]); q.b_mod = (const float*)(GAS const float*)rfl64(tab[5]); q.g_pre_mix = (const float*)(GAS const float*)rfl64(tab[6]); q.g_post_mix = (const float*)(GAS const float*)rfl64(tab[7]); q.g_pre_ffn = (const float*)(GAS const float*)rfl64(tab[8]); q.g_post_ffn = (const float*)(GAS const float*)rfl64(tab[9]); q.w_in = (const float*)(GAS const float*)rfl64(tab[10]); q.q_norm = (const float*)(GAS const float*)rfl64(tab[11]); q.k_norm = (const float*)(GAS const float*)rfl64(tab[12]); q.conv_w = (const float*)(GAS const float*)rfl64(tab[13]); q.conv_b = (const float*)(GAS const float*)rfl64(tab[14]); q.dt_bias = (const float*)(GAS const float*)rfl64(tab[15]); q.a_log = (const float*)(GAS const float*)rfl64(tab[16]); q.d_skip = (const float*)(GAS const float*)rfl64(tab[17]); q.ssd_norm = (const float*)(GAS const float*)rfl64(tab[18]); q.w_out = (const float*)(GAS const float*)rfl64(tab[19]); q.router_w = (const float*)(GAS const float*)rfl64(tab[20]); q.router_bias = (const float*)(GAS const float*)rfl64(tab[21]); q.w_gate = (const float*)(GAS const float*)rfl64(tab[22]); q.w_up = (const float*)(GAS const float*)rfl64(tab[23]); q.w_down = (const float*)(GAS const float*)rfl64(tab[24]); q.ws_gate = (const float*)(GAS const float*)rfl64(tab[25]); q.ws_up = (const float*)(GAS const float*)rfl64(tab[26]); q.ws_down = (const float*)(GAS const float*)rfl64(tab[27]); q.out = (float*)(GAS float*)rfl64(tab[28]); q.ws = (unsigned char*)(GAS unsigned char*)rfl64(tab[29]); return q; }
static_assert(g8::STAGE_BYTES + 512 * 16 <= LDS_HALF + LDS_MAIN, "the 8-wave GEMM's stage buffers + parking slots must stay below the second half's MoE map");
static_assert(HL_BYTES + 16 * 64 * 4 + 512 <= LDS_MAIN, "row-phase LDS");
__device__ __noinline__ void grid_bar() {
    const LAS unsigned long long* ptab = (const LAS unsigned long long*)(smem_all + LDS_PT);
    XcdBarrier bar_; bar_.bar = (unsigned*)(GAS unsigned*)rfl64(ptab[29]); bar_.x = xb_xcc_id(); bar_.st = (volatile LAS unsigned*)(smem_all + LDS_XB);
    xcd_barrier(bar_);
}
__global__ void __launch_bounds__(NTHR, 2) k_mega(P p0) {
    if ((threadIdx.x & 63) == 0) ((LAS int*)(smem_all + LDS_WT))[hw_slot()] = (int)(threadIdx.x >> 6);
    __syncthreads();
    unsigned char* smem = smem_all + vhalf() * LDS_HALF;
    MoeMap* mm = (MoeMap*)(smem + LDS_MAIN);
    LAS unsigned long long* ptab = (LAS unsigned long long*)(smem_all + LDS_PT);
    if (tid512() == 0) { *(uint4*)(smem_all + LDS_XB) = make_uint4(0u, 0u, 0u, 0u); park_params(p0, ptab); }
    __syncthreads();
    (void)xcd_barrier_post((unsigned*)(p0.ws + WS_CTL), (volatile LAS unsigned*)(smem_all + LDS_XB));
#define GRID_BAR() grid_bar()
    phase_p0(load_params(ptab), 0, smem, 2, true);
    GRID_BAR();
    phase_pa0<4>(load_params(ptab), smem, 0, TL); phase_pa0<1>(load_params(ptab), smem, TL, TC);
    GRID_BAR();
    constexpr int P1_EARLY = 800;
#define LAYER_BODY(layer) do { \
        phase_pb(load_params(ptab), layer, (LAS unsigned char*)smem_all); \
        if (layer == 0 && blockIdx.x >= 136) fill_strips(load_params(ptab), smem, 3); \
        if (layer == 1) { if (gridDim.x != 256) phase_p0(load_params(ptab), 1, smem, 1, false); \
                          else if (blockIdx.x >= 136) { const int hb = vbid() - 272; strips_loop(load_params(ptab), 1, smem, hb, (P1_EARLY - hb + 239) / 240, 240, 1); } }               \
        GRID_BAR(); \
        phase_pc(load_params(ptab), layer, smem); \
        GRID_BAR(); \
        phase_pd(load_params(ptab), smem_all); phase_pg(load_params(ptab), layer, smem_all); \
        if (layer == 1 && gridDim.x == 256 && blockIdx.x >= 128) strips_loop(load_params(ptab), 1, smem, P1_EARLY + (vbid() - 256), (2080 - P1_EARLY) / 256, 256, 1);        \
        if (layer == 0 && gridDim.x == 256 && blockIdx.x >= 160) fill_strips(load_params(ptab), smem, 4);        \
        GRID_BAR(); \
        phase_pf(load_params(ptab), layer, smem); \
        if (layer == 0 && blockIdx.x >= 64) fill_strips(load_params(ptab), smem, 1); \
        GRID_BAR(); \
        phase_ph(load_params(ptab), layer, (LAS unsigned char*)smem_all); \
        if (layer == 0 && blockIdx.x >= 32) fill_strips(load_params(ptab), smem, 3); \
        GRID_BAR(); \
        phase_pi<4>(load_params(ptab), layer, smem, 0, TL); if (layer == 0) phase_pi<1>(load_params(ptab), layer, smem, TL, TC); \
        if (layer == 0) fill_strips(load_params(ptab), smem, -1); \
        GRID_BAR(); \
        phase_pj(load_params(ptab), layer, (LAS unsigned char*)smem_all, (MoeMap*)(smem_all + LDS_HALF + LDS_MAIN)); \
        GRID_BAR(); \
        phase_pk<true>(load_params(ptab), layer, (LAS unsigned char*)smem_all, (MoeMap*)(smem_all + LDS_HALF + LDS_MAIN)); \
        GRID_BAR(); \
        phase_pm<4>(load_params(ptab), layer, smem, mm, 0, TL); if (layer == 0) phase_pm<1>(load_params(ptab), layer, smem, mm, TL, TC); \
        if (layer == 0) { phase_p0(load_params(ptab), 1, smem, 0, false); GRID_BAR(); } \
    } while (0)
    LAYER_BODY(0);
    LAYER_BODY(1);
#undef LAYER_BODY
}

extern "C" void kernel_launch(void* const* d_in, const int* in_sizes, int n_in, void* d_out, int out_size, void* d_ws, size_t ws_size, hipStream_t stream) {
    if (ws_size < WS_END) { fprintf(stderr, "workspace too small: %zu < %zu\n", ws_size, (size_t)WS_END); return; }
    static int grid = 0;
    if (!grid) {
        int dev = 0, cus = 0, per_cu = 0;
        (void)hipGetDevice(&dev);
        (void)hipDeviceGetAttribute(&cus, hipDeviceAttributeMultiprocessorCount, dev);
        (void)hipFuncSetAttribute((const void*)k_mega, hipFuncAttributeMaxDynamicSharedMemorySize, LDS_BYTES);
        (void)hipOccupancyMaxActiveBlocksPerMultiprocessor(&per_cu, (const void*)k_mega, NTHR, LDS_BYTES);
        if (per_cu < 1) per_cu = 1;
        grid = cus;
    }
    P p{};
    const float** pp = (const float**)&p;
    for (int i = 0; i < 28; ++i) pp[i] = (const float*)d_in[i];
    p.out = (float*)d_out; p.ws = (unsigned char*)d_ws;
    (void)hipMemsetAsync(d_ws, 0, CTL_BYTES, stream);
    hipLaunchKernelGGL(k_mega, dim3(grid), dim3(NTHR), LDS_BYTES, stream, p);
}
```
